# Optimizing an MI355X kernel written in HIP

```python
import jax, jax.numpy as jnp
from jax import lax
import numpy as np

D_MODEL = 1024
BATCH = 8
SEQ = 2048
DEPTH = 2
DEC_BATCH = 8
DEC_SEQ = 16
PAST_LEN = 4096

CHUNK = 64
Q_BLOCK = 128
EPS = 1e-6
N_AB = (DEPTH + 1) // 2
N_C = DEPTH // 2

D_A = D_MODEL
N_BLK_A = 8
BLK_A = D_A // N_BLK_A
CONV_W = 4
LRU_C = 8.0

H_B = 4
DK_B = D_MODEL // 8
DV_B = D_MODEL // 4
GATE_RANK = 16
GATE_TAU = 16.0

AB_SPLITS = (D_A, D_A, H_B * DK_B, H_B * DK_B, H_B * DV_B, H_B * DV_B, GATE_RANK)
IN_AB = 2 * D_A + 2 * H_B * DK_B + 2 * H_B * DV_B + GATE_RANK
MIX_AB = D_A + H_B * DV_B

H_C = 16
Q_LORA = 384
KV_LORA = 256
NOPE = 64
ROPE = 32
V_HEAD = 64
ROPE_BASE = 10000.0
IN_C = Q_LORA + KV_LORA + ROPE
SM_SCALE = (NOPE + ROPE) ** -0.5

D_FF = -(-8 * D_MODEL // (3 * 256)) * 256

kernel_name = 'hybrid_lru_gla_mla_streaming_step'

F32 = jnp.float32


def rms_norm(x, g):
    xf = x.astype(F32)
    y = xf * lax.rsqrt(jnp.mean(xf * xf, axis=-1, keepdims=True) + EPS)
    return (y * g.astype(F32)).astype(x.dtype)


def rope(x, pos):
    half = ROPE // 2
    inv = ROPE_BASE ** (-jnp.arange(half, dtype=F32) / half)
    ang = pos.astype(F32)[:, None] * inv[None, :]
    shape = (1, ang.shape[0]) + (1,) * (x.ndim - 3) + (half,)
    cos = jnp.cos(ang).reshape(shape)
    sin = jnp.sin(ang).reshape(shape)
    xf = x.astype(F32)
    x1, x2 = xf[..., :half], xf[..., half:]
    return jnp.concatenate([x1 * cos - x2 * sin, x1 * sin + x2 * cos], axis=-1).astype(x.dtype)


def causal_dwconv(x, buf, w, b):
    L = x.shape[1]
    xp = jnp.concatenate([buf.astype(x.dtype), x], axis=1)
    y = b + sum(xp[:, j:j + L] * w[j] for j in range(CONV_W))
    return y, xp[:, L:]


def _lin_combine(left, right):
    a_l, b_l = left
    a_r, b_r = right
    return a_l * a_r, a_r * b_l + b_r


def rg_lru(x, h0, w_a, b_a, w_x, b_x, lam):
    Bn, L, _ = x.shape
    xf = x.astype(F32)
    xb = xf.reshape(Bn, L, N_BLK_A, BLK_A)
    r = jax.nn.sigmoid(jnp.einsum('blnc,ncd->blnd', xb, w_a.astype(F32)).reshape(Bn, L, D_A) + b_a.astype(F32))
    i = jax.nn.sigmoid(jnp.einsum('blnc,ncd->blnd', xb, w_x.astype(F32)).reshape(Bn, L, D_A) + b_x.astype(F32))
    log_a = -LRU_C * r * jax.nn.softplus(-lam.astype(F32))
    a = jnp.exp(log_a)
    u = jnp.sqrt(-jnp.expm1(2.0 * log_a)) * (i * xf)
    u = u.at[:, 0].add(a[:, 0] * h0.astype(F32))
    _, h = lax.associative_scan(_lin_combine, (a, u), axis=1)
    return h, h[:, -1]


def gla(q, k, v, log_g, S0):
    Bn, H, L, _ = q.shape
    blk = CHUNK if L % CHUNK == 0 else L
    n = L // blk

    def split(t):
        return jnp.moveaxis(t.astype(F32).reshape(Bn, H, n, blk, t.shape[-1]), 2, 0)

    causal = jnp.tril(jnp.ones((blk, blk), dtype=bool))

    def step(S, inp):
        qc, kc, vc, gc = inp
        b = jnp.cumsum(gc, axis=2)
        o_inter = jnp.einsum('bhtk,bhkv->bhtv', qc * jnp.exp(b), S)
        diff = b[:, :, :, None, :] - b[:, :, None, :, :]
        decay = jnp.exp(jnp.where(causal[:, :, None], diff, -jnp.inf))
        A = jnp.einsum('bhtk,bhsk,bhtsk->bhts', qc, kc, decay)
        o = o_inter + jnp.einsum('bhts,bhsv->bhtv', A, vc)
        b_last = b[:, :, -1:, :]
        S_new = jnp.exp(b_last[:, :, 0, :])[..., None] * S + jnp.einsum('bhsk,bhsv->bhkv', kc * jnp.exp(b_last - b), vc)
        return S_new, o

    S_fin, o = lax.scan(step, S0.astype(F32), (split(q), split(k), split(v), split(log_g)))
    o = jnp.moveaxis(o, 0, 2).reshape(Bn, H, L, -1)
    return o, S_fin


def mixer_ab(u, conv_buf, lru_h0, gla_S0, w_in, conv_w, conv_b, w_a, b_a, w_x, b_x, lam,
             w_gate, b_gate, g_norm, w_out):
    Bn, L, _ = u.shape
    cuts = [int(c) for c in np.cumsum(AB_SPLITS)[:-1]]
    xa, ga, qb, kb, vb, gb, zr = jnp.split(u @ w_in, cuts, axis=-1)
    xa, new_buf = causal_dwconv(xa, conv_buf, conv_w, conv_b)
    ha, new_h = rg_lru(xa, lru_h0, w_a, b_a, w_x, b_x, lam)
    ya = ha.astype(u.dtype) * jax.nn.gelu(ga)
    def heads(t, d):
        return t.reshape(Bn, L, H_B, d).transpose(0, 2, 1, 3)
    log_g = jax.nn.log_sigmoid((zr @ w_gate + b_gate).astype(F32)) / GATE_TAU
    o, new_S = gla(heads(qb, DK_B) * (DK_B ** -0.5), heads(kb, DK_B), heads(vb, DV_B), heads(log_g, DK_B), gla_S0)
    o = rms_norm(o, g_norm).transpose(0, 2, 1, 3).reshape(Bn, L, H_B * DV_B).astype(u.dtype)
    yb = o * jax.nn.silu(gb)
    y = jnp.concatenate([ya, yb], axis=-1) @ w_out
    return y, new_buf, new_h.astype(lru_h0.dtype), new_S.astype(gla_S0.dtype)


def mla_project(u, pos, w_in, q_norm, w_uq, kv_norm):
    Bn, L, _ = u.shape
    cq, ckv, kpe = jnp.split(u @ w_in, [Q_LORA, Q_LORA + KV_LORA], axis=-1)
    q = (rms_norm(cq, q_norm) @ w_uq).reshape(Bn, L, H_C, NOPE + ROPE)
    q_nope = q[..., :NOPE]
    q_pe = rope(q[..., NOPE:], pos)
    return q_nope, q_pe, rms_norm(ckv, kv_norm), rope(kpe, pos)


def mla_prompt(u, w_in, q_norm, w_uq, kv_norm, w_uk, w_uv, w_out):
    Bn, L, _ = u.shape
    pos = jnp.arange(L)
    q_nope, q_pe, ckv, kpe = mla_project(u, pos, w_in, q_norm, w_uq, kv_norm)
    k_nope = jnp.einsum('bsc,chd->bhsd', ckv, w_uk)
    v = jnp.einsum('bsc,chd->bhsd', ckv, w_uv)
    key_chunk = pos // CHUNK

    def block(i):
        qs = i * Q_BLOCK
        qn = lax.dynamic_slice_in_dim(q_nope, qs, Q_BLOCK, axis=1)
        qp = lax.dynamic_slice_in_dim(q_pe, qs, Q_BLOCK, axis=1)
        s = (jnp.einsum('bqhd,bhkd->bhqk', qn, k_nope) + jnp.einsum('bqhr,bkr->bhqk', qp, kpe)).astype(F32) * SM_SCALE
        q_chunk = (qs + jnp.arange(Q_BLOCK)) // CHUNK
        s = jnp.where(key_chunk[None, :] <= q_chunk[:, None], s, -jnp.inf)
        p = jax.nn.softmax(s, axis=-1).astype(v.dtype)
        return jnp.einsum('bhqk,bhkd->bqhd', p, v)

    o = lax.map(block, jnp.arange(L // Q_BLOCK))
    o = jnp.moveaxis(o, 0, 1).reshape(Bn, L, H_C * V_HEAD)
    return o @ w_out, ckv, kpe


def mla_sample(u, cache_ckv, cache_kpe, w_in, q_norm, w_uq, kv_norm, w_uk, w_uv, w_out):
    Bn, L, _ = u.shape
    P = cache_ckv.shape[1]
    pos = P + jnp.arange(L)
    q_nope, q_pe, ckv, kpe = mla_project(u, pos, w_in, q_norm, w_uq, kv_norm)
    q_lat = jnp.einsum('blhd,chd->blhc', q_nope, w_uk)
    c_all = jnp.concatenate([cache_ckv.astype(ckv.dtype), ckv], axis=1)
    k_all = jnp.concatenate([cache_kpe.astype(kpe.dtype), kpe], axis=1)
    s = (jnp.einsum('blhc,bkc->bhlk', q_lat, c_all) + jnp.einsum('blhr,bkr->bhlk', q_pe, k_all)).astype(F32) * SM_SCALE
    p = jax.nn.softmax(s, axis=-1).astype(c_all.dtype)
    o_lat = jnp.einsum('bhlk,bkc->blhc', p, c_all)
    o = jnp.einsum('blhc,chd->blhd', o_lat, w_uv).reshape(Bn, L, H_C * V_HEAD)
    return o @ w_out, ckv, kpe


def swiglu(h, w_g, w_u, w_d):
    return (jax.nn.silu(h @ w_g) * (h @ w_u)) @ w_d


def setup_inputs(seed: int = 0) -> dict:
    key = jax.random.key(seed)
    ks = iter(jax.random.split(key, 48))

    def nrm(shape, scale=1.0):
        return jax.random.normal(next(ks), shape, F32) * scale

    def gain(shape):
        return 1.0 + nrm(shape, 0.02)

    a0 = jax.random.uniform(next(ks), (N_AB, D_A), F32, 0.9, 0.999) ** (1.0 / LRU_C)
    lam = jnp.log(a0) - jnp.log1p(-a0)
    return {
        'x_prompt': nrm((BATCH, SEQ, D_MODEL)),
        'x_sample': nrm((DEC_BATCH, DEC_SEQ, D_MODEL)),
        'state_conv_a': nrm((N_AB, DEC_BATCH, CONV_W - 1, D_A)),
        'state_lru_h': nrm((N_AB, DEC_BATCH, D_A), 0.5),
        'state_gla_S': nrm((N_AB, DEC_BATCH, H_B, DK_B, DV_B)),
        'cache_mla_ckv': nrm((N_C, DEC_BATCH, PAST_LEN, KV_LORA)),
        'cache_mla_kpe': nrm((N_C, DEC_BATCH, PAST_LEN, ROPE)),
        'norm_mix_pre': gain((DEPTH, D_MODEL)),
        'norm_mix_post': gain((DEPTH, D_MODEL)),
        'norm_ffn_pre': gain((DEPTH, D_MODEL)),
        'norm_ffn_post': gain((DEPTH, D_MODEL)),
        'w_in_ab': nrm((N_AB, D_MODEL, IN_AB), D_MODEL ** -0.5),
        'conv_w_a': nrm((N_AB, CONV_W, D_A), 0.5),
        'conv_b_a': nrm((N_AB, D_A), 0.01),
        'lru_w_a': nrm((N_AB, N_BLK_A, BLK_A, BLK_A), BLK_A ** -0.5),
        'lru_b_a': nrm((N_AB, D_A), 0.01),
        'lru_w_x': nrm((N_AB, N_BLK_A, BLK_A, BLK_A), BLK_A ** -0.5),
        'lru_b_x': nrm((N_AB, D_A), 0.01),
        'lru_lambda': lam,
        'gla_w_gate': nrm((N_AB, GATE_RANK, H_B * DK_B), GATE_RANK ** -0.5),
        'gla_b_gate': nrm((N_AB, H_B * DK_B), 0.01),
        'gla_norm': gain((N_AB, DV_B)),
        'w_out_ab': nrm((N_AB, MIX_AB, D_MODEL), MIX_AB ** -0.5),
        'w_in_c': nrm((N_C, D_MODEL, IN_C), D_MODEL ** -0.5),
        'mla_q_norm': gain((N_C, Q_LORA)),
        'w_uq': nrm((N_C, Q_LORA, H_C * (NOPE + ROPE)), Q_LORA ** -0.5),
        'mla_kv_norm': gain((N_C, KV_LORA)),
        'w_uk': nrm((N_C, KV_LORA, H_C, NOPE), KV_LORA ** -0.5),
        'w_uv': nrm((N_C, KV_LORA, H_C, V_HEAD), KV_LORA ** -0.5),
        'w_out_c': nrm((N_C, H_C * V_HEAD, D_MODEL), (H_C * V_HEAD) ** -0.5),
        'ffn_w_gate': nrm((DEPTH, D_MODEL, D_FF), D_MODEL ** -0.5),
        'ffn_w_up': nrm((DEPTH, D_MODEL, D_FF), D_MODEL ** -0.5),
        'ffn_w_down': nrm((DEPTH, D_FF, D_MODEL), D_FF ** -0.5),
    }


def reference(x_prompt, x_sample, state_conv_a, state_lru_h, state_gla_S, cache_mla_ckv, cache_mla_kpe,
              norm_mix_pre, norm_mix_post, norm_ffn_pre, norm_ffn_post,
              w_in_ab, conv_w_a, conv_b_a, lru_w_a, lru_b_a, lru_w_x, lru_b_x, lru_lambda,
              gla_w_gate, gla_b_gate, gla_norm, w_out_ab,
              w_in_c, mla_q_norm, w_uq, mla_kv_norm, w_uk, w_uv, w_out_c,
              ffn_w_gate, ffn_w_up, ffn_w_down):

    def run(x, conv_state, lru_state, gla_state, ckv_cache, kpe_cache):
        h = x
        n_conv, n_h, n_S, n_ckv, n_kpe = [], [], [], [], []
        for layer in range(DEPTH):
            j = layer // 2
            u = rms_norm(h, norm_mix_pre[layer])
            if layer % 2 == 0:
                y, cb, hl, S = mixer_ab(u, conv_state[j], lru_state[j], gla_state[j], w_in_ab[j],
                                        conv_w_a[j], conv_b_a[j], lru_w_a[j], lru_b_a[j], lru_w_x[j],
                                        lru_b_x[j], lru_lambda[j], gla_w_gate[j], gla_b_gate[j],
                                        gla_norm[j], w_out_ab[j])
                n_conv.append(cb)
                n_h.append(hl)
                n_S.append(S)
            else:
                if ckv_cache is None:
                    y, c, kp = mla_prompt(u, w_in_c[j], mla_q_norm[j], w_uq[j], mla_kv_norm[j],
                                          w_uk[j], w_uv[j], w_out_c[j])
                else:
                    y, c, kp = mla_sample(u, ckv_cache[j], kpe_cache[j], w_in_c[j], mla_q_norm[j], w_uq[j],
                                          mla_kv_norm[j], w_uk[j], w_uv[j], w_out_c[j])
                n_ckv.append(c)
                n_kpe.append(kp)
            h = h + rms_norm(y, norm_mix_post[layer])
            f = swiglu(rms_norm(h, norm_ffn_pre[layer]), ffn_w_gate[layer], ffn_w_up[layer], ffn_w_down[layer])
            h = h + rms_norm(f, norm_ffn_post[layer])
        return h, jnp.stack(n_conv), jnp.stack(n_h), jnp.stack(n_S), jnp.stack(n_ckv), jnp.stack(n_kpe)

    Bp = x_prompt.shape[0]
    zero_conv = jnp.zeros((N_AB, Bp, CONV_W - 1, D_A), state_conv_a.dtype)
    zero_h = jnp.zeros((N_AB, Bp, D_A), state_lru_h.dtype)
    zero_S = jnp.zeros((N_AB, Bp, H_B, DK_B, DV_B), state_gla_S.dtype)
    y_prompt, p_conv, p_h, p_S, p_ckv, p_kpe = run(x_prompt, zero_conv, zero_h, zero_S, None, None)
    y_sample, s_conv, s_h, s_S, s_ckv, s_kpe = run(x_sample, state_conv_a, state_lru_h, state_gla_S,
                                                   cache_mla_ckv, cache_mla_kpe)
    return (y_prompt, y_sample, p_conv, p_h, p_S, p_ckv, p_kpe, s_conv, s_h, s_S, s_ckv, s_kpe)
```

```cpp
#include <hip/hip_runtime.h>
#include <hip/hip_cooperative_groups.h>
#include <cstdio>
#include <cstdint>
namespace cg = cooperative_groups;

#define DI __device__ __forceinline__
#define LAS __attribute__((address_space(3)))
typedef unsigned short bf16_t;
typedef short bf16x8 __attribute__((ext_vector_type(8)));
typedef short s16x4 __attribute__((ext_vector_type(4)));
typedef float f32x2 __attribute__((ext_vector_type(2)));
typedef float f32x4 __attribute__((ext_vector_type(4)));
typedef float f32x16 __attribute__((ext_vector_type(16)));
typedef unsigned u32x2 __attribute__((ext_vector_type(2)));
typedef unsigned u32x4 __attribute__((ext_vector_type(4)));
typedef __bf16 bf16x2_t __attribute__((ext_vector_type(2)));

constexpr int DM = 1024, MP = 16384, MS = 128, SEQ = 2048, NB = 8, DSEQ = 16, PAST = 4096;
constexpr int NZ = 5376;
constexpr int ZC_XA = 0, ZC_GA = 1024, ZC_GB = 2048, ZC_Q = 3072, ZC_K = 3584, ZC_V = 4096, ZC_ZR = 5120;
constexpr int IN_AB = 5136, DFF = 2816, NGU = 5632, INC = 672, NINC = 768, NQ = 1536;
constexpr int KEYS = 4112, KEYP = 4160, DLAT = 288;
constexpr int NSPLIT = 30, NKT = 65;
constexpr float EPS = 1e-6f;
constexpr int LDS_BYTES = 147456;

constexpr size_t O_YP = 0, O_YS = 16777216, O_PCONV = 16908288, O_PH = 16932864, O_PS = 16941056, O_PCKV = 17989632, O_PKPE = 22183936,
                 O_SCONV = 22708224, O_SH = 22732800, O_SS = 22740992, O_SCKV = 23789568, O_SKPE = 23822336;

constexpr size_t al(size_t x) { return (x + 255) & ~(size_t)255; }
constexpr size_t WS_WIN = 0;
constexpr size_t WS_WOUT = WS_WIN + (size_t)NZ * 1024 * 2;
constexpr size_t WS_WGU0 = WS_WOUT + (size_t)1024 * 2048 * 2;
constexpr size_t WS_WDN0 = WS_WGU0 + (size_t)NGU * 1024 * 2;
constexpr size_t WS_WAT = WS_WDN0 + (size_t)1024 * DFF * 2;
constexpr size_t WS_ROPE = WS_WAT + (size_t)2 * 8 * 128 * 128 * 2;
constexpr size_t WS_US = al(WS_ROPE + (size_t)2064 * 32 * 4);
constexpr size_t WS_ZS = WS_US + (size_t)MS * 1024 * 2;
constexpr size_t WS_GS = WS_ZS + (size_t)MS * NZ * 2;
constexpr size_t WS_CQS = WS_GS + (size_t)MS * DFF * 2;
constexpr size_t WS_CQNS = WS_CQS + (size_t)MS * NINC * 4;
constexpr size_t WS_QNS = WS_CQNS + (size_t)MS * 384 * 2;
constexpr size_t WS_QLAT = WS_QNS + (size_t)MS * 1024 * 2;
constexpr size_t WS_ML = WS_QLAT + (size_t)2048 * DLAT * 2;
constexpr size_t WS_OLAT = al(WS_ML + (size_t)8 * NSPLIT * 256 * 2 * 4);
constexpr size_t WS_OS = WS_OLAT + (size_t)2048 * 256 * 2;
constexpr size_t WS_U = al(WS_OS + (size_t)MS * 1024 * 2);
constexpr size_t WS_Z = WS_U + (size_t)MP * 1024 * 2;
constexpr size_t Z_BYTES = (size_t)MP * NZ * 2;
constexpr size_t WS_CTL = WS_Z + Z_BYTES;
constexpr size_t CTL_BYTES = 16384;
constexpr size_t WS_DEC = WS_CTL + CTL_BYTES;
constexpr size_t WS_TA = WS_DEC + (size_t)1024 * 128 * 4;
constexpr size_t WS_TU = WS_TA + (size_t)128 * 1024 * 4;
constexpr size_t WS_WINC = WS_TU + (size_t)128 * 1024 * 4;
constexpr size_t WS_WUQ = WS_WINC + (size_t)NINC * 1024 * 2;
constexpr size_t WS_WUKT = WS_WUQ + (size_t)NQ * 384 * 2;
constexpr size_t WS_WUVT = WS_WUKT + (size_t)1024 * 256 * 2;
constexpr size_t WS_WOC = WS_WUVT + (size_t)1024 * 256 * 2;
constexpr size_t WS_WUKP = WS_WOC + (size_t)1024 * 1024 * 2;
constexpr size_t WS_END = WS_WUKP + (size_t)256 * 1024 * 2;
constexpr size_t ZR_WGU1 = WS_Z;
constexpr size_t ZR_WDN1 = ZR_WGU1 + (size_t)NGU * 1024 * 2;
constexpr size_t ZR_WUK = ZR_WDN1 + (size_t)1024 * DFF * 2;
constexpr size_t ZR_CC = ZR_WUK;
constexpr size_t ZR_CCT = ZR_CC + (size_t)NB * KEYP * DLAT * 2;
constexpr size_t ZR_G = al(ZR_CCT + (size_t)NB * 256 * KEYP * 2);
constexpr size_t ZR_QN = ZR_G;
constexpr size_t ZR_VT = ZR_QN + (size_t)MP * NQ * 2;
constexpr size_t ZR_CQN = ZR_VT + (size_t)MP * 1024 * 2;
constexpr size_t ZR_CKVN = ZR_CQN + (size_t)MP * 384 * 2;
constexpr size_t ZR_KPE = ZR_CKVN + (size_t)MP * 256 * 2;
constexpr size_t ZR_END = ZR_KPE + (size_t)MP * 32 * 2;
static_assert(ZR_END <= WS_CTL && ZR_G + (size_t)MP * DFF * 2 <= WS_CTL && WS_END <= 268435456, "ws map");
static_assert((size_t)NB * NSPLIT * 256 * 256 * 2 <= WS_WAT, "OP fits the layer-0 weight area");
static_assert((size_t)MP * NINC * 4 <= (size_t)MP * NQ * 2, "CQ fits QN");
static_assert(ZR_CC + (size_t)MP * 1024 * 2 <= ZR_G, "Hb2 fits the latent cache image");

DI unsigned cvtpk(float lo, float hi) { f32x2 v = {lo, hi}; bf16x2_t b = __builtin_convertvector(v, bf16x2_t); return __builtin_bit_cast(unsigned, b); }
DI float bf2f(bf16_t b) { return __uint_as_float(((unsigned)b) << 16); }
DI bf16_t f2bf(float f) { return (bf16_t)(cvtpk(f, 0.f) & 0xffffu); }
DI float lo2f(unsigned u) { return __uint_as_float(u << 16); }
DI float hi2f(unsigned u) { return __uint_as_float(u & 0xffff0000u); }
DI float fexp(float x) { return __builtin_amdgcn_exp2f(x * 1.44269504089f); }
DI float frcp(float x) { return __builtin_amdgcn_rcpf(x); }
DI float fsigmoid(float x) { return frcp(1.0f + fexp(-x)); }
DI float fsilu(float x) { return x * fsigmoid(x); }
DI float fgelu(float x) { const float u = 0.7978845608f * (x + 0.044715f * x * x * x); const float t = 1.0f - 2.0f * frcp(1.0f + fexp(2.0f * u)); return 0.5f * x * (1.0f + t); }
DI float flog(float x) { return __builtin_amdgcn_logf(x) * 0.69314718056f; }
DI float flog1p_small(float e) { return e < 0.03f ? e * (1.0f - e * (0.5f - e * (0.33333333f - 0.25f * e))) : flog(1.0f + e); }
DI float fsoftplus(float x) { return fmaxf(x, 0.f) + flog1p_small(fexp(-fabsf(x))); }
DI float neg_expm1(float y) {
    return (y > -0.1f) ? -y * (1.0f + y * 0.5f * (1.0f + y * 0.33333333f * (1.0f + y * 0.25f * (1.0f + y * 0.2f)))) : 1.0f - fexp(y); }
DI float wave_sum(float v) {
#pragma unroll
    for (int o = 32; o >= 1; o >>= 1) v += __shfl_xor(v, o, 64);
    return v; }
DI int ltid() { int t = threadIdx.x; asm volatile("" : "+v"(t)); return t; }
DI int crow(int i, int h) { return (i & 3) + 8 * (i >> 2) + 4 * h; }
DI bf16x8 pack8(const f32x16& x, int s) {
    u32x4 p; p.x = cvtpk(x[8 * s], x[8 * s + 1]); p.y = cvtpk(x[8 * s + 2], x[8 * s + 3]); p.z = cvtpk(x[8 * s + 4], x[8 * s + 5]); p.w = cvtpk(x[8 * s + 6], x[8 * s + 7]);
    return __builtin_bit_cast(bf16x8, p); }
DI bf16x8 ld8(const void* p) { return *(const bf16x8*)p; }
DI bf16x8 cat44(const void* lo, const void* hi) { const s16x4 a = *(const s16x4*)lo, b = *(const s16x4*)hi; return __builtin_shufflevector(a, b, 0, 1, 2, 3, 4, 5, 6, 7); }
#define MFMA32(a, b, c) __builtin_amdgcn_mfma_f32_32x32x16_bf16((a), (b), (c), 0, 0, 0)
#define MFMA16(a, b, c) __builtin_amdgcn_mfma_f32_16x16x32_bf16((a), (b), (c), 0, 0, 0)
DI f32x16 zero16() { f32x16 z; for (int i = 0; i < 16; ++i) z[i] = 0.f; return z; }

namespace pg8 {
constexpr int BM = 256, BK = 64, HALF = 128, HTB = HALF * BK * 2, STAGE_BYTES = 8 * HTB, NXCD = 8, WGM = 8;
DI int lds_byte(int r, int c) { const int st = (r >> 4) * 2 + (c >> 5), rr = r & 15, cc = c & 31, ob = rr * 64 + cc * 2; return st * 1024 + (ob ^ (((ob >> 9) & 1) << 5)); }
DI void stage_rc(int b, int& R, int& C) { const int st = b / 1024, sb = b % 1024, swz = sb ^ (((sb >> 9) & 1) << 5); R = (st >> 1) * 16 + swz / 64; C = (st & 1) * 32 + (swz % 64) / 2; }
DI int perm32(int rho) { const int n = rho >> 4, i = rho & 15; return 8 * (i >> 2) + 4 * n + (i & 3); }
struct Unit { int pm, pn; };
struct Gemm { const bf16_t* A; const bf16_t* Bt; int M, N, K, lda; };
struct StaticOrder {
    int nM, nN, nwg, G, c;
    DI void init(int M, int N, int G_, int c_) { nM = M / BM; nN = N / BM; nwg = nM * nN; G = G_; c = c_; }
    DI bool next(int i, Unit& u) const {
        const long L = (long)i * G + c; if (L >= nwg) return false;
        int wgid = (int)L; { const int q = nwg / NXCD, r = nwg % NXCD, xcd = wgid % NXCD, off = wgid / NXCD; wgid = (xcd < r ? xcd * (q + 1) : r * (q + 1) + (xcd - r) * q) + off; }
        const int nig = WGM * nN, gid = wgid / nig, fm = gid * WGM, gsz = (nM - fm) < WGM ? (nM - fm) : WGM;
        u.pm = fm + ((wgid % nig) % gsz); u.pn = (wgid % nig) / gsz; return true;
    }
};
template <class F> struct Epi {
    F f;
    DI void operator()(const f32x4 (&acc)[2][2][4][2], const Unit& u, int wr, int wc, int fr, int fq) const {
        int frl = fr, fql = fq; asm volatile("" : "+v"(frl), "+v"(fql));
        const int row0 = u.pm * BM + wr * 64 + frl, col0 = u.pn * BM + wc * 32 + 8 * fql;
#pragma unroll
        for (int ai = 0; ai < 2; ++ai)
#pragma unroll
            for (int m = 0; m < 4; ++m)
#pragma unroll
                for (int bj = 0; bj < 2; ++bj) f(row0 + ai * HALF + m * 16, col0 + bj * HALF, acc[ai][bj][m][0], acc[ai][bj][m][1]);
    }
};
template <class EpiT>
DI void gemm_phase(LAS unsigned char* lds, const Gemm g, const StaticOrder& S, const EpiT& E) {
    const int tid = ltid(), wid = __builtin_amdgcn_readfirstlane(tid >> 6), lane = tid & 63, wr = wid >> 2, wc = wid & 3, fr = lane & 15, fq = lane >> 4;
    int K_ = g.K, lda_ = g.lda; asm volatile("" : "+s"(K_), "+s"(lda_));
    const int K = K_, nt = K / BK, lda = lda_;
    unsigned voffA[2], voffB[2];
#pragma unroll
    for (int i = 0; i < 2; ++i) { int R, C; stage_rc(tid * 16 + i * 8192, R, C); const int Rb = (R & ~31) + perm32(R & 31);
        voffA[i] = (unsigned)(R * lda + C) * 2u; voffB[i] = (unsigned)(Rb * K + C) * 2u; }
    const size_t kstep = (size_t)(BK * 2);
    const size_t hstepA = (size_t)HALF * lda * 2, hstepB = (size_t)HALF * K * 2;
    const size_t tstepA = 2 * hstepA, tstepB = 2 * hstepB;
    const unsigned ldsw = (unsigned)wid * 1024u;
    const int aoff = lds_byte(wr * 64 + fr, fq * 8), boff = lds_byte(wc * 32 + fr, fq * 8);
#define PG8_SA(b, h) (((b) * 2 + (h)) * HTB)
#define PG8_SB(b, h) ((4 + (b) * 2 + (h)) * HTB)
#define PG8_STAGE(bufoff, gbase, voff) do { _Pragma("unroll") for (int _i = 0; _i < 2; ++_i) \
        __builtin_amdgcn_global_load_lds((const unsigned*)((const char*)(gbase) + (voff)[_i]), (LAS unsigned*)(lds + (bufoff) + ldsw + _i * 8192), 16, 0, 0); } while (0)
#define PG8_LDA(dst, b, h) do { _Pragma("unroll") for (int m = 0; m < 4; ++m) _Pragma("unroll") for (int k = 0; k < 2; ++k) dst[m][k] = *(const LAS bf16x8*)(lds + PG8_SA(b, h) + aoff + m * 2048 + k * 1024); } while (0)
#define PG8_LDB(dst, b, h) do { _Pragma("unroll") for (int n = 0; n < 2; ++n) _Pragma("unroll") for (int k = 0; k < 2; ++k) dst[n][k] = *(const LAS bf16x8*)(lds + PG8_SB(b, h) + boff + n * 2048 + k * 1024); } while (0)
#define PG8_MMA(ai, bj, At, Bt) do { __builtin_amdgcn_s_setprio(1); _Pragma("unroll") for (int m = 0; m < 4; ++m) _Pragma("unroll") for (int n = 0; n < 2; ++n) _Pragma("unroll") for (int k = 0; k < 2; ++k) \
        acc[ai][bj][m][n] = __builtin_amdgcn_mfma_f32_16x16x32_bf16(Bt[n][k], At[m][k], acc[ai][bj][m][n], 0, 0, 0); __builtin_amdgcn_s_setprio(0); } while (0)
#define PG8_WAIT_V(n) asm volatile("s_waitcnt vmcnt(" #n ")" ::: "memory")
#define PG8_WAIT_L(n) asm volatile("s_waitcnt lgkmcnt(" #n ")" ::: "memory")
#define PG8_BAR __builtin_amdgcn_s_barrier()
#define PG8_SCHED __builtin_amdgcn_sched_barrier(0)
    Unit cur, nxt; int ui = 0;
    if (!S.next(0, cur)) return;
    f32x4 acc[2][2][4][2];
#pragma unroll
    for (int a = 0; a < 2; ++a)
#pragma unroll
        for (int b = 0; b < 2; ++b)
#pragma unroll
            for (int m = 0; m < 4; ++m)
#pragma unroll
                for (int n = 0; n < 2; ++n) acc[a][b][m][n] = (f32x4){0.f, 0.f, 0.f, 0.f};
    bf16x8 At[4][2], B0[2][2], B1[2][2];
    const char* cA = (const char*)g.A + (size_t)cur.pm * tstepA; const char* cB = (const char*)g.Bt + (size_t)cur.pn * tstepB;
    PG8_STAGE(PG8_SB(0, 0), cB, voffB); PG8_STAGE(PG8_SA(0, 0), cA, voffA); PG8_STAGE(PG8_SB(0, 1), cB + hstepB, voffB); PG8_STAGE(PG8_SA(0, 1), cA + hstepA, voffA);
    if (wr == 1) PG8_BAR;
    PG8_WAIT_V(4); PG8_BAR;
    PG8_STAGE(PG8_SB(1, 0), cB + kstep, voffB); PG8_STAGE(PG8_SA(1, 0), cA + kstep, voffA); PG8_STAGE(PG8_SB(1, 1), cB + hstepB + kstep, voffB);
    PG8_WAIT_V(6); PG8_BAR;
    for (;;) {
        const bool has_next = S.next(ui + 1, nxt);
        const char* nA = has_next ? (const char*)g.A + (size_t)nxt.pm * tstepA : cA; const char* nB = has_next ? (const char*)g.Bt + (size_t)nxt.pn * tstepB : cB;
        for (int t = 0; t < nt; t += 2) {
            const bool last = (t == nt - 2);
            const char* a1 = cA + (size_t)(t + 1) * kstep;
            const char* a2 = last ? nA : cA + (size_t)(t + 2) * kstep; const char* b2 = last ? nB : cB + (size_t)(t + 2) * kstep;
            const char* a3 = a2 + kstep; const char* b3 = b2 + kstep;
            PG8_LDB(B0, 0, 0); PG8_SCHED; PG8_LDA(At, 0, 0); PG8_STAGE(PG8_SA(1, 1), a1 + hstepA, voffA);
            PG8_WAIT_L(8); PG8_BAR; PG8_WAIT_L(0); PG8_MMA(0, 0, At, B0); PG8_BAR; PG8_SCHED;
            PG8_LDB(B1, 0, 1); PG8_STAGE(PG8_SB(0, 0), b2, voffB);
            PG8_BAR; PG8_WAIT_L(0); PG8_MMA(0, 1, At, B1); PG8_BAR;
            PG8_LDA(At, 0, 1); PG8_STAGE(PG8_SA(0, 0), a2, voffA);
            PG8_BAR; PG8_WAIT_L(0); PG8_MMA(1, 0, At, B0); PG8_BAR; PG8_SCHED;
            PG8_STAGE(PG8_SB(0, 1), b2 + hstepB, voffB);
            PG8_WAIT_V(6); PG8_BAR; PG8_MMA(1, 1, At, B1); PG8_BAR;
            PG8_LDB(B0, 1, 0); PG8_SCHED; PG8_LDA(At, 1, 0); PG8_STAGE(PG8_SA(0, 1), a2 + hstepA, voffA);
            PG8_WAIT_L(8); PG8_BAR; PG8_WAIT_L(0); PG8_MMA(0, 0, At, B0); PG8_BAR; PG8_SCHED;
            PG8_LDB(B1, 1, 1); PG8_STAGE(PG8_SB(1, 0), b3, voffB);
            PG8_BAR; PG8_WAIT_L(0); PG8_MMA(0, 1, At, B1); PG8_BAR;
            PG8_LDA(At, 1, 1); PG8_STAGE(PG8_SA(1, 0), a3, voffA);
            PG8_BAR; PG8_WAIT_L(0); PG8_MMA(1, 0, At, B0); PG8_BAR; PG8_SCHED;
            PG8_STAGE(PG8_SB(1, 1), b3 + hstepB, voffB);
            PG8_WAIT_V(6); PG8_BAR; PG8_MMA(1, 1, At, B1); PG8_BAR;
        }
        E(acc, cur, wr, wc, fr, fq);
        if (!has_next) break;
#pragma unroll
        for (int a = 0; a < 2; ++a)
#pragma unroll
            for (int b = 0; b < 2; ++b)
#pragma unroll
                for (int m = 0; m < 4; ++m)
#pragma unroll
                    for (int n = 0; n < 2; ++n) acc[a][b][m][n] = (f32x4){0.f, 0.f, 0.f, 0.f};
        cur = nxt; cA = nA; cB = nB; ++ui;
    }
    PG8_WAIT_V(0);
    if (wr == 0) PG8_BAR;
    PG8_BAR;
#undef PG8_SA
#undef PG8_SB
#undef PG8_STAGE
#undef PG8_LDA
#undef PG8_LDB
#undef PG8_MMA
#undef PG8_WAIT_V
#undef PG8_WAIT_L
#undef PG8_BAR
#undef PG8_SCHED
}
}

template <class F>
DI void big_gemm(char* smem, const bf16_t* A, int lda, const bf16_t* Bt, int M, int N, int K, int crot, const F& f) {
    pg8::Gemm g{A, Bt, M, N, K, lda};
    pg8::StaticOrder S; S.init(M, N, (int)gridDim.x, (int)((blockIdx.x + crot) % gridDim.x));
    pg8::Epi<F> E{f};
    pg8::gemm_phase(( LAS unsigned char*)smem, g, S, E);
}

template <class F>
DI void small_gemm_unit(char* smem, const bf16_t* A, int lda, const bf16_t* Wt, int ldw, int K, int n0, const F& f) {
    const int tid = ltid(), wid = tid >> 6, lane = tid & 63, r16 = lane & 15, quad = lane >> 4;
    f32x4 acc[8];
#pragma unroll
    for (int i = 0; i < 8; ++i) acc[i] = (f32x4){0.f, 0.f, 0.f, 0.f};
    {
        const int nks = K / 32;
        bf16x8 bcur, acur[8];
        if (wid < nks) { const int k0 = wid * 32 + quad * 8; bcur = ld8(Wt + (size_t)(n0 + r16) * ldw + k0);
#pragma unroll
            for (int rb = 0; rb < 8; ++rb) acur[rb] = ld8(A + (size_t)(rb * 16 + r16) * lda + k0); }
        for (int ks = wid; ks < nks; ks += 8) {
            bf16x8 bnx = bcur, anx[8];
#pragma unroll
            for (int rb = 0; rb < 8; ++rb) anx[rb] = acur[rb];
            if (ks + 8 < nks) { const int k1 = (ks + 8) * 32 + quad * 8; bnx = ld8(Wt + (size_t)(n0 + r16) * ldw + k1);
#pragma unroll
                for (int rb = 0; rb < 8; ++rb) anx[rb] = ld8(A + (size_t)(rb * 16 + r16) * lda + k1); }
#pragma unroll
            for (int rb = 0; rb < 8; ++rb) acc[rb] = MFMA16(acur[rb], bcur, acc[rb]);
            bcur = bnx;
#pragma unroll
            for (int rb = 0; rb < 8; ++rb) acur[rb] = anx[rb];
        }
    }
    float* P = (float*)smem;
#pragma unroll
    for (int rb = 0; rb < 8; ++rb)
#pragma unroll
        for (int j = 0; j < 4; ++j) P[(wid * 128 + rb * 16 + quad * 4 + j) * 16 + r16] = acc[rb][j];
    __syncthreads();
    if (tid < 256) {
        const int row = tid >> 1, c8 = (tid & 1) * 8;
        f32x4 s0 = (f32x4){0.f, 0.f, 0.f, 0.f}, s1 = s0;
#pragma unroll
        for (int w = 0; w < 8; ++w) { s0 += *(const f32x4*)&P[(w * 128 + row) * 16 + c8]; s1 += *(const f32x4*)&P[(w * 128 + row) * 16 + c8 + 4]; }
        f(row, n0 + c8, s0, s1);
    }
    __syncthreads();
}
template <class F>
DI void small_gemm_unit2(char* smem, const bf16_t* A, int lda, const bf16_t* Wt, int ldw, int K, int n0, const F& f) {
    const int tid = ltid(), wid = tid >> 6, lane = tid & 63, r16 = lane & 15, quad = lane >> 4;
    f32x4 acc[2][8];
#pragma unroll
    for (int c = 0; c < 2; ++c)
#pragma unroll
        for (int i = 0; i < 8; ++i) acc[c][i] = (f32x4){0.f, 0.f, 0.f, 0.f};
    {
        const int nks = K / 32;
        bf16x8 b0c, b1c, acur[8];
        if (wid < nks) { const int k0 = wid * 32 + quad * 8; b0c = ld8(Wt + (size_t)(n0 + r16) * ldw + k0); b1c = ld8(Wt + (size_t)(n0 + 16 + r16) * ldw + k0);
#pragma unroll
            for (int rb = 0; rb < 8; ++rb) acur[rb] = ld8(A + (size_t)(rb * 16 + r16) * lda + k0); }
        for (int ks = wid; ks < nks; ks += 8) {
            bf16x8 b0n = b0c, b1n = b1c, anx[8];
#pragma unroll
            for (int rb = 0; rb < 8; ++rb) anx[rb] = acur[rb];
            if (ks + 8 < nks) { const int k1 = (ks + 8) * 32 + quad * 8; b0n = ld8(Wt + (size_t)(n0 + r16) * ldw + k1); b1n = ld8(Wt + (size_t)(n0 + 16 + r16) * ldw + k1);
#pragma unroll
                for (int rb = 0; rb < 8; ++rb) anx[rb] = ld8(A + (size_t)(rb * 16 + r16) * lda + k1); }
#pragma unroll
            for (int rb = 0; rb < 8; ++rb) { acc[0][rb] = MFMA16(acur[rb], b0c, acc[0][rb]); acc[1][rb] = MFMA16(acur[rb], b1c, acc[1][rb]); }
            b0c = b0n; b1c = b1n;
#pragma unroll
            for (int rb = 0; rb < 8; ++rb) acur[rb] = anx[rb];
        }
    }
    float* P = (float*)smem;
#pragma unroll
    for (int c = 0; c < 2; ++c)
#pragma unroll
        for (int rb = 0; rb < 8; ++rb)
#pragma unroll
            for (int j = 0; j < 4; ++j) P[(wid * 128 + rb * 16 + quad * 4 + j) * 32 + c * 16 + r16] = acc[c][rb][j];
    __syncthreads();
    {
        const int row = tid >> 2, c8 = (tid & 3) * 8;
        f32x4 s0 = (f32x4){0.f, 0.f, 0.f, 0.f}, s1 = s0;
#pragma unroll
        for (int w = 0; w < 8; ++w) { s0 += *(const f32x4*)&P[(w * 128 + row) * 32 + c8]; s1 += *(const f32x4*)&P[(w * 128 + row) * 32 + c8 + 4]; }
        f(row, n0 + c8, s0, s1);
    }
    __syncthreads();
}
template <class F>
DI void small_gemm2(char* smem, const bf16_t* A, int lda, const bf16_t* Wt, int ldw, int K, int N, int bstart, const F& f) {
    const int G = gridDim.x; const int me = ((int)blockIdx.x - bstart % G + G) % G;
    for (int u = me; u < N / 32; u += G) small_gemm_unit2(smem, A, lda, Wt, ldw, K, u * 32, f);
}
template <class F>
DI void small_gemm(char* smem, const bf16_t* A, int lda, const bf16_t* Wt, int ldw, int K, int N, int bstart, const F& f) {
    const int G = gridDim.x; const int me = ((int)blockIdx.x - bstart % G + G) % G;
    for (int u = me; u < N / 16; u += G) small_gemm_unit(smem, A, lda, Wt, ldw, K, u * 16, f);
}

struct FZ {
    bf16_t* Z;
    DI void operator()(int row, int col, f32x4 v0, f32x4 v1) const {
        if (col >= ZC_GA && col < ZC_GB) { for (int j = 0; j < 4; ++j) { v0[j] = fgelu(v0[j]); v1[j] = fgelu(v1[j]); } }
        else if (col >= ZC_GB && col < ZC_Q) { for (int j = 0; j < 4; ++j) { v0[j] = fsilu(v0[j]); v1[j] = fsilu(v1[j]); } }
        u32x4 w; w.x = cvtpk(v0[0], v0[1]); w.y = cvtpk(v0[2], v0[3]); w.z = cvtpk(v1[0], v1[1]); w.w = cvtpk(v1[2], v1[3]);
        *(u32x4*)(Z + (size_t)row * NZ + col) = w;
    }
};
struct FB {
    bf16_t* O; int ldc;
    DI void operator()(int row, int col, f32x4 v0, f32x4 v1) const {
        u32x4 w; w.x = cvtpk(v0[0], v0[1]); w.y = cvtpk(v0[2], v0[3]); w.z = cvtpk(v1[0], v1[1]); w.w = cvtpk(v1[2], v1[3]);
        *(u32x4*)(O + (size_t)row * ldc + col) = w;
    }
};
struct FSw {
    bf16_t* G;
    DI void operator()(int row, int col, f32x4 v0, f32x4 v1) const {
        u32x2 w; w.x = cvtpk(fsilu(v0[0]) * v1[0], fsilu(v0[1]) * v1[1]); w.y = cvtpk(fsilu(v0[2]) * v1[2], fsilu(v0[3]) * v1[3]);
        *(u32x2*)(G + (size_t)row * DFF + (col >> 1)) = w;
    }
};
struct FF32 {
    float* C; int ldc;
    DI void operator()(int row, int col, f32x4 v0, f32x4 v1) const { *(f32x4*)(C + (size_t)row * ldc + col) = v0; *(f32x4*)(C + (size_t)row * ldc + col + 4) = v1; }
};
constexpr float QSCALE = 0.10206207261596575f * 1.4426950408889634f;
struct FQ {
    const float* rope; int sample; bf16_t* QN; bf16_t* QLAT;
    DI void operator()(int row, int col, f32x4 v0, f32x4 v1) const {
        if (col >= 1024) {
            const int m = col - 1024, i0 = (m & 31) >> 1;
            const int pidx = sample ? (2048 + (row & 15)) : (row & 2047);
            const f32x4 c = *(const f32x4*)(rope + pidx * 32 + i0), s = *(const f32x4*)(rope + pidx * 32 + 16 + i0);
            f32x4 a, b;
            a[0] = v0[0] * c[0] - v0[1] * s[0]; a[1] = v0[0] * s[0] + v0[1] * c[0]; a[2] = v0[2] * c[1] - v0[3] * s[1]; a[3] = v0[2] * s[1] + v0[3] * c[1];
            b[0] = v1[0] * c[2] - v1[1] * s[2]; b[1] = v1[0] * s[2] + v1[1] * c[2]; b[2] = v1[2] * c[3] - v1[3] * s[3]; b[3] = v1[2] * s[3] + v1[3] * c[3];
            v0 = a; v1 = b;
        }
        u32x4 w; w.x = cvtpk(v0[0] * QSCALE, v0[1] * QSCALE); w.y = cvtpk(v0[2] * QSCALE, v0[3] * QSCALE); w.z = cvtpk(v1[0] * QSCALE, v1[1] * QSCALE); w.w = cvtpk(v1[2] * QSCALE, v1[3] * QSCALE);
        if (!sample) *(u32x4*)(QN + (size_t)row * NQ + col) = w;
        else if (col < 1024) *(u32x4*)(QN + (size_t)row * 1024 + col) = w;
        else { const int m = col - 1024, h = m >> 5; *(u32x4*)(QLAT + ((size_t)row * 16 + h) * DLAT + 256 + (m & 31)) = w; }
    }
};
struct FQL {
    bf16_t* QLAT; int h;
    DI void operator()(int row, int col, f32x4 v0, f32x4 v1) const {
        u32x4 w; w.x = cvtpk(v0[0], v0[1]); w.y = cvtpk(v0[2], v0[3]); w.z = cvtpk(v1[0], v1[1]); w.w = cvtpk(v1[2], v1[3]);
        *(u32x4*)(QLAT + ((size_t)row * 16 + h) * DLAT + col) = w;
    }
};
struct FOS {
    bf16_t* O; int h;
    DI void operator()(int row, int col, f32x4 v0, f32x4 v1) const {
        u32x4 w; w.x = cvtpk(v0[0], v0[1]); w.y = cvtpk(v0[2], v0[3]); w.z = cvtpk(v1[0], v1[1]); w.w = cvtpk(v1[2], v1[3]);
        *(u32x4*)(O + (size_t)row * 1024 + h * 64 + col) = w;
    }
};

template <class SrcF>
DI void transpose_job(char* smem, int K, int Nout, bf16_t* WT, int ldwt, const SrcF& src, int& tile_base, int nw = -1, int me = 0) {
    float* T = (float*)smem;
    const int nkt = K / 64, ntiles = nkt * (Nout / 256), G = nw > 0 ? nw : (int)gridDim.x, tid = ltid();
    const int first = nw > 0 ? (me < 0 ? ntiles : (me - tile_base % G + G) % G) : ((int)blockIdx.x - tile_base % G + G) % G;
    float v[32];
    auto tload = [&](int t) { const int kt = t % nkt, nt = t / nkt; const int n = nt * 256 + (tid & 255), kb = kt * 64 + (tid >> 8);
#pragma unroll
        for (int j = 0; j < 32; ++j) v[j] = src(n, kb + 2 * j); };
    if (first < ntiles) tload(first);
    for (int t = first; t < ntiles; t += G) {
        const int kt = t % nkt, nt = t / nkt;
#pragma unroll
        for (int j = 0; j < 32; ++j) T[((tid >> 8) + 2 * j) * 257 + (tid & 255)] = v[j];
        if (t + G < ntiles) tload(t + G);
        __syncthreads();
#pragma unroll
        for (int i = 0; i < 4; ++i) {
            const int p = tid + 512 * i, nn = p >> 3, kp = (p & 7) * 8;
            u32x4 w;
            w.x = cvtpk(T[(kp + 0) * 257 + nn], T[(kp + 1) * 257 + nn]); w.y = cvtpk(T[(kp + 2) * 257 + nn], T[(kp + 3) * 257 + nn]);
            w.z = cvtpk(T[(kp + 4) * 257 + nn], T[(kp + 5) * 257 + nn]); w.w = cvtpk(T[(kp + 6) * 257 + nn], T[(kp + 7) * 257 + nn]);
            *(u32x4*)(WT + (size_t)(nt * 256 + nn) * ldwt + kt * 64 + kp) = w;
        }
        __syncthreads();
    }
    tile_base += ntiles;
}
struct SrcPlain { const float* W; int N; DI float operator()(int n, int k) const { return W[(size_t)k * N + n]; } };
struct SrcWin { const float* W; DI float operator()(int n, int k) const {
    int oc;
    if (n < 2048) oc = n; else if (n < 3072) oc = n - 2048 + 4096; else if (n < 3584) oc = n - 3072 + 2048; else if (n < 4096) oc = n - 3584 + 2560;
    else if (n < 5120) oc = n - 4096 + 3072; else if (n < IN_AB) oc = n; else oc = -1;
    return oc < 0 ? 0.f : W[(size_t)k * IN_AB + oc]; } };
struct SrcGU { const float* Wg; const float* Wu; DI float operator()(int n, int k) const { const int i = n >> 3, j = n & 7; return j < 4 ? Wg[(size_t)k * DFF + 4 * i + j] : Wu[(size_t)k * DFF + 4 * i + j - 4]; } };
struct SrcInc { const float* W; DI float operator()(int n, int k) const { return n < INC ? W[(size_t)k * INC + n] : 0.f; } };
struct SrcUq { const float* W; DI float operator()(int n, int k) const {
    int oc; if (n < 1024) { oc = (n >> 6) * 96 + (n & 63); } else { const int m = n - 1024, h = m >> 5, i = (m & 31) >> 1, p = m & 1; oc = h * 96 + 64 + p * 16 + i; }
    return W[(size_t)k * NQ + oc]; } };

DI void rms_rows_to_bf16(const float* X, const float* g, bf16_t* U, int nrows) {
    const int tid_ = ltid(); const int lane = tid_ & 63, gw = blockIdx.x * 8 + (tid_ >> 6), GW = gridDim.x * 8;
    f32x4 nx[4], gg4[4];
#pragma unroll
    for (int i = 0; i < 4; ++i) gg4[i] = *(const f32x4*)(g + i * 256 + lane * 4);
    if (gw < nrows) {
#pragma unroll
        for (int i = 0; i < 4; ++i) nx[i] = *(const f32x4*)(X + (size_t)gw * DM + i * 256 + lane * 4); }
    for (int r = gw; r < nrows; r += GW) {
        f32x4 a[4]; float ss = 0.f;
#pragma unroll
        for (int i = 0; i < 4; ++i) { a[i] = nx[i]; ss += a[i][0] * a[i][0] + a[i][1] * a[i][1] + a[i][2] * a[i][2] + a[i][3] * a[i][3]; }
        if (r + GW < nrows) {
#pragma unroll
            for (int i = 0; i < 4; ++i) nx[i] = *(const f32x4*)(X + (size_t)(r + GW) * DM + i * 256 + lane * 4); }
        ss = wave_sum(ss); const float rs = __builtin_amdgcn_rsqf(ss * (1.0f / DM) + EPS);
#pragma unroll
        for (int i = 0; i < 4; ++i) { const f32x4 gg = gg4[i];
            u32x2 w; w.x = cvtpk(a[i][0] * rs * gg[0], a[i][1] * rs * gg[1]); w.y = cvtpk(a[i][2] * rs * gg[2], a[i][3] * rs * gg[3]);
            *(u32x2*)(U + (size_t)r * DM + i * 256 + lane * 4) = w; }
    }
}
template <int HI, int HO>
DI void norm_rows(const bf16_t* Y, const void* Hin_, void* Hout_, const float* gpost, const float* gpre, bf16_t* U, int nrows, int dry = 0) {
    const int tid_ = ltid(); const int lane = tid_ & 63, gw = blockIdx.x * 8 + (tid_ >> 6), GW = gridDim.x * 8;
    u32x4 ry[2], rh[4];
    auto rload = [&](int r) {
#pragma unroll
        for (int i = 0; i < 2; ++i) { const int c = i * 512 + lane * 8;
            ry[i] = *(const u32x4*)(Y + (size_t)r * DM + c);
            if (HI == 0) { rh[2 * i] = *(const u32x4*)((const float*)Hin_ + (size_t)r * DM + c); rh[2 * i + 1] = *(const u32x4*)((const float*)Hin_ + (size_t)r * DM + c + 4); }
            else rh[2 * i] = *(const u32x4*)((const bf16_t*)Hin_ + (size_t)r * DM + c); }
    };
    f32x4 gp[4], gq[4];
#pragma unroll
    for (int i = 0; i < 2; ++i) { const int c = i * 512 + lane * 8; gp[2 * i] = *(const f32x4*)(gpost + c); gp[2 * i + 1] = *(const f32x4*)(gpost + c + 4);
        gq[2 * i] = gpre ? *(const f32x4*)(gpre + c) : (f32x4){0.f, 0.f, 0.f, 0.f}; gq[2 * i + 1] = gpre ? *(const f32x4*)(gpre + c + 4) : (f32x4){0.f, 0.f, 0.f, 0.f}; }
    if (gw < nrows) rload(gw);
    for (int r = gw; r < nrows; r += GW) {
        float y[16], hin[16]; float ss = 0.f;
#pragma unroll
        for (int i = 0; i < 2; ++i) { const u32x4 w = ry[i];
            y[i * 8 + 0] = lo2f(w.x); y[i * 8 + 1] = hi2f(w.x); y[i * 8 + 2] = lo2f(w.y); y[i * 8 + 3] = hi2f(w.y); y[i * 8 + 4] = lo2f(w.z); y[i * 8 + 5] = hi2f(w.z); y[i * 8 + 6] = lo2f(w.w); y[i * 8 + 7] = hi2f(w.w);
            if (HI == 0) { const f32x4 a0 = __builtin_bit_cast(f32x4, rh[2 * i]), a1 = __builtin_bit_cast(f32x4, rh[2 * i + 1]);
#pragma unroll
                for (int j = 0; j < 4; ++j) { hin[i * 8 + j] = a0[j]; hin[i * 8 + 4 + j] = a1[j]; } }
            else { const u32x4 v = rh[2 * i];
                hin[i * 8 + 0] = lo2f(v.x); hin[i * 8 + 1] = hi2f(v.x); hin[i * 8 + 2] = lo2f(v.y); hin[i * 8 + 3] = hi2f(v.y); hin[i * 8 + 4] = lo2f(v.z); hin[i * 8 + 5] = hi2f(v.z); hin[i * 8 + 6] = lo2f(v.w); hin[i * 8 + 7] = hi2f(v.w); }
        }
        if (r + GW < nrows) rload(r + GW);
#pragma unroll
        for (int i = 0; i < 16; ++i) ss += y[i] * y[i];
        ss = wave_sum(ss); const float rs = __builtin_amdgcn_rsqf(ss * (1.0f / DM) + EPS);
        float h[16]; float s2 = 0.f;
#pragma unroll
        for (int i = 0; i < 2; ++i) {
            const int c = i * 512 + lane * 8; const f32x4 g0 = gp[2 * i], g1 = gp[2 * i + 1];
#pragma unroll
            for (int j = 0; j < 4; ++j) { h[i * 8 + j] = hin[i * 8 + j] + y[i * 8 + j] * rs * g0[j]; h[i * 8 + 4 + j] = hin[i * 8 + 4 + j] + y[i * 8 + 4 + j] * rs * g1[j]; }
            if (HO == 1) {
                u32x4 w; w.x = cvtpk(h[i * 8 + 0], h[i * 8 + 1]); w.y = cvtpk(h[i * 8 + 2], h[i * 8 + 3]); w.z = cvtpk(h[i * 8 + 4], h[i * 8 + 5]); w.w = cvtpk(h[i * 8 + 6], h[i * 8 + 7]);
                if (!dry) *(u32x4*)((bf16_t*)Hout_ + (size_t)r * DM + c) = w;
                h[i * 8 + 0] = lo2f(w.x); h[i * 8 + 1] = hi2f(w.x); h[i * 8 + 2] = lo2f(w.y); h[i * 8 + 3] = hi2f(w.y); h[i * 8 + 4] = lo2f(w.z); h[i * 8 + 5] = hi2f(w.z); h[i * 8 + 6] = lo2f(w.w); h[i * 8 + 7] = hi2f(w.w);
            } else if (!dry) {
                *(f32x4*)((float*)Hout_ + (size_t)r * DM + c) = (f32x4){h[i * 8 + 0], h[i * 8 + 1], h[i * 8 + 2], h[i * 8 + 3]};
                *(f32x4*)((float*)Hout_ + (size_t)r * DM + c + 4) = (f32x4){h[i * 8 + 4], h[i * 8 + 5], h[i * 8 + 6], h[i * 8 + 7]};
            }
        }
        if (gpre) {
#pragma unroll
            for (int i = 0; i < 16; ++i) s2 += h[i] * h[i];
            s2 = wave_sum(s2); const float r2 = __builtin_amdgcn_rsqf(s2 * (1.0f / DM) + EPS);
#pragma unroll
            for (int i = 0; i < 2; ++i) { const int c = i * 512 + lane * 8; const f32x4 g0 = gq[2 * i], g1 = gq[2 * i + 1];
                u32x4 w; w.x = cvtpk(h[i * 8 + 0] * r2 * g0[0], h[i * 8 + 1] * r2 * g0[1]); w.y = cvtpk(h[i * 8 + 2] * r2 * g0[2], h[i * 8 + 3] * r2 * g0[3]);
                w.z = cvtpk(h[i * 8 + 4] * r2 * g1[0], h[i * 8 + 5] * r2 * g1[1]); w.w = cvtpk(h[i * 8 + 6] * r2 * g1[2], h[i * 8 + 7] * r2 * g1[3]);
                if (!dry) *(u32x4*)(U + (size_t)r * DM + c) = w; }
        }
    }
}

DI void lru_unit(char* smem, bf16_t* Zb, int L, int n, int half, const float* convw, const float* convb, const bf16_t* WAT, const bf16_t* WXT,
                 const float* ba, const float* bx, const float* lam, const float* conv0  , const float* h0  ,
                 float* conv_out  , float* h_out  , int dry = 0) {
    bf16_t* Xc = (bf16_t*)smem;
    float* SumA = (float*)(smem + 128 * 136 * 2);
    float* SumU = SumA + 256;
    float* Carry = SumU + 256;
    const int tid = ltid(), wid = tid >> 6, lane = tid & 63, r = lane & 31, hh = lane >> 5, tb = wid >> 1, cb = wid & 1;
    const int cl = half * 64 + cb * 32 + r;
    const int cg_ = n * 128 + cl;
    const float b_a = ba[cg_], b_x = bx[cg_], sp = fsoftplus(-lam[cg_]);
    if (tid < 64) Carry[tid] = h0 ? h0[n * 128 + half * 64 + tid] : 0.f;
    if (tid < 192 && !dry) { const int j = tid >> 6, c = n * 128 + half * 64 + (tid & 63); conv_out[j * 1024 + c] = bf2f(Zb[(size_t)(L - 3 + j) * NZ + ZC_XA + c]); }
    const int sc = (tid & 15) * 8, st = (tid >> 4) * 4;
    float cw[4][8], cbias[8];
#pragma unroll
    for (int j = 0; j < 4; ++j)
#pragma unroll
        for (int e = 0; e < 8; ++e) cw[j][e] = convw[j * 1024 + n * 128 + sc + e];
#pragma unroll
    for (int e = 0; e < 8; ++e) cbias[e] = convb[n * 128 + sc + e];
    const int nsteps = (L + 127) / 128;
    for (int step = 0; step < nsteps; ++step) {
        const int t0 = step * 128;
        {
            float xr[7][8];
#pragma unroll
            for (int j = 0; j < 7; ++j) {
                const int t = t0 + st - 3 + j;
                if (t >= 0 && t < L) { const u32x4 w = *(const u32x4*)(Zb + (size_t)t * NZ + ZC_XA + n * 128 + sc);
                    xr[j][0] = lo2f(w.x); xr[j][1] = hi2f(w.x); xr[j][2] = lo2f(w.y); xr[j][3] = hi2f(w.y); xr[j][4] = lo2f(w.z); xr[j][5] = hi2f(w.z); xr[j][6] = lo2f(w.w); xr[j][7] = hi2f(w.w); }
                else if (t < 0 && conv0) {
#pragma unroll
                    for (int e = 0; e < 8; ++e) xr[j][e] = conv0[(3 + t) * 1024 + n * 128 + sc + e]; }
                else {
#pragma unroll
                    for (int e = 0; e < 8; ++e) xr[j][e] = 0.f; }
            }
#pragma unroll
            for (int q = 0; q < 4; ++q) {
                float o[8];
#pragma unroll
                for (int e = 0; e < 8; ++e) o[e] = cbias[e] + cw[0][e] * xr[q][e] + cw[1][e] * xr[q + 1][e] + cw[2][e] * xr[q + 2][e] + cw[3][e] * xr[q + 3][e];
                u32x4 w; w.x = cvtpk(o[0], o[1]); w.y = cvtpk(o[2], o[3]); w.z = cvtpk(o[4], o[5]); w.w = cvtpk(o[6], o[7]);
                *(u32x4*)(Xc + (st + q) * 136 + sc) = w;
            }
        }
        __syncthreads();
        f32x16 accr = zero16(), acci = zero16();
#pragma unroll
        for (int ks = 0; ks < 8; ++ks) {
            const bf16x8 a = ld8(Xc + (tb * 32 + r) * 136 + ks * 16 + hh * 8);
            const bf16x8 wa = ld8(WAT + ((size_t)n * 128 + cl) * 128 + ks * 16 + hh * 8), wx = ld8(WXT + ((size_t)n * 128 + cl) * 128 + ks * 16 + hh * 8);
            accr = MFMA32(a, wa, accr); acci = MFMA32(a, wx, acci);
        }
        float av[16], uv[16];
#pragma unroll
        for (int i = 0; i < 16; ++i) {
            const int tl = tb * 32 + crow(i, hh);
            const float xf = bf2f(Xc[tl * 136 + cl]);
            const float rg = fsigmoid(accr[i] + b_a), ig = fsigmoid(acci[i] + b_x);
            const float la = -8.0f * rg * sp;
            float a = fexp(la), u = __builtin_sqrtf(neg_expm1(2.0f * la)) * (ig * xf);
            if (t0 + tl >= L) { a = 1.f; u = 0.f; }
            av[i] = a; uv[i] = u;
        }
        float PA[4], PU[4];
#pragma unroll
        for (int g = 0; g < 4; ++g) {
            float A = av[4 * g], U = uv[4 * g];
#pragma unroll
            for (int k = 1; k < 4; ++k) { U = av[4 * g + k] * U + uv[4 * g + k]; A *= av[4 * g + k]; uv[4 * g + k] = U; av[4 * g + k] = A; }
            PA[g] = A; PU[g] = U;
        }
        float QA[4], QU[4];
#pragma unroll
        for (int g = 0; g < 4; ++g) { QA[g] = __shfl_xor(PA[g], 32, 64); QU[g] = __shfl_xor(PU[g], 32, 64); }
        float CA = 1.f, CU = 0.f;
#pragma unroll
        for (int g = 0; g < 4; ++g) {
            const float A0 = hh == 0 ? PA[g] : QA[g], U0 = hh == 0 ? PU[g] : QU[g], A1 = hh == 0 ? QA[g] : PA[g], U1 = hh == 0 ? QU[g] : PU[g];
            CU = A0 * CU + U0; CA = A0 * CA;
            CU = A1 * CU + U1; CA = A1 * CA;
        }
        if (hh == 0) { SumA[tb * 64 + cb * 32 + r] = CA; SumU[tb * 64 + cb * 32 + r] = CU; }
        __syncthreads();
        float carry = Carry[(step & 1) * 64 + cb * 32 + r];
        for (int j = 0; j < tb; ++j) carry = SumA[j * 64 + cb * 32 + r] * carry + SumU[j * 64 + cb * 32 + r];
        float hcur = carry;
#pragma unroll
        for (int g = 0; g < 4; ++g) {
            float my_in;
            if (hh == 0) { my_in = hcur; hcur = PA[g] * hcur + PU[g]; hcur = QA[g] * hcur + QU[g]; }
            else { hcur = QA[g] * hcur + QU[g]; my_in = hcur; hcur = PA[g] * hcur + PU[g]; }
#pragma unroll
            for (int k = 0; k < 4; ++k) {
                const int i = 4 * g + k, tl = tb * 32 + crow(i, hh), t = t0 + tl;
                const float hv = uv[i] + av[i] * my_in;
                if (t < L && !dry) { bf16_t* p = Zb + (size_t)t * NZ + ZC_GA + cg_; *p = f2bf(hv * bf2f(*p)); }
            }
        }
        if (tb == 3 && hh == 0) { Carry[((step + 1) & 1) * 64 + cb * 32 + r] = hcur; if (step == nsteps - 1 && !dry) h_out[cg_] = hcur; }
        __syncthreads();
    }
}

DI void gla_unit(char* smem, bf16_t* Zb, int L, int hd, const float* wgate  , const float* bgate  , const float* gnorm  ,
                 const float* S0  , float* Sout  , int dry = 0) {
    float* BL = (float*)smem;
    bf16_t* Qs = (bf16_t*)(smem + 32768);
    bf16_t* Ks = Qs + 64 * 136;
    bf16_t* KTs = Ks + 64 * 136;
    bf16_t* VTs = KTs + 128 * 72;
    bf16_t* As = VTs + 256 * 72;
    float* ZRs = (float*)(As + 64 * 72);
    float* Seg = ZRs + 64 * 16;
    float* Dec = Seg + 512;
    float* SSq = Dec + 128;
    const int tid = ltid(), wid = tid >> 6, lane = tid & 63, r = lane & 31, hh = lane >> 5;
    f32x16 S[4];
#pragma unroll
    for (int d = 0; d < 4; ++d)
#pragma unroll
        for (int i = 0; i < 16; ++i) S[d][i] = S0 ? S0[(size_t)(32 * d + crow(i, hh)) * 256 + 32 * wid + r] : 0.f;
    const int gdk = tid & 127, gseg = tid >> 7;
    const float gn = gnorm[32 * wid + r];
    const int nch = (L + 63) / 64;
    for (int ch = 0; ch < nch; ++ch) {
        const int t0 = ch * 64;
        for (int e = tid; e < 64 * 16; e += 512) { const int t = e >> 4, j = e & 15; ZRs[e] = (t0 + t < L) ? bf2f(Zb[(size_t)(t0 + t) * NZ + ZC_ZR + j]) : 0.f; }
        __syncthreads();
        {
            float wg[16];
#pragma unroll
            for (int j = 0; j < 16; ++j) wg[j] = wgate[j * 512 + hd * 128 + gdk];
            const float bg = bgate[hd * 128 + gdk];
            float run = 0.f;
#pragma unroll 4
            for (int tt = 0; tt < 16; ++tt) {
                const int t = gseg * 16 + tt;
                float z = bg;
#pragma unroll
                for (int j = 0; j < 16; ++j) z += ZRs[t * 16 + j] * wg[j];
                const float lg = (t0 + t < L) ? -fsoftplus(-z) * (1.0f / 16.0f) : 0.f;
                run += lg; BL[t * 128 + gdk] = run;
            }
            Seg[gseg * 128 + gdk] = run;
        }
        __syncthreads();
        if (tid < 128) { const float s0 = Seg[tid], s1 = Seg[128 + tid], s2 = Seg[256 + tid], s3 = Seg[384 + tid]; Dec[tid] = fexp(s0 + s1 + s2 + s3); }
        {
            const int t = tid >> 3, d0 = (tid & 7) * 16, sg = t >> 4;
            const bool valid = (t0 + t) < L;
#pragma unroll 1
            for (int half8 = 0; half8 < 2; ++half8) {
                const int dk = d0 + half8 * 8;
                u32x4 qw = (u32x4){0, 0, 0, 0}, kw = qw;
                if (valid) { qw = *(const u32x4*)(Zb + (size_t)(t0 + t) * NZ + ZC_Q + hd * 128 + dk); kw = *(const u32x4*)(Zb + (size_t)(t0 + t) * NZ + ZC_K + hd * 128 + dk); }
                float q[8] = {lo2f(qw.x), hi2f(qw.x), lo2f(qw.y), hi2f(qw.y), lo2f(qw.z), hi2f(qw.z), lo2f(qw.w), hi2f(qw.w)};
                float k[8] = {lo2f(kw.x), hi2f(kw.x), lo2f(kw.y), hi2f(kw.y), lo2f(kw.z), hi2f(kw.z), lo2f(kw.w), hi2f(kw.w)};
                float qt[8], kt[8];
#pragma unroll
                for (int e = 0; e < 8; ++e) {
                    float off = 0.f, tot = 0.f;
#pragma unroll
                    for (int s = 0; s < 4; ++s) { const float sv = Seg[s * 128 + dk + e]; tot += sv; if (s < sg) off += sv; }
                    const float b = BL[t * 128 + dk + e] + off;
                    qt[e] = q[e] * fexp(b) * 0.08838834764831845f; kt[e] = k[e] * fexp(-b);
                    KTs[(dk + e) * 72 + t] = f2bf(k[e] * fexp(tot - b));
                }
                u32x4 w; w.x = cvtpk(qt[0], qt[1]); w.y = cvtpk(qt[2], qt[3]); w.z = cvtpk(qt[4], qt[5]); w.w = cvtpk(qt[6], qt[7]);
                *(u32x4*)(Qs + t * 136 + dk) = w;
                w.x = cvtpk(kt[0], kt[1]); w.y = cvtpk(kt[2], kt[3]); w.z = cvtpk(kt[4], kt[5]); w.w = cvtpk(kt[6], kt[7]);
                *(u32x4*)(Ks + t * 136 + dk) = w;
            }
        }
#pragma unroll 1
        for (int it = 0; it < 4; ++it) {
            const int p = tid + 512 * it, t = p >> 5, dv = (p & 31) * 8;
            u32x4 vw = (u32x4){0, 0, 0, 0};
            if (t0 + t < L) vw = *(const u32x4*)(Zb + (size_t)(t0 + t) * NZ + ZC_V + hd * 256 + dv);
            VTs[(dv + 0) * 72 + t] = (bf16_t)(vw.x & 0xffff); VTs[(dv + 1) * 72 + t] = (bf16_t)(vw.x >> 16); VTs[(dv + 2) * 72 + t] = (bf16_t)(vw.y & 0xffff); VTs[(dv + 3) * 72 + t] = (bf16_t)(vw.y >> 16);
            VTs[(dv + 4) * 72 + t] = (bf16_t)(vw.z & 0xffff); VTs[(dv + 5) * 72 + t] = (bf16_t)(vw.z >> 16); VTs[(dv + 6) * 72 + t] = (bf16_t)(vw.w & 0xffff); VTs[(dv + 7) * 72 + t] = (bf16_t)(vw.w >> 16);
        }
        __syncthreads();
        if (wid < 4) {
            const int tbk = wid >> 1, sbk = wid & 1;
            f32x16 a = zero16();
            if (tbk >= sbk) {
#pragma unroll
                for (int ks = 0; ks < 8; ++ks) a = MFMA32(ld8(Qs + (tbk * 32 + r) * 136 + ks * 16 + hh * 8), ld8(Ks + (sbk * 32 + r) * 136 + ks * 16 + hh * 8), a);
            }
#pragma unroll
            for (int i = 0; i < 16; ++i) { const int t = tbk * 32 + crow(i, hh), s = sbk * 32 + r; As[t * 72 + s] = f2bf(s <= t ? a[i] : 0.f); }
        }
        f32x16 o[2]; o[0] = zero16(); o[1] = zero16();
#pragma unroll
        for (int d = 0; d < 4; ++d)
#pragma unroll
            for (int s = 0; s < 2; ++s) {
                const bf16x8 bS = pack8(S[d], s);
#pragma unroll
                for (int tbk = 0; tbk < 2; ++tbk) {
                    const bf16_t* qp = Qs + (tbk * 32 + r) * 136 + d * 32 + 16 * s + 4 * hh;
                    o[tbk] = MFMA32(cat44(qp, qp + 8), bS, o[tbk]);
                }
            }
        __syncthreads();
#pragma unroll
        for (int ks = 0; ks < 4; ++ks) {
            const bf16x8 bv = ld8(VTs + (wid * 32 + r) * 72 + ks * 16 + hh * 8);
#pragma unroll
            for (int tbk = 0; tbk < 2; ++tbk) o[tbk] = MFMA32(ld8(As + (tbk * 32 + r) * 72 + ks * 16 + hh * 8), bv, o[tbk]);
        }
#pragma unroll
        for (int d = 0; d < 4; ++d)
#pragma unroll
            for (int i = 0; i < 16; ++i) S[d][i] *= Dec[32 * d + crow(i, hh)];
#pragma unroll
        for (int ks = 0; ks < 4; ++ks) {
            const bf16x8 bv = ld8(VTs + (wid * 32 + r) * 72 + ks * 16 + hh * 8);
#pragma unroll
            for (int d = 0; d < 4; ++d) S[d] = MFMA32(ld8(KTs + (d * 32 + r) * 72 + ks * 16 + hh * 8), bv, S[d]);
        }
#pragma unroll
        for (int tbk = 0; tbk < 2; ++tbk)
#pragma unroll
            for (int i = 0; i < 16; ++i) {
                float v = o[tbk][i] * o[tbk][i];
                v += __shfl_xor(v, 1, 64); v += __shfl_xor(v, 2, 64); v += __shfl_xor(v, 4, 64); v += __shfl_xor(v, 8, 64); v += __shfl_xor(v, 16, 64);
                if (r == 0) SSq[wid * 64 + tbk * 32 + crow(i, hh)] = v;
            }
        __syncthreads();
#pragma unroll
        for (int tbk = 0; tbk < 2; ++tbk)
#pragma unroll
            for (int i = 0; i < 16; ++i) {
                const int tl = tbk * 32 + crow(i, hh), t = t0 + tl;
                float ss = 0.f;
#pragma unroll
                for (int w = 0; w < 8; ++w) ss += SSq[w * 64 + tl];
                const float rs = __builtin_amdgcn_rsqf(ss * (1.0f / 256.0f) + EPS);
                if (t < L && !dry) { bf16_t* p = Zb + (size_t)t * NZ + ZC_GB + hd * 256 + 32 * wid + r; *p = f2bf(o[tbk][i] * rs * gn * bf2f(*p)); }
            }
        __syncthreads();
    }
#pragma unroll
    for (int d = 0; d < 4; ++d)
#pragma unroll
        for (int i = 0; i < 16; ++i) if (!dry) Sout[(size_t)(32 * d + crow(i, hh)) * 256 + 32 * wid + r] = S[d][i];
}


DI void gla_pre_unit(char* smem, bf16_t* Zc, int hd, const float* wgate, const float* bgate, bf16_t* OIc, float* decp, int dry = 0) {
    float* BL = (float*)smem;
    bf16_t* Qs = (bf16_t*)(smem + 33792);
    bf16_t* Ks = Qs + 64 * 136;
    bf16_t* KTs = Ks + 64 * 136;
    bf16_t* VTs = KTs + 128 * 72;
    bf16_t* As = VTs + 256 * 72;
    float* ZRs = (float*)(As + 64 * 72);
    float* Seg = ZRs + 64 * 16;
    float* Pre = Seg + 512;
    float* Tot = Pre + 512;
    const int tid = ltid(), wid = tid >> 6, lane = tid & 63, r = lane & 31, hh = lane >> 5;
    const int gdk = tid & 127, gseg = tid >> 7;
    float wg[16];
#pragma unroll
    for (int j = 0; j < 16; ++j) wg[j] = wgate[j * 512 + hd * 128 + gdk];
    const float bg = bgate[hd * 128 + gdk];
    u32x4 gq[2], gk[2], gvv[4];
    { const int t = tid >> 3, d0 = (tid & 7) * 16;
#pragma unroll
      for (int h8 = 0; h8 < 2; ++h8) { gq[h8] = *(const u32x4*)(Zc + (size_t)t * NZ + ZC_Q + hd * 128 + d0 + h8 * 8); gk[h8] = *(const u32x4*)(Zc + (size_t)t * NZ + ZC_K + hd * 128 + d0 + h8 * 8); }
#pragma unroll
      for (int it = 0; it < 4; ++it) { const int p = tid + 512 * it; gvv[it] = *(const u32x4*)(Zc + (size_t)(p >> 5) * NZ + ZC_V + hd * 256 + (p & 31) * 8); } }
    for (int e = tid; e < 64 * 16; e += 512) { const int t = e >> 4, j = e & 15; ZRs[e] = bf2f(Zc[(size_t)t * NZ + ZC_ZR + j]); }
    __syncthreads();
    {
        float run = 0.f;
#pragma unroll 4
        for (int tt = 0; tt < 16; ++tt) {
            const int t = gseg * 16 + tt;
            float z = bg;
#pragma unroll
            for (int j4 = 0; j4 < 4; ++j4) { const f32x4 zz = *(const f32x4*)(ZRs + t * 16 + j4 * 4); z += zz[0] * wg[j4 * 4] + zz[1] * wg[j4 * 4 + 1] + zz[2] * wg[j4 * 4 + 2] + zz[3] * wg[j4 * 4 + 3]; }
            run += -fsoftplus(-z) * (1.0f / 16.0f); BL[t * 132 + gdk] = run;
        }
        Seg[gseg * 128 + gdk] = run;
    }
    __syncthreads();
    if (tid < 128) { const float s0 = Seg[tid], s1 = Seg[128 + tid], s2 = Seg[256 + tid], s3 = Seg[384 + tid];
        Pre[tid] = 0.f; Pre[128 + tid] = s0; Pre[256 + tid] = s0 + s1; Pre[384 + tid] = s0 + s1 + s2; Tot[tid] = s0 + s1 + s2 + s3; decp[tid] = fexp(s0 + s1 + s2 + s3); }
    __syncthreads();
    {
        const int t = tid >> 3, d0 = (tid & 7) * 16, sg = t >> 4;
#pragma unroll
        for (int half8 = 0; half8 < 2; ++half8) {
            const int dk = d0 + half8 * 8;
            const u32x4 qw = gq[half8], kw = gk[half8];
            float q[8] = {lo2f(qw.x), hi2f(qw.x), lo2f(qw.y), hi2f(qw.y), lo2f(qw.z), hi2f(qw.z), lo2f(qw.w), hi2f(qw.w)};
            float k[8] = {lo2f(kw.x), hi2f(kw.x), lo2f(kw.y), hi2f(kw.y), lo2f(kw.z), hi2f(kw.z), lo2f(kw.w), hi2f(kw.w)};
            float qt[8], kt[8];
            const f32x4 bl0 = *(const f32x4*)(BL + t * 132 + dk), bl1 = *(const f32x4*)(BL + t * 132 + dk + 4), pr0 = *(const f32x4*)(Pre + sg * 128 + dk), pr1 = *(const f32x4*)(Pre + sg * 128 + dk + 4);
            const f32x4 to0 = *(const f32x4*)(Tot + dk), to1 = *(const f32x4*)(Tot + dk + 4);
            const int kcol = (((t >> 3) ^ ((dk >> 3) & 7)) << 3) + (t & 7);
#pragma unroll
            for (int e = 0; e < 8; ++e) {
                const float b = (e < 4 ? bl0[e & 3] + pr0[e & 3] : bl1[e & 3] + pr1[e & 3]), tot = (e < 4 ? to0[e & 3] : to1[e & 3]);
                qt[e] = q[e] * fexp(b) * 0.08838834764831845f; kt[e] = k[e] * fexp(-b);
                KTs[(dk + e) * 72 + kcol] = f2bf(k[e] * fexp(tot - b));
            }
            u32x4 w; w.x = cvtpk(qt[0], qt[1]); w.y = cvtpk(qt[2], qt[3]); w.z = cvtpk(qt[4], qt[5]); w.w = cvtpk(qt[6], qt[7]);
            *(u32x4*)(Qs + t * 136 + dk) = w;
            w.x = cvtpk(kt[0], kt[1]); w.y = cvtpk(kt[2], kt[3]); w.z = cvtpk(kt[4], kt[5]); w.w = cvtpk(kt[6], kt[7]);
            *(u32x4*)(Ks + t * 136 + dk) = w;
        }
    }
#pragma unroll
    for (int it = 0; it < 4; ++it) {
        const int p = tid + 512 * it, t = p >> 5, dv = (p & 31) * 8;
        const u32x4 vw = gvv[it];
        const int vcol = (((t >> 3) ^ ((dv >> 3) & 7)) << 3) + (t & 7);
        VTs[(dv + 0) * 72 + vcol] = (bf16_t)(vw.x & 0xffff); VTs[(dv + 1) * 72 + vcol] = (bf16_t)(vw.x >> 16); VTs[(dv + 2) * 72 + vcol] = (bf16_t)(vw.y & 0xffff); VTs[(dv + 3) * 72 + vcol] = (bf16_t)(vw.y >> 16);
        VTs[(dv + 4) * 72 + vcol] = (bf16_t)(vw.z & 0xffff); VTs[(dv + 5) * 72 + vcol] = (bf16_t)(vw.z >> 16); VTs[(dv + 6) * 72 + vcol] = (bf16_t)(vw.w & 0xffff); VTs[(dv + 7) * 72 + vcol] = (bf16_t)(vw.w >> 16);
    }
    __syncthreads();
    if (wid < 4) {
        const int tbk = wid >> 1, sbk = wid & 1;
        f32x16 a = zero16();
        if (tbk >= sbk) {
#pragma unroll
            for (int ks = 0; ks < 8; ++ks) a = MFMA32(ld8(Qs + (tbk * 32 + r) * 136 + ks * 16 + hh * 8), ld8(Ks + (sbk * 32 + r) * 136 + ks * 16 + hh * 8), a);
        }
#pragma unroll
        for (int i = 0; i < 16; ++i) { const int t = tbk * 32 + crow(i, hh), s2 = sbk * 32 + r; As[t * 72 + s2] = f2bf(s2 <= t ? a[i] : 0.f); }
    }
    if (!dry) {
#pragma unroll
    for (int it = 0; it < 2; ++it) { const int p = tid + 512 * it;
        { const int t = p >> 4, pc = p & 15; *(u32x4*)(Zc + (size_t)t * NZ + ZC_Q + hd * 128 + pc * 8) = *(const u32x4*)(Qs + t * 136 + pc * 8); }
        { const int dk = p >> 3, tp = p & 7, idx = dk * 64 + tp * 8; *(u32x4*)(Zc + (size_t)(idx >> 7) * NZ + ZC_K + hd * 128 + (idx & 127)) = *(const u32x4*)(KTs + dk * 72 + ((tp ^ ((dk >> 3) & 7)) << 3)); } }
#pragma unroll
    for (int it = 0; it < 4; ++it) { const int p = tid + 512 * it, dv = p >> 3, tp = p & 7, idx = dv * 64 + tp * 8;
        *(u32x4*)(Zc + (size_t)(idx >> 8) * NZ + ZC_V + hd * 256 + (idx & 255)) = *(const u32x4*)(VTs + dv * 72 + ((tp ^ ((dv >> 3) & 7)) << 3)); }
    }
    __syncthreads();
    f32x16 o[2]; o[0] = zero16(); o[1] = zero16();
#pragma unroll
    for (int ks = 0; ks < 4; ++ks) {
        const int dvr = wid * 32 + r; const bf16x8 bv = ld8(VTs + dvr * 72 + (((ks * 2 + hh) ^ ((dvr >> 3) & 7)) << 3));
#pragma unroll
        for (int tbk = 0; tbk < 2; ++tbk) o[tbk] = MFMA32(ld8(As + (tbk * 32 + r) * 72 + ks * 16 + hh * 8), bv, o[tbk]);
    }
    {
        bf16_t* op = OIc + ((size_t)wid * 64 + lane) * 32;
#pragma unroll
        for (int tbk = 0; tbk < 2; ++tbk)
#pragma unroll
            for (int g = 0; g < 2; ++g) { u32x4 w; w.x = cvtpk(o[tbk][8 * g], o[tbk][8 * g + 1]); w.y = cvtpk(o[tbk][8 * g + 2], o[tbk][8 * g + 3]); w.z = cvtpk(o[tbk][8 * g + 4], o[tbk][8 * g + 5]); w.w = cvtpk(o[tbk][8 * g + 6], o[tbk][8 * g + 7]);
                if (!dry) *(u32x4*)(op + tbk * 16 + g * 8) = w; }
    }
    __syncthreads();
}

DI void gla_seq_unit(char* smem, const bf16_t* Zb, int hd, bf16_t* OIb  , const float* DECb, float* Sout, int dry = 0) {
    constexpr int SEQBUF = 64 * 136 + 128 * 72 + 256 * 72;
    bf16_t* Qt = (bf16_t*)smem;
    bf16_t* KTt = Qt + 64 * 136;
    bf16_t* VTt = KTt + 128 * 72;
    float* Dec = (float*)(Qt + 2 * SEQBUF);
    const int tid = ltid(), wid = tid >> 6, lane = tid & 63, r = lane & 31, hh = lane >> 5;
    f32x16 S[4];
#pragma unroll
    for (int d = 0; d < 4; ++d) S[d] = zero16();
    u32x4 pq[2], pk[2], pv[4]; float pd = 0.f;
    auto gload = [&](int ch) {
        const bf16_t* Zc = Zb + (size_t)ch * 64 * NZ;
#pragma unroll
        for (int it = 0; it < 2; ++it) { const int p = tid + 512 * it, row = p >> 4, col = (p & 15) * 8;
            pq[it] = *(const u32x4*)(Zc + (size_t)row * NZ + ZC_Q + hd * 128 + col); pk[it] = *(const u32x4*)(Zc + (size_t)row * NZ + ZC_K + hd * 128 + col); }
#pragma unroll
        for (int it = 0; it < 4; ++it) { const int p = tid + 512 * it, row = p >> 5, col = (p & 31) * 8; pv[it] = *(const u32x4*)(Zc + (size_t)row * NZ + ZC_V + hd * 256 + col); }
        if (tid < 128) pd = DECb[ch * 128 + tid];
    };
    auto lstore = [&](int bsel) {
        const int bo = bsel * SEQBUF;
#pragma unroll
        for (int it = 0; it < 2; ++it) { const int p = tid + 512 * it;
            *(u32x4*)(Qt + bo + (p >> 4) * 136 + (p & 15) * 8) = pq[it];
            *(u32x4*)(KTt + bo + (p >> 3) * 72 + (p & 7) * 8) = pk[it]; }
#pragma unroll
        for (int it = 0; it < 4; ++it) { const int p = tid + 512 * it; *(u32x4*)(VTt + bo + (p >> 3) * 72 + (p & 7) * 8) = pv[it]; }
        if (tid < 128) Dec[bsel * 128 + tid] = pd;
    };
    gload(0); lstore(0);
    if (SEQ / 64 > 1) gload(1);
    __syncthreads();
    for (int ch = 0; ch < SEQ / 64; ++ch) {
        const int bo = (ch & 1) * SEQBUF;
        bf16_t* op = OIb + (((size_t)ch * 8 + wid) * 64 + lane) * 32;
        u32x4 oi[4];
#pragma unroll
        for (int g = 0; g < 4; ++g) oi[g] = *(const u32x4*)(op + g * 8);
        f32x16 o[2], o2[2]; o[0] = zero16(); o[1] = zero16(); o2[0] = zero16(); o2[1] = zero16();
#pragma unroll
        for (int d = 0; d < 4; ++d)
#pragma unroll
            for (int s = 0; s < 2; ++s) {
                const bf16x8 bS = pack8(S[d], s);
#pragma unroll
                for (int tbk = 0; tbk < 2; ++tbk) { const bf16_t* qp = Qt + bo + (tbk * 32 + r) * 136 + d * 32 + 16 * s + 4 * hh;
                    if (d < 2) o[tbk] = MFMA32(cat44(qp, qp + 8), bS, o[tbk]); else o2[tbk] = MFMA32(cat44(qp, qp + 8), bS, o2[tbk]); }
            }
        o[0] = o[0] + o2[0]; o[1] = o[1] + o2[1];
#pragma unroll
        for (int d = 0; d < 4; ++d)
#pragma unroll
            for (int g = 0; g < 4; ++g) { const f32x4 dv4 = *(const f32x4*)(Dec + (ch & 1) * 128 + 32 * d + 8 * g + 4 * hh);
                S[d][4 * g] *= dv4[0]; S[d][4 * g + 1] *= dv4[1]; S[d][4 * g + 2] *= dv4[2]; S[d][4 * g + 3] *= dv4[3]; }
#pragma unroll
        for (int ks = 0; ks < 4; ++ks) {
            const bf16x8 bv = ld8(VTt + bo + (wid * 32 + r) * 72 + ks * 16 + hh * 8);
#pragma unroll
            for (int d = 0; d < 4; ++d) S[d] = MFMA32(ld8(KTt + bo + (d * 32 + r) * 72 + ks * 16 + hh * 8), bv, S[d]);
        }
#pragma unroll
        for (int g = 0; g < 4; ++g) { const int tbk = g >> 1, i0 = (g & 1) * 8; const unsigned ou[4] = {oi[g].x, oi[g].y, oi[g].z, oi[g].w}; u32x4 w;
            w.x = cvtpk(o[tbk][i0 + 0] + lo2f(ou[0]), o[tbk][i0 + 1] + hi2f(ou[0])); w.y = cvtpk(o[tbk][i0 + 2] + lo2f(ou[1]), o[tbk][i0 + 3] + hi2f(ou[1]));
            w.z = cvtpk(o[tbk][i0 + 4] + lo2f(ou[2]), o[tbk][i0 + 5] + hi2f(ou[2])); w.w = cvtpk(o[tbk][i0 + 6] + lo2f(ou[3]), o[tbk][i0 + 7] + hi2f(ou[3]));
            if (!dry) *(u32x4*)(op + g * 8) = w; }
        if (ch + 1 < SEQ / 64) lstore((ch + 1) & 1);
        if (ch + 2 < SEQ / 64) gload(ch + 2);
        __syncthreads();
    }
#pragma unroll
    for (int d = 0; d < 4; ++d)
#pragma unroll
        for (int i = 0; i < 16; ++i) Sout[(size_t)(32 * d + crow(i, hh)) * 256 + 32 * wid + r] = S[d][i];
}
DI void gla_post_unit(char* smem, bf16_t* Zc, int hd, const bf16_t* OIc, const float* gnorm, int dry = 0) {
    float* SSq = (float*)smem;
    float* RS = SSq + 512;
    const int tid = ltid(), wid = tid >> 6, lane = tid & 63, r = lane & 31, hh = lane >> 5;
    const float gn = gnorm[32 * wid + r];
    float o[32];
    const bf16_t* op = OIc + ((size_t)wid * 64 + lane) * 32;
#pragma unroll
    for (int g = 0; g < 4; ++g) { const u32x4 w = *(const u32x4*)(op + g * 8);
        o[g * 8 + 0] = lo2f(w.x); o[g * 8 + 1] = hi2f(w.x); o[g * 8 + 2] = lo2f(w.y); o[g * 8 + 3] = hi2f(w.y); o[g * 8 + 4] = lo2f(w.z); o[g * 8 + 5] = hi2f(w.z); o[g * 8 + 6] = lo2f(w.w); o[g * 8 + 7] = hi2f(w.w); }
    bf16_t gv[32];
#pragma unroll
    for (int e = 0; e < 32; ++e) gv[e] = Zc[(size_t)((e >> 4) * 32 + crow(e & 15, hh)) * NZ + ZC_GB + hd * 256 + 32 * wid + r];
    float v[32];
#pragma unroll
    for (int e = 0; e < 32; ++e) v[e] = o[e] * o[e];
#pragma unroll
    for (int k = 0; k < 16; ++k) { const bool up = (r & 16) != 0; const float keep = up ? v[16 + k] : v[k], send = up ? v[k] : v[16 + k]; v[k] = keep + __shfl_xor(send, 16, 64); }
#pragma unroll
    for (int k = 0; k < 8; ++k) { const bool up = (r & 8) != 0; const float keep = up ? v[8 + k] : v[k], send = up ? v[k] : v[8 + k]; v[k] = keep + __shfl_xor(send, 8, 64); }
#pragma unroll
    for (int k = 0; k < 4; ++k) { const bool up = (r & 4) != 0; const float keep = up ? v[4 + k] : v[k], send = up ? v[k] : v[4 + k]; v[k] = keep + __shfl_xor(send, 4, 64); }
#pragma unroll
    for (int k = 0; k < 2; ++k) { const bool up = (r & 2) != 0; const float keep = up ? v[2 + k] : v[k], send = up ? v[k] : v[2 + k]; v[k] = keep + __shfl_xor(send, 2, 64); }
    { const bool up = (r & 1) != 0; const float keep = up ? v[1] : v[0], send = up ? v[0] : v[1]; v[0] = keep + __shfl_xor(send, 1, 64); }
    SSq[wid * 64 + (r >> 4) * 32 + crow(r & 15, hh)] = v[0];
    __syncthreads();
    if (tid < 64) { float ss = 0.f;
#pragma unroll
        for (int w = 0; w < 8; ++w) ss += SSq[w * 64 + tid];
        RS[tid] = __builtin_amdgcn_rsqf(ss * (1.0f / 256.0f) + EPS); }
    __syncthreads();
#pragma unroll
    for (int e = 0; e < 32; ++e) {
        const int tl = (e >> 4) * 32 + crow(e & 15, hh);
        bf16_t* p = Zc + (size_t)tl * NZ + ZC_GB + hd * 256 + 32 * wid + r; const float v_ = o[e] * RS[tl] * gn * bf2f(gv[e]); if (!dry) *p = f2bf(v_);
    }
    __syncthreads();
}

DI void lru_pre_multi(char* smem, const bf16_t* Z, int idx0, int cnt, int n, int half, const float* convw, const float* convb, const bf16_t* WAT, const bf16_t* WXT,
                      const float* ba, const float* bx, const float* lam, bf16_t* HL, bf16_t* AC, float* TA, float* TU, float* conv_all) {
    bf16_t* Xc = (bf16_t*)smem;
    float* SumA = (float*)(smem + 128 * 136 * 2);
    float* SumU = SumA + 256;
    const int tid = ltid(), wid = tid >> 6, lane = tid & 63, r = lane & 31, hh = lane >> 5, tb = wid >> 1, cb = wid & 1;
    const int cl = half * 64 + cb * 32 + r, cg_ = n * 128 + cl;
    const float b_a = ba[cg_], b_x = bx[cg_], sp = fsoftplus(-lam[cg_]);
    bf16x8 wa[8], wx[8];
#pragma unroll
    for (int ks = 0; ks < 8; ++ks) { wa[ks] = ld8(WAT + ((size_t)n * 128 + cl) * 128 + ks * 16 + hh * 8); wx[ks] = ld8(WXT + ((size_t)n * 128 + cl) * 128 + ks * 16 + hh * 8); }
    const int sc = (tid & 15) * 8, st = (tid >> 4) * 4;
    float cw[4][8], cbias[8];
#pragma unroll
    for (int j = 0; j < 4; ++j) { const f32x4 w0 = *(const f32x4*)(convw + j * 1024 + n * 128 + sc), w1 = *(const f32x4*)(convw + j * 1024 + n * 128 + sc + 4);
#pragma unroll
        for (int e = 0; e < 4; ++e) { cw[j][e] = w0[e]; cw[j][4 + e] = w1[e]; } }
    { const f32x4 w0 = *(const f32x4*)(convb + n * 128 + sc), w1 = *(const f32x4*)(convb + n * 128 + sc + 4);
#pragma unroll
        for (int e = 0; e < 4; ++e) { cbias[e] = w0[e]; cbias[4 + e] = w1[e]; } }
    u32x4 xw[7];
    auto xload = [&](int idx_) { const int bb_ = idx_ >> 4, t0_ = (idx_ & 15) * 128; const bf16_t* Zb_ = Z + (size_t)bb_ * SEQ * NZ;
#pragma unroll
        for (int j = 0; j < 7; ++j) { const int t = t0_ + st - 3 + j; xw[j] = (u32x4){0u, 0u, 0u, 0u}; if (t >= 0) xw[j] = *(const u32x4*)(Zb_ + (size_t)t * NZ + ZC_XA + n * 128 + sc); } };
    xload(idx0);
    for (int kk = 0; kk < cnt; ++kk) {
    const int idx = idx0 + kk, bb = idx >> 4, step = idx & 15;
    const bf16_t* Zb = Z + (size_t)bb * SEQ * NZ; bf16_t* HLb = HL + (size_t)bb * SEQ * 1024; bf16_t* ACb = AC + (size_t)bb * SEQ * 1024;
    float* TAp = TA + (size_t)idx * 1024; float* TUp = TU + (size_t)idx * 1024; float* conv_out = step == 15 ? conv_all + (size_t)bb * 3 * 1024 : nullptr;
    const int t0 = step * 128;
    if (conv_out && tid < 192) { const int j = tid >> 6, c = n * 128 + half * 64 + (tid & 63); conv_out[j * 1024 + c] = bf2f(Zb[(size_t)(SEQ - 3 + j) * NZ + ZC_XA + c]); }
    {
        float xr[7][8];
#pragma unroll
        for (int j = 0; j < 7; ++j) { const u32x4 w = xw[j];
            xr[j][0] = lo2f(w.x); xr[j][1] = hi2f(w.x); xr[j][2] = lo2f(w.y); xr[j][3] = hi2f(w.y); xr[j][4] = lo2f(w.z); xr[j][5] = hi2f(w.z); xr[j][6] = lo2f(w.w); xr[j][7] = hi2f(w.w); }
#pragma unroll
        for (int q = 0; q < 4; ++q) {
            float o[8];
#pragma unroll
            for (int e = 0; e < 8; ++e) o[e] = cbias[e] + cw[0][e] * xr[q][e] + cw[1][e] * xr[q + 1][e] + cw[2][e] * xr[q + 2][e] + cw[3][e] * xr[q + 3][e];
            u32x4 w; w.x = cvtpk(o[0], o[1]); w.y = cvtpk(o[2], o[3]); w.z = cvtpk(o[4], o[5]); w.w = cvtpk(o[6], o[7]);
            *(u32x4*)(Xc + (st + q) * 136 + sc) = w;
        }
    }
    if (kk + 1 < cnt) xload(idx + 1);
    __syncthreads();
    f32x16 accr = zero16(), acci = zero16();
#pragma unroll
    for (int ks = 0; ks < 8; ++ks) {
        const bf16x8 a = ld8(Xc + (tb * 32 + r) * 136 + ks * 16 + hh * 8);
        accr = MFMA32(a, wa[ks], accr); acci = MFMA32(a, wx[ks], acci);
    }
    float av[16], uv[16];
#pragma unroll
    for (int i = 0; i < 16; ++i) {
        const int tl = tb * 32 + crow(i, hh);
        const float xf = bf2f(Xc[tl * 136 + cl]);
        const float rg = fsigmoid(accr[i] + b_a), ig = fsigmoid(acci[i] + b_x);
        const float la = -8.0f * rg * sp;
        av[i] = fexp(la); uv[i] = __builtin_sqrtf(neg_expm1(2.0f * la)) * (ig * xf);
    }
    float PA[4], PU[4];
#pragma unroll
    for (int g = 0; g < 4; ++g) {
        float A = av[4 * g], U = uv[4 * g];
#pragma unroll
        for (int k = 1; k < 4; ++k) { U = av[4 * g + k] * U + uv[4 * g + k]; A *= av[4 * g + k]; uv[4 * g + k] = U; av[4 * g + k] = A; }
        PA[g] = A; PU[g] = U;
    }
    float QA[4], QU[4];
#pragma unroll
    for (int g = 0; g < 4; ++g) { QA[g] = __shfl_xor(PA[g], 32, 64); QU[g] = __shfl_xor(PU[g], 32, 64); }
    float gA[4], gU[4]; float CA = 1.f, CU = 0.f;
#pragma unroll
    for (int g = 0; g < 4; ++g) {
        if (hh == 0) { gA[g] = CA; gU[g] = CU; CU = PA[g] * CU + PU[g]; CA = PA[g] * CA; CU = QA[g] * CU + QU[g]; CA = QA[g] * CA; }
        else { CU = QA[g] * CU + QU[g]; CA = QA[g] * CA; gA[g] = CA; gU[g] = CU; CU = PA[g] * CU + PU[g]; CA = PA[g] * CA; }
    }
    if (hh == 0) { SumA[tb * 64 + cb * 32 + r] = CA; SumU[tb * 64 + cb * 32 + r] = CU; }
    __syncthreads();
    float pA = 1.f, pU = 0.f;
    for (int j = 0; j < tb; ++j) { const float sa = SumA[j * 64 + cb * 32 + r], su = SumU[j * 64 + cb * 32 + r]; pU = sa * pU + su; pA = sa * pA; }
#pragma unroll
    for (int g = 0; g < 4; ++g)
#pragma unroll
        for (int k = 0; k < 4; ++k) {
            const int i = 4 * g + k, t = t0 + tb * 32 + crow(i, hh);
            HLb[(size_t)t * 1024 + cg_] = f2bf(uv[i] + av[i] * (gA[g] * pU + gU[g]));
            ACb[(size_t)t * 1024 + cg_] = f2bf(av[i] * gA[g] * pA);
        }
    if (tb == 3 && hh == 0) { TAp[cg_] = CA * pA; TUp[cg_] = CA * pU + CU; }
    __syncthreads();
    }
}
DI void lru_fix_seq(bf16_t* Zb, int n, int q4, const bf16_t* HLb, const bf16_t* ACb, const float* TAb  , const float* TUb, float* h_out, int dry = 0) {
    const int tid = ltid(), c0 = n * 128 + q4 * 32 + (tid & 3) * 8, tl = tid >> 2;
    float carry[8];
#pragma unroll
    for (int e = 0; e < 8; ++e) carry[e] = 0.f;
    for (int s0 = 0; s0 < 16; s0 += 4) {
        u32x4 hw[4], aw[4], gw[4]; f32x4 ta0[4], ta1[4], tu0[4], tu1[4];
#pragma unroll
        for (int k = 0; k < 4; ++k) { const int stp = s0 + k, t = stp * 128 + tl;
            hw[k] = *(const u32x4*)(HLb + (size_t)t * 1024 + c0); aw[k] = *(const u32x4*)(ACb + (size_t)t * 1024 + c0); gw[k] = *(const u32x4*)(Zb + (size_t)t * NZ + ZC_GA + c0);
            ta0[k] = *(const f32x4*)(TAb + stp * 1024 + c0); ta1[k] = *(const f32x4*)(TAb + stp * 1024 + c0 + 4); tu0[k] = *(const f32x4*)(TUb + stp * 1024 + c0); tu1[k] = *(const f32x4*)(TUb + stp * 1024 + c0 + 4); }
#pragma unroll
        for (int k = 0; k < 4; ++k) {
            const int t = (s0 + k) * 128 + tl;
            const unsigned hu[4] = {hw[k].x, hw[k].y, hw[k].z, hw[k].w}, au[4] = {aw[k].x, aw[k].y, aw[k].z, aw[k].w}, gu[4] = {gw[k].x, gw[k].y, gw[k].z, gw[k].w};
            float h[8]; unsigned ou[4];
#pragma unroll
            for (int e = 0; e < 4; ++e) {
                h[2 * e] = lo2f(hu[e]) + lo2f(au[e]) * carry[2 * e]; h[2 * e + 1] = hi2f(hu[e]) + hi2f(au[e]) * carry[2 * e + 1];
                ou[e] = cvtpk(h[2 * e] * lo2f(gu[e]), h[2 * e + 1] * hi2f(gu[e]));
            }
            if (!dry) *(u32x4*)(Zb + (size_t)t * NZ + ZC_GA + c0) = (u32x4){ou[0], ou[1], ou[2], ou[3]};
            if (t == SEQ - 1) {
#pragma unroll
                for (int e = 0; e < 8; ++e) h_out[c0 + e] = h[e];
            }
#pragma unroll
            for (int e = 0; e < 4; ++e) { carry[e] = ta0[k][e] * carry[e] + tu0[k][e]; carry[4 + e] = ta1[k][e] * carry[4 + e] + tu1[k][e]; }
        }
    }
}

template <int NKS, class QF>
DI void qk_tile(const bf16_t* Kt, int kstr, const QF& qf, f32x16& s0, f32x16& s1, int r, int hh) {
    s0 = zero16(); s1 = zero16();
#pragma unroll
    for (int s = 0; s < NKS; ++s) {
        const bf16x8 q = qf(s);
        s0 = MFMA32(ld8(Kt + r * kstr + s * 16 + hh * 8), q, s0);
        s1 = MFMA32(ld8(Kt + (32 + r) * kstr + s * 16 + hh * 8), q, s1);
    }
}
template <int NKS, int NBATCH>
DI void qk_tile_stream(const bf16_t* Kt, int kstr, const bf16_t* qrow, f32x16& s0, f32x16& s1, int r, int hh) {
    s0 = zero16(); s1 = zero16();
#pragma unroll
    for (int b0 = 0; b0 < NKS; b0 += NBATCH) {
        bf16x8 q[NBATCH];
#pragma unroll
        for (int k = 0; k < NBATCH; ++k) q[k] = ld8(qrow + (b0 + k) * 16 + hh * 8);
#pragma unroll
        for (int k = 0; k < NBATCH; ++k) { const int s = b0 + k;
            s0 = MFMA32(ld8(Kt + r * kstr + s * 16 + hh * 8), q[k], s0);
            s1 = MFMA32(ld8(Kt + (32 + r) * kstr + s * 16 + hh * 8), q[k], s1); }
    }
}
template <int NDB>
DI void softmax_pv_tile(f32x16 s0, f32x16 s1, const bf16_t* Vt, int vstr, f32x16 (&o)[NDB], float& m, float& l, int nvalid, int r, int hh) {
    if (nvalid < 64) {
#pragma unroll
        for (int i = 0; i < 16; ++i) { if (crow(i, hh) >= nvalid) s0[i] = -INFINITY; if (32 + crow(i, hh) >= nvalid) s1[i] = -INFINITY; }
    }
    float mx = s0[0];
#pragma unroll
    for (int i = 1; i < 16; ++i) mx = fmaxf(mx, s0[i]);
#pragma unroll
    for (int i = 0; i < 16; ++i) mx = fmaxf(mx, s1[i]);
    mx = fmaxf(mx, __shfl_xor(mx, 32, 64));
    const float mn = fmaxf(m, mx), alpha = __builtin_amdgcn_exp2f(m - mn);
    float rs = 0.f;
#pragma unroll
    for (int i = 0; i < 16; ++i) { s0[i] = __builtin_amdgcn_exp2f(s0[i] - mn); s1[i] = __builtin_amdgcn_exp2f(s1[i] - mn); rs += s0[i] + s1[i]; }
    rs += __shfl_xor(rs, 32, 64);
    l = l * alpha + rs; m = mn;
#pragma unroll
    for (int d = 0; d < NDB; ++d)
#pragma unroll
        for (int i = 0; i < 16; ++i) o[d][i] *= alpha;
    const bf16x8 p00 = pack8(s0, 0), p01 = pack8(s0, 1), p10 = pack8(s1, 0), p11 = pack8(s1, 1);
#pragma unroll
    for (int d = 0; d < NDB; ++d) {
        const bf16_t* vp = Vt + (d * 32 + r) * vstr + 4 * hh;
        o[d] = MFMA32(cat44(vp, vp + 8), p00, o[d]);
        o[d] = MFMA32(cat44(vp + 16, vp + 24), p01, o[d]);
        o[d] = MFMA32(cat44(vp + 32, vp + 40), p10, o[d]);
        o[d] = MFMA32(cat44(vp + 48, vp + 56), p11, o[d]);
    }
}
template <int NKS, int NDB, class QF>
DI void flash_tile(const bf16_t* Kt, int kstr, const bf16_t* Vt, int vstr, const QF& qf, f32x16 (&o)[NDB], float& m, float& l, int nvalid, int r, int hh) {
    f32x16 s0, s1;
    qk_tile<NKS>(Kt, kstr, qf, s0, s1, r, hh);
    softmax_pv_tile<NDB>(s0, s1, Vt, vstr, o, m, l, nvalid, r, hh);
}

DI void attn_prompt_unit(char* smem, int b, int hd, int qb, bf16_t* QN, const bf16_t* KN, const bf16_t* KPE, const bf16_t* VT, int dry = 0) {
    constexpr int KSTR = 104, VSTR = 72, KB = 64 * KSTR, VB = 64 * VSTR;
    bf16_t* Kb = (bf16_t*)smem;
    bf16_t* Vb = Kb + 3 * KB;
    const int tid = ltid(), wid = tid >> 6, lane = tid & 63, r = lane & 31, hh = lane >> 5;
    const size_t tok0 = (size_t)b * SEQ;
    const int qrow = qb * 256 + wid * 32 + r;
    bf16x8 qf[6];
#pragma unroll
    for (int s = 0; s < 4; ++s) qf[s] = ld8(QN + (tok0 + qrow) * NQ + hd * 64 + s * 16 + hh * 8);
#pragma unroll
    for (int s = 0; s < 2; ++s) qf[4 + s] = ld8(QN + (tok0 + qrow) * NQ + 1024 + hd * 32 + s * 16 + hh * 8);
    f32x16 o[2]; o[0] = zero16(); o[1] = zero16();
    float m = -INFINITY, l = 0.f;
    const int ntiles = 4 * qb + 4, myl = 4 * qb + (wid >> 1);
    const int sr = tid >> 3, sp = tid & 7;
    u32x4 kreg, vreg, preg = (u32x4){0, 0, 0, 0};
    auto gloadK = [&](int kt) { const size_t key = tok0 + (size_t)kt * 64;
        kreg = *(const u32x4*)(KN + (key + sr) * 1024 + hd * 64 + sp * 8);
        if (tid < 256) preg = *(const u32x4*)(KPE + (key + (tid >> 2)) * 32 + (tid & 3) * 8); };
    auto gloadV = [&](int kt) { const size_t key = tok0 + (size_t)kt * 64; vreg = *(const u32x4*)(VT + (size_t)(hd * 64 + sr) * MP + key + sp * 8); };
    auto lstoreK = [&](int bi) { *(u32x4*)(Kb + bi * KB + sr * KSTR + sp * 8) = kreg; if (tid < 256) *(u32x4*)(Kb + bi * KB + (tid >> 2) * KSTR + 64 + (tid & 3) * 8) = preg; };
    auto lstoreV = [&](int bi) { *(u32x4*)(Vb + bi * VB + sr * VSTR + sp * 8) = vreg; };
    {
        gloadK(0); gloadV(0);
        const u32x4 k0 = kreg, p0 = preg;
        gloadK(1);
        const u32x4 k1 = kreg, p1 = preg;
        kreg = k0; preg = p0; lstoreK(0); lstoreV(0);
        kreg = k1; preg = p1; lstoreK(1);
    }
    __syncthreads();
    f32x16 c0 = zero16(), c1 = zero16(), n0 = zero16(), n1 = zero16();
    qk_tile<6>(Kb, KSTR, [&](int s) { return qf[s]; }, c0, c1, r, hh);
    for (int kt = 0; kt < ntiles; ++kt) {
        if (kt + 2 < ntiles) gloadK(kt + 2);
        if (kt + 1 < ntiles) gloadV(kt + 1);
        if (kt + 1 < ntiles && kt + 1 <= myl) qk_tile<6>(Kb + ((kt + 1) % 3) * KB, KSTR, [&](int s) { return qf[s]; }, n0, n1, r, hh);
        if (kt <= myl) softmax_pv_tile<2>(c0, c1, Vb + (kt & 1) * VB, VSTR, o, m, l, 64, r, hh);
        if (kt + 2 < ntiles) lstoreK((kt + 2) % 3);
        if (kt + 1 < ntiles) lstoreV((kt + 1) & 1);
        __syncthreads();
        c0 = n0; c1 = n1;
    }
    const float inv = frcp(l);
#pragma unroll
    for (int d = 0; d < 2; ++d)
#pragma unroll
        for (int g = 0; g < 4; ++g) {
            u32x2 w; w.x = cvtpk(o[d][4 * g] * inv, o[d][4 * g + 1] * inv); w.y = cvtpk(o[d][4 * g + 2] * inv, o[d][4 * g + 3] * inv);
            if (!dry) *(u32x2*)(QN + (tok0 + qrow) * NQ + hd * 64 + d * 32 + 8 * g + 4 * hh) = w;
        }
    __syncthreads();
}

DI void attn_sample_unit(char* smem, int b, int sp, const bf16_t* QLAT, const bf16_t* CC, const bf16_t* CCT, bf16_t* OP, float* ML) {
    constexpr int KSTR = 296, VSTR = 72;
    bf16_t* Kt = (bf16_t*)smem;
    bf16_t* Vt = (bf16_t*)(smem + 64 * KSTR * 2);
    const int tid = ltid(), wid = tid >> 6, lane = tid & 63, r = lane & 31, hh = lane >> 5;
    const bf16_t* qrow = QLAT + ((size_t)b * 256 + wid * 32 + r) * DLAT;
    f32x16 o[8];
#pragma unroll
    for (int d = 0; d < 8; ++d) o[d] = zero16();
    float m = -INFINITY, l = 0.f;
    for (int kt = (NKT * sp) / NSPLIT; kt < (NKT * (sp + 1)) / NSPLIT; ++kt) {
        const int key0 = kt * 64;
        {
            u32x4 kk[5], vv[4];
#pragma unroll
            for (int it = 0; it < 5; ++it) { const int p = tid + 512 * it; kk[it] = (u32x4){0u, 0u, 0u, 0u}; if (p < 64 * 36) { const int row = p / 36, pc = p % 36; kk[it] = *(const u32x4*)(CC + ((size_t)b * KEYP + key0 + row) * DLAT + pc * 8); } }
#pragma unroll
            for (int it = 0; it < 4; ++it) { const int p = tid + 512 * it, row = p >> 3, pc = p & 7; vv[it] = *(const u32x4*)(CCT + ((size_t)b * 256 + row) * KEYP + key0 + pc * 8); }
#pragma unroll
            for (int it = 0; it < 5; ++it) { const int p = tid + 512 * it; if (p < 64 * 36) { const int row = p / 36, pc = p % 36; *(u32x4*)(Kt + row * KSTR + pc * 8) = kk[it]; } }
#pragma unroll
            for (int it = 0; it < 4; ++it) { const int p = tid + 512 * it, row = p >> 3, pc = p & 7; *(u32x4*)(Vt + row * VSTR + pc * 8) = vv[it]; }
        }
        __syncthreads();
        const int nvalid = (KEYS - key0) < 64 ? (KEYS - key0) : 64;
        { f32x16 s0, s1; qk_tile_stream<18, 9>(Kt, KSTR, qrow, s0, s1, r, hh); softmax_pv_tile<8>(s0, s1, Vt, VSTR, o, m, l, nvalid, r, hh); }
        __syncthreads();
    }
    bf16_t* op = OP + (((size_t)b * NSPLIT + sp) * 256 + wid * 32 + r) * 256;
#pragma unroll
    for (int d = 0; d < 8; ++d)
#pragma unroll
        for (int g = 0; g < 4; ++g) { u32x2 w; w.x = cvtpk(o[d][4 * g], o[d][4 * g + 1]); w.y = cvtpk(o[d][4 * g + 2], o[d][4 * g + 3]); *(u32x2*)(op + d * 32 + 8 * g + 4 * hh) = w; }
    if (hh == 0) { float* ml = ML + (((size_t)b * NSPLIT + sp) * 256 + wid * 32 + r) * 2; ml[0] = m; ml[1] = l; }
}


#define XB_TMO      128
#define XB_XCNT(j)  (256  + 64 * (j))
#define XB_XSUB(j)  (1280 + 64 * (j))
#define XB_XGEN(j)  (2304 + 64 * (j))
#define XB_TOP      3328
#define XB_TOPGEN   3392
#define XCD_BAR_WORDS 3456
#define XB_SPIN_CAP (1u << 18)
DI unsigned xb_ld(unsigned* p)              { return __hip_atomic_load(p, __ATOMIC_RELAXED, __HIP_MEMORY_SCOPE_AGENT); }
DI unsigned xb_add(unsigned* p, unsigned v) { return __hip_atomic_fetch_add(p, v, __ATOMIC_RELAXED, __HIP_MEMORY_SCOPE_AGENT); }
DI unsigned xb_xcc_id() { return (unsigned)__builtin_amdgcn_s_getreg((3 << 11) | 20) & 0xFu; }
#define XB_SPIN(cond, bar) do { unsigned _sp = 0; while (cond) { __builtin_amdgcn_s_sleep(1); \
    if ((++_sp & 255u) == 0u) { if (xb_ld(&(bar)[XB_TMO])) break; if (_sp > XB_SPIN_CAP) { atomicAdd(&(bar)[XB_TMO], 1u); break; } } } } while (0)
struct XcdBarrier { unsigned* bar; unsigned x; volatile LAS unsigned* st; };
DI XcdBarrier xcd_barrier_post(unsigned* bar, volatile LAS unsigned* st) {
    XcdBarrier b; b.bar = bar; b.x = xb_xcc_id(); b.st = st;
    if (threadIdx.x == 0) (void)xb_add(&bar[XB_XCNT(b.x)], 1u);
    return b;
}
DI void xcd_barrier_complete(unsigned* bar, unsigned x, unsigned& nloc, unsigned& nx) {
    const unsigned G = gridDim.x * gridDim.y * gridDim.z;
    unsigned sum, cnt, mine, sp = 0u;
    for (;;) {
        sum = 0u; cnt = 0u; mine = 0u;
#pragma unroll
        for (unsigned j = 0; j < 16; ++j) { const unsigned c = xb_ld(&bar[XB_XCNT(j)]); sum += c; cnt += (c > 0u) ? 1u : 0u; mine = (j == x) ? c : mine; }
        if (sum == G) break;
        __builtin_amdgcn_s_sleep(1);
        if ((++sp & 255u) == 0u) { if (xb_ld(&bar[XB_TMO])) break; if (sp > XB_SPIN_CAP) { atomicAdd(&bar[XB_TMO], 1u); break; } }
    }
    nloc = mine > 0u ? mine : 1u; nx = cnt > 0u ? cnt : 1u;
}
DI void xcd_barrier(const XcdBarrier& b) {
    asm volatile("s_waitcnt vmcnt(0)" ::: "memory");
    __syncthreads();
    if (threadIdx.x == 0) {
        unsigned* bar = b.bar;
        __builtin_amdgcn_s_waitcnt(0);
        unsigned nloc = b.st[0], nx = b.st[1];
        if (nloc == 0u) { xcd_barrier_complete(bar, b.x, nloc, nx); b.st[0] = nloc; b.st[1] = nx; }
        const unsigned old = xb_add(&bar[XB_XSUB(b.x)], 1u);
        const unsigned gen = old / nloc;
        if (old + 1u == (gen + 1u) * nloc) {
            __builtin_amdgcn_fence(__ATOMIC_RELEASE, "agent");
            asm volatile("s_waitcnt vmcnt(0)" ::: "memory");
            const unsigned og = xb_add(&bar[XB_TOP], 1u);
            const unsigned tg = og / nx;
            if (og + 1u == (tg + 1u) * nx) xb_add(&bar[XB_TOPGEN], 1u);
            else XB_SPIN(xb_ld(&bar[XB_TOPGEN]) == tg, bar);
            __builtin_amdgcn_fence(__ATOMIC_ACQUIRE, "agent");
            xb_add(&bar[XB_XGEN(b.x)], 1u);
            asm volatile("s_waitcnt vmcnt(0)" ::: "memory");
        } else {
            XB_SPIN(xb_ld(&bar[XB_XGEN(b.x)]) == gen, bar);
            __builtin_amdgcn_fence(__ATOMIC_ACQUIRE, "agent");
            asm volatile("s_waitcnt vmcnt(0)" ::: "memory");
        }
    }
    __syncthreads();
}
struct Args { const float* in[33]; float* out; char* ws; int ph_lo, ph_hi; };
enum { I_XP = 0, I_XS, I_SCONV, I_SLRU, I_SGLA, I_CCKV, I_CKPE, I_NMPRE, I_NMPOST, I_NFPRE, I_NFPOST, I_WINAB, I_CONVW, I_CONVB, I_LWA, I_LBA, I_LWX, I_LBX, I_LAM,
       I_GWG, I_GBG, I_GNORM, I_WOUTAB, I_WINC, I_QNORM, I_WUQ, I_KVNORM, I_WUK, I_WUV, I_WOUTC, I_FG, I_FU, I_FD };
constexpr int NPHASE = 21;
__device__ const int PH_ORDER_unused = 0;
#ifndef PH_MASK
#define PH_MASK 0x3FFFFF
#endif
#define PHM(n) ((PH_MASK >> (n)) & 1)
#ifndef PROBE_DUP
#define PROBE_DUP 0
#endif

extern __shared__ __attribute__((aligned(16))) unsigned char dyn_lds[];

__global__ void __launch_bounds__(512, 2) mk_fwd(Args a) {
    char* smem = (char*)dyn_lds;
    char* ws = a.ws; float* out = a.out;
    const int G = gridDim.x, bid = blockIdx.x;
    bf16_t* WIN = (bf16_t*)(ws + WS_WIN); bf16_t* WOUT = (bf16_t*)(ws + WS_WOUT); bf16_t* WGU0 = (bf16_t*)(ws + WS_WGU0); bf16_t* WDN0 = (bf16_t*)(ws + WS_WDN0);
    bf16_t* WAT = (bf16_t*)(ws + WS_WAT); bf16_t* WXT = WAT + 8 * 128 * 128; float* ROPE = (float*)(ws + WS_ROPE);
    bf16_t* Us = (bf16_t*)(ws + WS_US); bf16_t* Zs = (bf16_t*)(ws + WS_ZS); bf16_t* Gs = (bf16_t*)(ws + WS_GS); float* CQs = (float*)(ws + WS_CQS);
    bf16_t* CQNs = (bf16_t*)(ws + WS_CQNS); bf16_t* QNs = (bf16_t*)(ws + WS_QNS); bf16_t* QLAT = (bf16_t*)(ws + WS_QLAT); float* ML = (float*)(ws + WS_ML);
    bf16_t* OLAT = (bf16_t*)(ws + WS_OLAT); bf16_t* Os = (bf16_t*)(ws + WS_OS);
    bf16_t* U = (bf16_t*)(ws + WS_U); bf16_t* Z = (bf16_t*)(ws + WS_Z);
    bf16_t* WGU1 = (bf16_t*)(ws + ZR_WGU1); bf16_t* WDN1 = (bf16_t*)(ws + ZR_WDN1); bf16_t* WINC = (bf16_t*)(ws + WS_WINC); bf16_t* WUQ = (bf16_t*)(ws + WS_WUQ);
    bf16_t* WUKT = (bf16_t*)(ws + WS_WUKT); bf16_t* WUVT = (bf16_t*)(ws + WS_WUVT); bf16_t* WOC = (bf16_t*)(ws + WS_WOC); bf16_t* WUK = (bf16_t*)(ws + WS_WUKP);
    bf16_t* CC = (bf16_t*)(ws + ZR_CC); bf16_t* CCT = (bf16_t*)(ws + ZR_CCT); bf16_t* Gp = (bf16_t*)(ws + ZR_G);
    float* CQ = (float*)(ws + ZR_QN); bf16_t* QN = (bf16_t*)(ws + ZR_QN); bf16_t* VT = (bf16_t*)(ws + ZR_VT); bf16_t* OP = (bf16_t*)(ws + WS_WIN);
    bf16_t* CQN = (bf16_t*)(ws + ZR_CQN); bf16_t* CKVN = (bf16_t*)(ws + ZR_CKVN); bf16_t* KPE = (bf16_t*)(ws + ZR_KPE);
    bf16_t* U0 = (bf16_t*)(out + O_YP);
    float* Hp = out + O_YP; float* Hs = out + O_YS;
    bf16_t* Hb = (bf16_t*)(out + O_YP);
    bf16_t* Hb2 = (bf16_t*)(ws + ZR_CC);

    volatile LAS unsigned* bst = (volatile LAS unsigned*)(dyn_lds + LDS_BYTES - 16);
    if (threadIdx.x == 0) { bst[0] = 0u; bst[1] = 0u; }
    __syncthreads();
    XcdBarrier xb = xcd_barrier_post((unsigned*)(ws + WS_CTL), bst);
    if (a.ph_hi > NPHASE) cg::this_grid().sync();
    for (int ph = a.ph_lo; ph < a.ph_hi; ++ph) {
        if (ph > a.ph_lo) xcd_barrier(xb);
        const int phc = ph < 2 ? ph : (ph == 2 ? 20 : (ph == 3 ? 2 : (ph == 4 ? 21 : ph - 2)));
        for (int rep_ = 0; rep_ < (((PROBE_DUP >> phc) & 1) ? 2 : 1); ++rep_) {
        if (rep_) __syncthreads();
        const int dry_ = (((PROBE_DUP >> phc) & 1) && rep_ == 0) ? 1 : 0;
        int r9lo = 0, r9hi = 0;
        switch (phc) {
        case 0: if (PHM(0)) {
            const int tid = ltid(), wid = tid >> 6, lane = tid & 63; (void)wid; (void)lane;
            int tb = 0;
            transpose_job(smem, 1024, NZ, WIN, 1024, SrcWin{a.in[I_WINAB]}, tb);
            transpose_job(smem, 2048, 1024, WOUT, 2048, SrcPlain{a.in[I_WOUTAB], 1024}, tb);
            for (int e = bid * 512 + tid; e < 2 * 8 * 128 * 16; e += G * 512) {
                const int which = e >> 14, idx = e & 16383, n = idx >> 11, cg8 = (idx >> 7) & 15, d = idx & 127;
                const float* wsrc = a.in[which ? I_LWX : I_LWA] + ((size_t)(n * 128 + cg8 * 8)) * 128 + d;
                float v[8];
#pragma unroll
                for (int k = 0; k < 8; ++k) v[k] = wsrc[k * 128];
                u32x4 w; w.x = cvtpk(v[0], v[1]); w.y = cvtpk(v[2], v[3]); w.z = cvtpk(v[4], v[5]); w.w = cvtpk(v[6], v[7]);
                *(u32x4*)(WAT + (size_t)which * 131072 + ((size_t)(n * 128 + d)) * 128 + cg8 * 8) = w;
            }
            for (int e = bid * 512 + tid; e < 2064 * 16; e += G * 512) {
                const int pi = e >> 4, i = e & 15; const int pos = pi < 2048 ? pi : PAST + (pi - 2048);
                const float inv = __builtin_amdgcn_exp2f(-(float)i * 0.830482023721841f);
                const float ang = (float)pos * inv;
                const double rev = (double)ang * 0.15915494309189535; const float fr = (float)(rev - floor(rev));
                ROPE[pi * 32 + i] = __builtin_amdgcn_cosf(fr); ROPE[pi * 32 + 16 + i] = __builtin_amdgcn_sinf(fr);
            }
            rms_rows_to_bf16(a.in[I_XP], a.in[I_NMPRE], U0, MP);
            rms_rows_to_bf16(a.in[I_XS], a.in[I_NMPRE], Us, MS);
        } break;
        case 1: if (PHM(1)) {
            big_gemm(smem, U0, 1024, WIN, MP, 5120, 1024, 0, FZ{Z});
            for (int u = (bid + G - 64 % G) % G; u < MP / 128; u += G) small_gemm_unit(smem, U0 + (size_t)u * 128 * 1024, 1024, WIN, 1024, 1024, ZC_ZR, FZ{Z + (size_t)u * 128 * NZ});
            small_gemm(smem, Us, 1024, WIN, 1024, 1024, IN_AB, 192, FZ{Zs});
        } break;
        case 20: if (PHM(20)) {
            bf16_t* HL = (bf16_t*)(out + O_YP); bf16_t* AC = HL + (size_t)MP * 1024; float* DEC = (float*)(ws + WS_DEC); float* TA = (float*)(ws + WS_TA); float* TU = (float*)(ws + WS_TU);
            for (int u = bid; u < 1024; u += G) { const int b = u >> 7, hd = (u >> 5) & 3, ch = u & 31;
                gla_pre_unit(smem, Z + ((size_t)b * SEQ + ch * 64) * NZ, hd, a.in[I_GWG], a.in[I_GBG], U + ((size_t)(b * 4 + hd) * 32 + ch) * 16384, DEC + ((size_t)(b * 4 + hd) * 32 + ch) * 128, dry_); }
        } break;
        case 2: if (PHM(2)) {
            bf16_t* HL = (bf16_t*)(out + O_YP); bf16_t* AC = HL + (size_t)MP * 1024; float* DEC = (float*)(ws + WS_DEC); float* TA = (float*)(ws + WS_TA); float* TU = (float*)(ws + WS_TU);
            if (bid < 32) { const int b = bid >> 2, hd = bid & 3;
                gla_seq_unit(smem, Z + (size_t)b * SEQ * NZ, hd, U + (size_t)(b * 4 + hd) * 32 * 16384, DEC + (size_t)(b * 4 + hd) * 32 * 128, out + O_PS + ((size_t)b * 4 + hd) * 128 * 256, dry_);
            }
            const int nb2 = G > 64 ? G - 32 : G, me2 = G > 64 ? (int)bid - 32 : (int)bid;
            if (me2 >= 0) for (int u = me2; u < 32 + 128; u += nb2) {
                if (u < 32) { const int b = u >> 2, hd = u & 3;
                    gla_unit(smem, Zs + (size_t)b * DSEQ * NZ, DSEQ, hd, a.in[I_GWG], a.in[I_GBG], a.in[I_GNORM], a.in[I_SGLA] + ((size_t)b * 4 + hd) * 128 * 256, out + O_SS + ((size_t)b * 4 + hd) * 128 * 256, dry_);
                } else { const int w = u - 32, b = w >> 4, n = (w >> 1) & 7, half = w & 1;
                    lru_unit(smem, Zs + (size_t)b * DSEQ * NZ, DSEQ, n, half, a.in[I_CONVW], a.in[I_CONVB], WAT, WXT, a.in[I_LBA], a.in[I_LBX], a.in[I_LAM],
                             a.in[I_SCONV] + (size_t)b * 3 * 1024, a.in[I_SLRU] + (size_t)b * 1024, out + O_SCONV + (size_t)b * 3 * 1024, out + O_SH + (size_t)b * 1024, dry_);
                }
                __syncthreads();
            }
            const int sk2 = nb2 >= 96 ? 32 : 0;
            if (me2 >= sk2) { const int m3 = me2 - sk2, n3 = nb2 - sk2; const int nh = m3 & 15, grp = m3 >> 4, ngrp = (n3 + 15 - nh) / 16;
              if (ngrp > 0) { const int per = (128 + ngrp - 1) / ngrp, i0 = grp * per, i1 = (i0 + per < 128) ? i0 + per : 128;
                if (i0 < i1) lru_pre_multi(smem, Z, i0, i1 - i0, nh >> 1, nh & 1, a.in[I_CONVW], a.in[I_CONVB], WAT, WXT, a.in[I_LBA], a.in[I_LBX], a.in[I_LAM], HL, AC, TA, TU, out + O_PCONV); } }
            { int tb2 = 0;
              transpose_job(smem, 1024, NGU, WGU0, 1024, SrcGU{a.in[I_FG], a.in[I_FU]}, tb2, nb2, G > 64 ? me2 : (int)bid);
              transpose_job(smem, DFF, 1024, WDN0, DFF, SrcPlain{a.in[I_FD], 1024}, tb2, nb2, G > 64 ? me2 : (int)bid);
              const int mw = G > 64 ? me2 : (int)bid;
              transpose_job(smem, 1024, NINC, WINC, 1024, SrcInc{a.in[I_WINC]}, tb2, nb2, mw);
              transpose_job(smem, 384, NQ, WUQ, 384, SrcUq{a.in[I_WUQ]}, tb2, nb2, mw);
              transpose_job(smem, 256, 1024, WUKT, 256, SrcPlain{a.in[I_WUK], 1024}, tb2, nb2, mw);
              transpose_job(smem, 256, 1024, WUVT, 256, SrcPlain{a.in[I_WUV], 1024}, tb2, nb2, mw);
              transpose_job(smem, 1024, 1024, WOC, 1024, SrcPlain{a.in[I_WOUTC], 1024}, tb2, nb2, mw);
              if (mw >= 0) { const int tid = ltid(); for (int e = mw * 512 + tid; e < 256 * 1024 / 4; e += nb2 * 512) { const f32x4 v = *(const f32x4*)(a.in[I_WUK] + (size_t)e * 4); u32x2 w; w.x = cvtpk(v[0], v[1]); w.y = cvtpk(v[2], v[3]); *(u32x2*)(WUK + (size_t)e * 4) = w; } } }
        } break;
        case 21: if (PHM(21)) {
            for (int u = bid; u < 1024; u += G) { const int b = u >> 7, hd = (u >> 5) & 3, ch = u & 31;
                gla_post_unit(smem, Z + ((size_t)b * SEQ + ch * 64) * NZ, hd, U + ((size_t)(b * 4 + hd) * 32 + ch) * 16384, a.in[I_GNORM], dry_); }
            { bf16_t* HL = (bf16_t*)(out + O_YP); bf16_t* AC = HL + (size_t)MP * 1024; float* TA = (float*)(ws + WS_TA); float* TU = (float*)(ws + WS_TU);
              for (int v = bid; v < 256; v += G) { const int b = v >> 5, n = (v >> 2) & 7, q4 = v & 3;
                lru_fix_seq(Z + (size_t)b * SEQ * NZ, n, q4, HL + (size_t)b * SEQ * 1024, AC + (size_t)b * SEQ * 1024, TA + (size_t)b * 16 * 1024, TU + (size_t)b * 16 * 1024, out + O_PH + (size_t)b * 1024, dry_); } }
            small_gemm(smem, Zs + ZC_GA, NZ, WOUT, 2048, 2048, 1024, 0, FB{Us, 1024});
        } break;
        case 3: if (PHM(3)) {
            big_gemm(smem, Z + ZC_GA, NZ, WOUT, MP, 1024, 2048, 0, FB{U, 1024});
            norm_rows<0, 0>(Us, a.in[I_XS], Hs, a.in[I_NMPOST], a.in[I_NFPRE], Us, MS, dry_);
        } break;
        case 4: if (PHM(4)) {
            const int tid = ltid(), wid = tid >> 6, lane = tid & 63; (void)wid; (void)lane;
            norm_rows<0, 1>(U, a.in[I_XP], Hb, a.in[I_NMPOST], a.in[I_NFPRE], U, MP, dry_);
            { int tb = 0; for (int b = 0; b < NB; ++b) transpose_job(smem, PAST, 256, CCT + (size_t)b * 256 * KEYP, KEYP, SrcPlain{a.in[I_CCKV] + (size_t)b * PAST * 256, 256}, tb); }
            for (int e0 = bid * 512 + tid; e0 < NB * PAST * 64; e0 += 4 * G * 512) {
                f32x4 v[4];
#pragma unroll
                for (int k = 0; k < 4; ++k) { const int e = e0 + k * G * 512; v[k] = (f32x4){0.f, 0.f, 0.f, 0.f}; if (e < NB * PAST * 64) v[k] = *(const f32x4*)(a.in[I_CCKV] + (size_t)(e >> 6) * 256 + (e & 63) * 4); }
#pragma unroll
                for (int k = 0; k < 4; ++k) { const int e = e0 + k * G * 512; if (e < NB * PAST * 64) { const int row = e >> 6, c4 = (e & 63) * 4; const int b = row >> 12, key = row & 4095;
                    u32x2 w; w.x = cvtpk(v[k][0], v[k][1]); w.y = cvtpk(v[k][2], v[k][3]); *(u32x2*)(CC + ((size_t)b * KEYP + key) * DLAT + c4) = w; } }
            }
            {
                float x1[4], x2[4];
#pragma unroll
                for (int k = 0; k < 4; ++k) { const int e = bid * 512 + tid + k * G * 512; x1[k] = 0.f; x2[k] = 0.f;
                    if (e < NB * PAST * 16) { const int row = e >> 4, i = e & 15; x1[k] = a.in[I_CKPE][(size_t)row * 32 + i]; x2[k] = a.in[I_CKPE][(size_t)row * 32 + 16 + i]; } }
#pragma unroll
                for (int k = 0; k < 4; ++k) { const int e = bid * 512 + tid + k * G * 512;
                    if (e < NB * PAST * 16) { const int row = e >> 4, i = e & 15; const int b = row >> 12, key = row & 4095; *(unsigned*)(CC + ((size_t)b * KEYP + key) * DLAT + 256 + 2 * i) = cvtpk(x1[k], x2[k]); } }
                for (int e = bid * 512 + tid + 4 * G * 512; e < NB * PAST * 16; e += G * 512) { const int row = e >> 4, i = e & 15; const int b = row >> 12, key = row & 4095;
                    *(unsigned*)(CC + ((size_t)b * KEYP + key) * DLAT + 256 + 2 * i) = cvtpk(a.in[I_CKPE][(size_t)row * 32 + i], a.in[I_CKPE][(size_t)row * 32 + 16 + i]); }
            }
            small_gemm2(smem, Us, 1024, WGU0, 1024, 1024, NGU, 0, FSw{Gs});
        } break;
        case 5: if (PHM(5)) {
            big_gemm(smem, U, 1024, WGU0, MP, NGU, 1024, 0, FSw{Gp});
            { int tb5 = 0; const int nw5 = G > 128 ? G - 128 : G, me5 = G > 128 ? (int)bid - 128 : (int)bid;
              transpose_job(smem, 1024, NGU, WGU1, 1024, SrcGU{a.in[I_FG] + (size_t)1024 * DFF, a.in[I_FU] + (size_t)1024 * DFF}, tb5, nw5, me5);
              transpose_job(smem, DFF, 1024, WDN1, DFF, SrcPlain{a.in[I_FD] + (size_t)DFF * 1024, 1024}, tb5, nw5, me5); }
            small_gemm(smem, Gs, DFF, WDN0, DFF, DFF, 1024, 128, FB{Us, 1024});
        } break;
        case 6: if (PHM(6)) {
            big_gemm(smem, Gp, DFF, WDN0, MP, 1024, DFF, 0, FB{U, 1024});
            norm_rows<0, 0>(Us, Hs, Hs, a.in[I_NFPOST], a.in[I_NMPRE] + 1024, Us, MS, dry_);
        } break;
        case 7: if (PHM(7)) {
            norm_rows<1, 1>(U, Hb, Hb, a.in[I_NFPOST], a.in[I_NMPRE] + 1024, U, MP, dry_);
            small_gemm(smem, Us, 1024, WINC, 1024, 1024, INC, 0, FF32{CQs, NINC});
        } break;
        case 8: if (PHM(8)) {
            big_gemm(smem, U, 1024, WINC, MP, NINC, 1024, 0, FF32{CQ, NINC});
            r9lo = MP; r9hi = MP + MS;
        } break;
        case 9: if (PHM(9)) {
            r9lo = 0; r9hi = MP;
            small_gemm(smem, CQNs, 384, WUQ, 384, 384, NQ, 0, FQ{ROPE, 1, QNs, QLAT});
        } break;
        case 10: if (PHM(10)) {
            big_gemm(smem, CQN, 384, WUQ, MP, NQ, 384, 0, FQ{ROPE, 0, QN, nullptr});
            big_gemm(smem, CKVN, 256, WUKT, MP, 1024, 256, 128, FB{U, 1024});
            big_gemm(smem, WUVT, 256, CKVN, 1024, MP, 256, 128, FB{VT, MP});
            { const int nw10 = G > 128 ? G - 128 : G, me10 = G > 128 ? (int)bid - 128 : (int)bid;
              if (me10 >= 0) for (int u = me10; u < 128; u += nw10) { const int hd = u >> 3, nt = u & 7; small_gemm_unit2(smem, QNs + hd * 64, 1024, WUK + hd * 64, 1024, 64, nt * 32, FQL{QLAT, hd}); } }
        } break;
        case 11: if (PHM(11)) {
            { const int bh = bid >> 1, set = bid & 1, b = bh >> 4, hd = bh & 15;
              if (bid < 256) for (int i = 0; i < 4; ++i) { const int qb = set ? (i & 1 ? 2 + (i >> 1) : 5 - (i >> 1)) : (i & 1 ? (i >> 1) : 7 - (i >> 1)); attn_prompt_unit(smem, b, hd, qb, QN, U, KPE, VT, dry_); }
              if (G < 256) {   for (int u = G + bid; u < 256; u += G) { const int bh2 = u >> 1, s2 = u & 1; for (int i = 0; i < 4; ++i) { const int qb = s2 ? (i & 1 ? 2 + (i >> 1) : 5 - (i >> 1)) : (i & 1 ? (i >> 1) : 7 - (i >> 1)); attn_prompt_unit(smem, bh2 >> 4, bh2 & 15, qb, QN, U, KPE, VT, dry_); } } } }
            for (int u = bid; u < NB * NSPLIT; u += G) attn_sample_unit(smem, u / NSPLIT, u % NSPLIT, QLAT, CC, CCT, OP, ML);
        } break;
        case 12: if (PHM(12)) {
            big_gemm(smem, QN, NQ, WOC, MP, 1024, 1024, 0, FB{U, 1024});
            { const int tid = ltid(), wid = tid >> 6, lane = tid & 63; (void)lane;
            const int gw = bid * 8 + wid, GW = G * 8;
            for (int rr = gw; rr < 2048; rr += GW) { const int b = rr >> 8, qr = rr & 255;
                float mm[NSPLIT], ll[NSPLIT]; float M = -INFINITY;
#pragma unroll
                for (int j = 0; j < NSPLIT; ++j) { const float* ml = ML + (((size_t)b * NSPLIT + j) * 256 + qr) * 2; mm[j] = ml[0]; ll[j] = ml[1]; M = fmaxf(M, mm[j]); }
                float Lt = 0.f; f32x4 acc = (f32x4){0.f, 0.f, 0.f, 0.f};
#pragma unroll
                for (int j = 0; j < NSPLIT; ++j) { const float w = __builtin_amdgcn_exp2f(mm[j] - M); Lt += w * ll[j];
                    const u32x2 pv = *(const u32x2*)(OP + (((size_t)b * NSPLIT + j) * 256 + qr) * 256 + lane * 4); acc += (f32x4){lo2f(pv.x), hi2f(pv.x), lo2f(pv.y), hi2f(pv.y)} * w; }
                const float inv = frcp(Lt); u32x2 w; w.x = cvtpk(acc[0] * inv, acc[1] * inv); w.y = cvtpk(acc[2] * inv, acc[3] * inv);
                *(u32x2*)(OLAT + (size_t)rr * 256 + lane * 4) = w; }
            }
        } break;
        case 13: if (PHM(13)) {
            const int tid = ltid(), wid = tid >> 6, lane = tid & 63; (void)wid; (void)lane;
            norm_rows<1, 1>(U, Hb, Hb2, a.in[I_NMPOST] + 1024, a.in[I_NFPRE] + 1024, U, MP, dry_);
            for (int u = bid; u < 64; u += G) { const int hd = u >> 2, nt = u & 3; small_gemm_unit(smem, OLAT + hd * 256, 4096, WUVT + (size_t)hd * 64 * 256, 256, 256, nt * 16, FOS{Os, hd}); }
        } break;
        case 14: if (PHM(14)) {
            big_gemm(smem, U, 1024, WGU1, MP, NGU, 1024, 0, FSw{Gp});
            small_gemm(smem, Os, 1024, WOC, 1024, 1024, 1024, 128, FB{Us, 1024});
        } break;
        case 15: if (PHM(15)) {
            big_gemm(smem, Gp, DFF, WDN1, MP, 1024, DFF, 0, FB{U, 1024});
            norm_rows<0, 0>(Us, Hs, Hs, a.in[I_NMPOST] + 1024, a.in[I_NFPRE] + 1024, Us, MS, dry_);
        } break;
        case 16: if (PHM(16)) {
            norm_rows<1, 0>(U, Hb2, Hp, a.in[I_NFPOST] + 1024, nullptr, nullptr, MP, dry_);
            small_gemm2(smem, Us, 1024, WGU1, 1024, 1024, NGU, 0, FSw{Gs});
        } break;
        case 17: if (PHM(17)) small_gemm(smem, Gs, DFF, WDN1, DFF, DFF, 1024, 0, FB{Us, 1024}); break;
        case 18: if (PHM(18)) norm_rows<0, 0>(Us, Hs, Hs, a.in[I_NFPOST] + 1024, nullptr, nullptr, MS, dry_); break;
        default: break;
        }
        if (r9hi > r9lo) {
            const int tid = ltid(), wid = tid >> 6, lane = tid & 63; (void)wid; (void)lane;
            const int gw = bid * 8 + wid, GW = G * 8;
            float nq[6]; f32x4 nkv = (f32x4){0.f, 0.f, 0.f, 0.f}; float nx1 = 0.f, nx2 = 0.f;
            auto p9load = [&](int rr_) { const bool smp_ = rr_ >= MP; const float* cq_ = (smp_ ? CQs + (size_t)(rr_ - MP) * NINC : CQ + (size_t)rr_ * NINC);
#pragma unroll
                for (int i = 0; i < 6; ++i) nq[i] = cq_[i * 64 + lane];
                nkv = *(const f32x4*)(cq_ + 384 + lane * 4); nx1 = cq_[640 + (lane & 15)]; nx2 = cq_[656 + (lane & 15)]; };
            float gqn[6];
#pragma unroll
            for (int i = 0; i < 6; ++i) gqn[i] = a.in[I_QNORM][i * 64 + lane];
            const f32x4 gkn = *(const f32x4*)(a.in[I_KVNORM] + lane * 4);
            if (r9lo + gw < r9hi) p9load(r9lo + gw);
            for (int rr = r9lo + gw; rr < r9hi; rr += GW) {
                const bool smp = rr >= MP; const int row = smp ? rr - MP : rr;
                const float* cq = (smp ? CQs : CQ) + (size_t)row * NINC;
                float q[6]; float ss = 0.f;
#pragma unroll
                for (int i = 0; i < 6; ++i) { q[i] = nq[i]; ss += q[i] * q[i]; }
                const f32x4 kv = nkv; const float x1 = nx1, x2 = nx2;
                if (rr + GW < r9hi) p9load(rr + GW);
                ss = wave_sum(ss); const float rq = __builtin_amdgcn_rsqf(ss * (1.0f / 384.0f) + EPS);
                bf16_t* cqn = (smp ? CQNs : CQN) + (size_t)row * 384;
#pragma unroll
                for (int i = 0; i < 6; ++i) cqn[i * 64 + lane] = f2bf(q[i] * rq * gqn[i]);
                float s2 = kv[0] * kv[0] + kv[1] * kv[1] + kv[2] * kv[2] + kv[3] * kv[3]; s2 = wave_sum(s2); const float rk = __builtin_amdgcn_rsqf(s2 * (1.0f / 256.0f) + EPS);
                const f32x4 gk = gkn;
                const f32x4 kn = (f32x4){kv[0] * rk * gk[0], kv[1] * rk * gk[1], kv[2] * rk * gk[2], kv[3] * rk * gk[3]};
                *(f32x4*)(out + (smp ? O_SCKV : O_PCKV) + (size_t)row * 256 + lane * 4) = kn;
                u32x2 w; w.x = cvtpk(kn[0], kn[1]); w.y = cvtpk(kn[2], kn[3]);
                const int b = row >> 4, t = row & 15;
                if (!smp) *(u32x2*)(CKVN + (size_t)row * 256 + lane * 4) = w;
                else { *(u32x2*)(CC + ((size_t)b * KEYP + PAST + t) * DLAT + lane * 4) = w;
#pragma unroll
                    for (int j = 0; j < 4; ++j) CCT[((size_t)b * 256 + lane * 4 + j) * KEYP + PAST + t] = f2bf(kn[j]); }
                if (lane < 16) {
                    const int pidx = smp ? 2048 + t : (row & 2047);
                    const float c = ROPE[pidx * 32 + lane], s = ROPE[pidx * 32 + 16 + lane];
                    const float o1 = x1 * c - x2 * s, o2 = x1 * s + x2 * c;
                    float* ko = out + (smp ? O_SKPE : O_PKPE) + (size_t)row * 32; ko[lane] = o1; ko[16 + lane] = o2;
                    if (!smp) *(unsigned*)(KPE + (size_t)row * 32 + 2 * lane) = cvtpk(o1, o2);
                    else *(unsigned*)(CC + ((size_t)b * KEYP + PAST + t) * DLAT + 256 + 2 * lane) = cvtpk(o1, o2);
                }
            }
            }
        }
    }
}

#ifndef MK_COOP
#define MK_COOP 1
#endif
extern "C" void kernel_launch(void* const* d_in, const int* in_sizes, int n_in, void* d_out, int out_size, void* d_ws, size_t ws_size, hipStream_t stream) {
    static int grid = 0;
    if (grid == 0) {
        if (n_in != 33 || ws_size < WS_END) { fprintf(stderr, "kernel_launch: unexpected n_in %d / ws %zu\n", n_in, ws_size); grid = -1; return; }
        int dev = 0, cus = 0, per_cu = 0;
        hipGetDevice(&dev); hipDeviceGetAttribute(&cus, hipDeviceAttributeMultiprocessorCount, dev);
        if (hipFuncSetAttribute((const void*)mk_fwd, hipFuncAttributeMaxDynamicSharedMemorySize, LDS_BYTES) != hipSuccess) { fprintf(stderr, "hipFuncSetAttribute failed\n"); grid = -1; return; }
        hipOccupancyMaxActiveBlocksPerMultiprocessor(&per_cu, (const void*)mk_fwd, 512, LDS_BYTES);
        (void)hipGetLastError();
        if (per_cu < 1) per_cu = 1;
        grid = cus;
    }
    if (grid < 0) return;
    if (hipMemsetAsync((char*)d_ws + WS_CTL, 0, CTL_BYTES, stream) != hipSuccess) { fprintf(stderr, "memset failed\n"); return; }
    Args a{};
    for (int i = 0; i < 33; ++i) a.in[i] = (const float*)d_in[i];
    a.out = (float*)d_out; a.ws = (char*)d_ws;
#if MK_COOP
    a.ph_lo = 0; a.ph_hi = NPHASE;
    void* args[] = {&a};
    hipError_t e = hipLaunchCooperativeKernel((const void*)mk_fwd, dim3(grid), dim3(512), args, LDS_BYTES, stream);
    if (e != hipSuccess) fprintf(stderr, "cooperative launch failed: %s (grid %d)\n", hipGetErrorString(e), grid);
#else
    for (int ph = 0; ph < NPHASE; ++ph) { a.ph_lo = ph; a.ph_hi = ph + 1; hipLaunchKernelGGL(mk_fwd, dim3(grid), dim3(512), LDS_BYTES, stream, a); }
#endif
}
```

```cpp
#include <hip/hip_runtime.h>
#include <hip/hip_cooperative_groups.h>
#include <cstdio>
#include <cstdint>
namespace cg = cooperative_groups;

#define DI __device__ __forceinline__
#define LAS __attribute__((address_space(3)))
typedef unsigned short bf16_t;
typedef short bf16x8 __attribute__((ext_vector_type(8)));
typedef short s16x4 __attribute__((ext_vector_type(4)));
typedef float f32x2 __attribute__((ext_vector_type(2)));
typedef float f32x4 __attribute__((ext_vector_type(4)));
typedef float f32x16 __attribute__((ext_vector_type(16)));
typedef unsigned u32x2 __attribute__((ext_vector_type(2)));
typedef unsigned u32x4 __attribute__((ext_vector_type(4)));
typedef __bf16 bf16x2_t __attribute__((ext_vector_type(2)));

constexpr int DM = 1024, MP = 16384, MS = 128, SEQ = 2048, NB = 8, DSEQ = 16, PAST = 4096;
constexpr int NZ = 5376;
constexpr int ZC_XA = 0, ZC_GA = 1024, ZC_GB = 2048, ZC_Q = 3072, ZC_K = 3584, ZC_V = 4096, ZC_ZR = 5120;
constexpr int IN_AB = 5136, DFF = 2816, NGU = 5632, INC = 672, NINC = 768, NQ = 1536;
constexpr int KEYS = 4112, KEYP = 4160, DLAT = 288;
constexpr int NSPLIT = 30, NKT = 65;
constexpr float EPS = 1e-6f;
constexpr int LDS_BYTES = 147456;

constexpr size_t O_YP = 0, O_YS = 16777216, O_PCONV = 16908288, O_PH = 16932864, O_PS = 16941056, O_PCKV = 17989632, O_PKPE = 22183936,
                 O_SCONV = 22708224, O_SH = 22732800, O_SS = 22740992, O_SCKV = 23789568, O_SKPE = 23822336;

constexpr size_t al(size_t x) { return (x + 255) & ~(size_t)255; }
constexpr size_t WS_WIN = 0;
constexpr size_t WS_WOUT = WS_WIN + (size_t)NZ * 1024 * 2;
constexpr size_t WS_WGU0 = WS_WOUT + (size_t)1024 * 2048 * 2;
constexpr size_t WS_WDN0 = WS_WGU0 + (size_t)NGU * 1024 * 2;
constexpr size_t WS_WAT = WS_WDN0 + (size_t)1024 * DFF * 2;
constexpr size_t WS_ROPE = WS_WAT + (size_t)2 * 8 * 128 * 128 * 2;
constexpr size_t WS_US = al(WS_ROPE + (size_t)2064 * 32 * 4);
constexpr size_t WS_ZS = WS_US + (size_t)MS * 1024 * 2;
constexpr size_t WS_GS = WS_ZS + (size_t)MS * NZ * 2;
constexpr size_t WS_CQS = WS_GS + (size_t)MS * DFF * 2;
constexpr size_t WS_CQNS = WS_CQS + (size_t)MS * NINC * 4;
constexpr size_t WS_QNS = WS_CQNS + (size_t)MS * 384 * 2;
constexpr size_t WS_QLAT = WS_QNS + (size_t)MS * 1024 * 2;
constexpr size_t WS_ML = WS_QLAT + (size_t)2048 * DLAT * 2;
constexpr size_t WS_OLAT = al(WS_ML + (size_t)8 * NSPLIT * 256 * 2 * 4);
constexpr size_t WS_OS = WS_OLAT + (size_t)2048 * 256 * 2;
constexpr size_t WS_U = al(WS_OS + (size_t)MS * 1024 * 2);
constexpr size_t WS_Z = WS_U + (size_t)MP * 1024 * 2;
constexpr size_t Z_BYTES = (size_t)MP * NZ * 2;
constexpr size_t WS_CTL = WS_Z + Z_BYTES;
constexpr size_t CTL_BYTES = 16384;
constexpr size_t WS_DEC = WS_CTL + CTL_BYTES;
constexpr size_t WS_TA = WS_DEC + (size_t)1024 * 128 * 4;
constexpr size_t WS_TU = WS_TA + (size_t)128 * 1024 * 4;
constexpr size_t WS_WINC = WS_TU + (size_t)128 * 1024 * 4;
constexpr size_t WS_WUQ = WS_WINC + (size_t)NINC * 1024 * 2;
constexpr size_t WS_WUKT = WS_WUQ + (size_t)NQ * 384 * 2;
constexpr size_t WS_WUVT = WS_WUKT + (size_t)1024 * 256 * 2;
constexpr size_t WS_WOC = WS_WUVT + (size_t)1024 * 256 * 2;
constexpr size_t WS_WUKP = WS_WOC + (size_t)1024 * 1024 * 2;
constexpr size_t WS_END = WS_WUKP + (size_t)256 * 1024 * 2;
constexpr size_t ZR_WGU1 = WS_Z;
constexpr size_t ZR_WDN1 = ZR_WGU1 + (size_t)NGU * 1024 * 2;
constexpr size_t ZR_WUK = ZR_WDN1 + (size_t)1024 * DFF * 2;
constexpr size_t ZR_CC = ZR_WUK;
constexpr size_t ZR_CCT = ZR_CC + (size_t)NB * KEYP * DLAT * 2;
constexpr size_t ZR_G = al(ZR_CCT + (size_t)NB * 256 * KEYP * 2);
constexpr size_t ZR_QN = ZR_G;
constexpr size_t ZR_VT = ZR_QN + (size_t)MP * NQ * 2;
constexpr size_t ZR_CQN = ZR_VT + (size_t)MP * 1024 * 2;
constexpr size_t ZR_CKVN = ZR_CQN + (size_t)MP * 384 * 2;
constexpr size_t ZR_KPE = ZR_CKVN + (size_t)MP * 256 * 2;
constexpr size_t ZR_END = ZR_KPE + (size_t)MP * 32 * 2;
static_assert(ZR_END <= WS_CTL && ZR_G + (size_t)MP * DFF * 2 <= WS_CTL && WS_END <= 268435456, "ws map");
static_assert((size_t)NB * NSPLIT * 256 * 256 * 2 <= WS_WAT, "OP fits the layer-0 weight area");
static_assert((size_t)MP * NINC * 4 <= (size_t)MP * NQ * 2, "CQ fits QN");
static_assert(ZR_CC + (size_t)MP * 1024 * 2 <= ZR_G, "Hb2 fits the latent cache image");

DI unsigned cvtpk(float lo, float hi) { f32x2 v = {lo, hi}; bf16x2_t b = __builtin_convertvector(v, bf16x2_t); return __builtin_bit_cast(unsigned, b); }
DI float bf2f(bf16_t b) { return __uint_as_float(((unsigned)b) << 16); }
DI bf16_t f2bf(float f) { return (bf16_t)(cvtpk(f, 0.f) & 0xffffu); }
DI float lo2f(unsigned u) { return __uint_as_float(u << 16); }
DI float hi2f(unsigned u) { return __uint_as_float(u & 0xffff0000u); }
DI float fexp(float x) { return __builtin_amdgcn_exp2f(x * 1.44269504089f); }
DI float frcp(float x) { return __builtin_amdgcn_rcpf(x); }
DI float fsigmoid(float x) { return frcp(1.0f + fexp(-x)); }
DI float fsilu(float x) { return x * fsigmoid(x); }
DI float fgelu(float x) { const float u = 0.7978845608f * (x + 0.044715f * x * x * x); const float t = 1.0f - 2.0f * frcp(1.0f + fexp(2.0f * u)); return 0.5f * x * (1.0f + t); }
DI float flog(float x) { return __builtin_amdgcn_logf(x) * 0.69314718056f; }
DI float flog1p_small(float e) { return e < 0.03f ? e * (1.0f - e * (0.5f - e * (0.33333333f - 0.25f * e))) : flog(1.0f + e); }
DI float fsoftplus(float x) { return fmaxf(x, 0.f) + flog1p_small(fexp(-fabsf(x))); }
DI float neg_expm1(float y) {
    return (y > -0.1f) ? -y * (1.0f + y * 0.5f * (1.0f + y * 0.33333333f * (1.0f + y * 0.25f * (1.0f + y * 0.2f)))) : 1.0f - fexp(y); }
DI float wave_sum(float v) {
#pragma unroll
    for (int o = 32; o >= 1; o >>= 1) v += __shfl_xor(v, o, 64);
    return v; }
DI int ltid() { int t = threadIdx.x; asm volatile("" : "+v"(t)); return t; }
DI int crow(int i, int h) { return (i & 3) + 8 * (i >> 2) + 4 * h; }
DI bf16x8 pack8(const f32x16& x, int s) {
    u32x4 p; p.x = cvtpk(x[8 * s], x[8 * s + 1]); p.y = cvtpk(x[8 * s + 2], x[8 * s + 3]); p.z = cvtpk(x[8 * s + 4], x[8 * s + 5]); p.w = cvtpk(x[8 * s + 6], x[8 * s + 7]);
    return __builtin_bit_cast(bf16x8, p); }
DI bf16x8 ld8(const void* p) { return *(const bf16x8*)p; }
DI bf16x8 cat44(const void* lo, const void* hi) { const s16x4 a = *(const s16x4*)lo, b = *(const s16x4*)hi; return __builtin_shufflevector(a, b, 0, 1, 2, 3, 4, 5, 6, 7); }
#define MFMA32(a, b, c) __builtin_amdgcn_mfma_f32_32x32x16_bf16((a), (b), (c), 0, 0, 0)
#define MFMA16(a, b, c) __builtin_amdgcn_mfma_f32_16x16x32_bf16((a), (b), (c), 0, 0, 0)
DI f32x16 zero16() { f32x16 z; for (int i = 0; i < 16; ++i) z[i] = 0.f; return z; }

namespace pg8 {
constexpr int BM = 256, BK = 64, HALF = 128, HTB = HALF * BK * 2, STAGE_BYTES = 8 * HTB, NXCD = 8, WGM = 8;
DI int lds_byte(int r, int c) { const int st = (r >> 4) * 2 + (c >> 5), rr = r & 15, cc = c & 31, ob = rr * 64 + cc * 2; return st * 1024 + (ob ^ (((ob >> 9) & 1) << 5)); }
DI void stage_rc(int b, int& R, int& C) { const int st = b / 1024, sb = b % 1024, swz = sb ^ (((sb >> 9) & 1) << 5); R = (st >> 1) * 16 + swz / 64; C = (st & 1) * 32 + (swz % 64) / 2; }
DI int perm32(int rho) { const int n = rho >> 4, i = rho & 15; return 8 * (i >> 2) + 4 * n + (i & 3); }
struct Unit { int pm, pn; };
struct Gemm { const bf16_t* A; const bf16_t* Bt; int M, N, K, lda; };
struct StaticOrder {
    int nM, nN, nwg, G, c;
    DI void init(int M, int N, int G_, int c_) { nM = M / BM; nN = N / BM; nwg = nM * nN; G = G_; c = c_; }
    DI bool next(int i, Unit& u) const {
        const long L = (long)i * G + c; if (L >= nwg) return false;
        int wgid = (int)L; { const int q = nwg / NXCD, r = nwg % NXCD, xcd = wgid % NXCD, off = wgid / NXCD; wgid = (xcd < r ? xcd * (q + 1) : r * (q + 1) + (xcd - r) * q) + off; }
        const int nig = WGM * nN, gid = wgid / nig, fm = gid * WGM, gsz = (nM - fm) < WGM ? (nM - fm) : WGM;
        u.pm = fm + ((wgid % nig) % gsz); u.pn = (wgid % nig) / gsz; return true;
    }
};
template <class F> struct Epi {
    F f;
    DI void operator()(const f32x4 (&acc)[2][2][4][2], const Unit& u, int wr, int wc, int fr, int fq) const {
        int frl = fr, fql = fq; asm volatile("" : "+v"(frl), "+v"(fql));
        const int row0 = u.pm * BM + wr * 64 + frl, col0 = u.pn * BM + wc * 32 + 8 * fql;
#pragma unroll
        for (int ai = 0; ai < 2; ++ai)
#pragma unroll
            for (int m = 0; m < 4; ++m)
#pragma unroll
                for (int bj = 0; bj < 2; ++bj) f(row0 + ai * HALF + m * 16, col0 + bj * HALF, acc[ai][bj][m][0], acc[ai][bj][m][1]);
    }
};
template <class EpiT>
DI void gemm_phase(LAS unsigned char* lds, const Gemm g, const StaticOrder& S, const EpiT& E) {
    const int tid = ltid(), wid = __builtin_amdgcn_readfirstlane(tid >> 6), lane = tid & 63, wr = wid >> 2, wc = wid & 3, fr = lane & 15, fq = lane >> 4;
    int K_ = g.K, lda_ = g.lda; asm volatile("" : "+s"(K_), "+s"(lda_));
    const int K = K_, nt = K / BK, lda = lda_;
    unsigned voffA[2], voffB[2];
#pragma unroll
    for (int i = 0; i < 2; ++i) { int R, C; stage_rc(tid * 16 + i * 8192, R, C); const int Rb = (R & ~31) + perm32(R & 31);
        voffA[i] = (unsigned)(R * lda + C) * 2u; voffB[i] = (unsigned)(Rb * K + C) * 2u; }
    const size_t kstep = (size_t)(BK * 2);
    const size_t hstepA = (size_t)HALF * lda * 2, hstepB = (size_t)HALF * K * 2;
    const size_t tstepA = 2 * hstepA, tstepB = 2 * hstepB;
    const unsigned ldsw = (unsigned)wid * 1024u;
    const int aoff = lds_byte(wr * 64 + fr, fq * 8), boff = lds_byte(wc * 32 + fr, fq * 8);
#define PG8_SA(b, h) (((b) * 2 + (h)) * HTB)
#define PG8_SB(b, h) ((4 + (b) * 2 + (h)) * HTB)
#define PG8_STAGE(bufoff, gbase, voff) do { _Pragma("unroll") for (int _i = 0; _i < 2; ++_i) \
        __builtin_amdgcn_global_load_lds((const unsigned*)((const char*)(gbase) + (voff)[_i]), (LAS unsigned*)(lds + (bufoff) + ldsw + _i * 8192), 16, 0, 0); } while (0)
#define PG8_LDA(dst, b, h) do { _Pragma("unroll") for (int m = 0; m < 4; ++m) _Pragma("unroll") for (int k = 0; k < 2; ++k) dst[m][k] = *(const LAS bf16x8*)(lds + PG8_SA(b, h) + aoff + m * 2048 + k * 1024); } while (0)
#define PG8_LDB(dst, b, h) do { _Pragma("unroll") for (int n = 0; n < 2; ++n) _Pragma("unroll") for (int k = 0; k < 2; ++k) dst[n][k] = *(const LAS bf16x8*)(lds + PG8_SB(b, h) + boff + n * 2048 + k * 1024); } while (0)
#define PG8_MMA(ai, bj, At, Bt) do { __builtin_amdgcn_s_setprio(1); _Pragma("unroll") for (int m = 0; m < 4; ++m) _Pragma("unroll") for (int n = 0; n < 2; ++n) _Pragma("unroll") for (int k = 0; k < 2; ++k) \
        acc[ai][bj][m][n] = __builtin_amdgcn_mfma_f32_16x16x32_bf16(Bt[n][k], At[m][k], acc[ai][bj][m][n], 0, 0, 0); __builtin_amdgcn_s_setprio(0); } while (0)
#define PG8_WAIT_V(n) asm volatile("s_waitcnt vmcnt(" #n ")" ::: "memory")
#define PG8_WAIT_L(n) asm volatile("s_waitcnt lgkmcnt(" #n ")" ::: "memory")
#define PG8_BAR __builtin_amdgcn_s_barrier()
#define PG8_SCHED __builtin_amdgcn_sched_barrier(0)
    Unit cur, nxt; int ui = 0;
    if (!S.next(0, cur)) return;
    f32x4 acc[2][2][4][2];
#pragma unroll
    for (int a = 0; a < 2; ++a)
#pragma unroll
        for (int b = 0; b < 2; ++b)
#pragma unroll
            for (int m = 0; m < 4; ++m)
#pragma unroll
                for (int n = 0; n < 2; ++n) acc[a][b][m][n] = (f32x4){0.f, 0.f, 0.f, 0.f};
    bf16x8 At[4][2], B0[2][2], B1[2][2];
    const char* cA = (const char*)g.A + (size_t)cur.pm * tstepA; const char* cB = (const char*)g.Bt + (size_t)cur.pn * tstepB;
    PG8_STAGE(PG8_SB(0, 0), cB, voffB); PG8_STAGE(PG8_SA(0, 0), cA, voffA); PG8_STAGE(PG8_SB(0, 1), cB + hstepB, voffB); PG8_STAGE(PG8_SA(0, 1), cA + hstepA, voffA);
    if (wr == 1) PG8_BAR;
    PG8_WAIT_V(4); PG8_BAR;
    PG8_STAGE(PG8_SB(1, 0), cB + kstep, voffB); PG8_STAGE(PG8_SA(1, 0), cA + kstep, voffA); PG8_STAGE(PG8_SB(1, 1), cB + hstepB + kstep, voffB);
    PG8_WAIT_V(6); PG8_BAR;
    for (;;) {
        const bool has_next = S.next(ui + 1, nxt);
        const char* nA = has_next ? (const char*)g.A + (size_t)nxt.pm * tstepA : cA; const char* nB = has_next ? (const char*)g.Bt + (size_t)nxt.pn * tstepB : cB;
        for (int t = 0; t < nt; t += 2) {
            const bool last = (t == nt - 2);
            const char* a1 = cA + (size_t)(t + 1) * kstep;
            const char* a2 = last ? nA : cA + (size_t)(t + 2) * kstep; const char* b2 = last ? nB : cB + (size_t)(t + 2) * kstep;
            const char* a3 = a2 + kstep; const char* b3 = b2 + kstep;
            PG8_LDB(B0, 0, 0); PG8_SCHED; PG8_LDA(At, 0, 0); PG8_STAGE(PG8_SA(1, 1), a1 + hstepA, voffA);
            PG8_WAIT_L(8); PG8_BAR; PG8_WAIT_L(0); PG8_MMA(0, 0, At, B0); PG8_BAR; PG8_SCHED;
            PG8_LDB(B1, 0, 1); PG8_STAGE(PG8_SB(0, 0), b2, voffB);
            PG8_BAR; PG8_WAIT_L(0); PG8_MMA(0, 1, At, B1); PG8_BAR;
            PG8_LDA(At, 0, 1); PG8_STAGE(PG8_SA(0, 0), a2, voffA);
            PG8_BAR; PG8_WAIT_L(0); PG8_MMA(1, 0, At, B0); PG8_BAR; PG8_SCHED;
            PG8_STAGE(PG8_SB(0, 1), b2 + hstepB, voffB);
            PG8_WAIT_V(6); PG8_BAR; PG8_MMA(1, 1, At, B1); PG8_BAR;
            PG8_LDB(B0, 1, 0); PG8_SCHED; PG8_LDA(At, 1, 0); PG8_STAGE(PG8_SA(0, 1), a2 + hstepA, voffA);
            PG8_WAIT_L(8); PG8_BAR; PG8_WAIT_L(0); PG8_MMA(0, 0, At, B0); PG8_BAR; PG8_SCHED;
            PG8_LDB(B1, 1, 1); PG8_STAGE(PG8_SB(1, 0), b3, voffB);
            PG8_BAR; PG8_WAIT_L(0); PG8_MMA(0, 1, At, B1); PG8_BAR;
            PG8_LDA(At, 1, 1); PG8_STAGE(PG8_SA(1, 0), a3, voffA);
            PG8_BAR; PG8_WAIT_L(0); PG8_MMA(1, 0, At, B0); PG8_BAR; PG8_SCHED;
            PG8_STAGE(PG8_SB(1, 1), b3 + hstepB, voffB);
            PG8_WAIT_V(6); PG8_BAR; PG8_MMA(1, 1, At, B1); PG8_BAR;
        }
        E(acc, cur, wr, wc, fr, fq);
        if (!has_next) break;
#pragma unroll
        for (int a = 0; a < 2; ++a)
#pragma unroll
            for (int b = 0; b < 2; ++b)
#pragma unroll
                for (int m = 0; m < 4; ++m)
#pragma unroll
                    for (int n = 0; n < 2; ++n) acc[a][b][m][n] = (f32x4){0.f, 0.f, 0.f, 0.f};
        cur = nxt; cA = nA; cB = nB; ++ui;
    }
    PG8_WAIT_V(0);
    if (wr == 0) PG8_BAR;
    PG8_BAR;
#undef PG8_SA
#undef PG8_SB
#undef PG8_STAGE
#undef PG8_LDA
#undef PG8_LDB
#undef PG8_MMA
#undef PG8_WAIT_V
#undef PG8_WAIT_L
#undef PG8_BAR
#undef PG8_SCHED
}
}

template <class F>
DI void big_gemm(char* smem, const bf16_t* A, int lda, const bf16_t* Bt, int M, int N, int K, int crot, const F& f) {
    pg8::Gemm g{A, Bt, M, N, K, lda};
    pg8::StaticOrder S; S.init(M, N, (int)gridDim.x, (int)((blockIdx.x + crot) % gridDim.x));
    pg8::Epi<F> E{f};
    pg8::gemm_phase(( LAS unsigned char*)smem, g, S, E);
}

template <class F>
DI void small_gemm_unit(char* smem, const bf16_t* A, int lda, const bf16_t* Wt, int ldw, int K, int n0, const F& f) {
    const int tid = ltid(), wid = tid >> 6, lane = tid & 63, r16 = lane & 15, quad = lane >> 4;
    f32x4 acc[8];
#pragma unroll
    for (int i = 0; i < 8; ++i) acc[i] = (f32x4){0.f, 0.f, 0.f, 0.f};
    {
        const int nks = K / 32;
        bf16x8 bcur, acur[8];
        if (wid < nks) { const int k0 = wid * 32 + quad * 8; bcur = ld8(Wt + (size_t)(n0 + r16) * ldw + k0);
#pragma unroll
            for (int rb = 0; rb < 8; ++rb) acur[rb] = ld8(A + (size_t)(rb * 16 + r16) * lda + k0); }
        for (int ks = wid; ks < nks; ks += 8) {
            bf16x8 bnx = bcur, anx[8];
#pragma unroll
            for (int rb = 0; rb < 8; ++rb) anx[rb] = acur[rb];
            if (ks + 8 < nks) { const int k1 = (ks + 8) * 32 + quad * 8; bnx = ld8(Wt + (size_t)(n0 + r16) * ldw + k1);
#pragma unroll
                for (int rb = 0; rb < 8; ++rb) anx[rb] = ld8(A + (size_t)(rb * 16 + r16) * lda + k1); }
#pragma unroll
            for (int rb = 0; rb < 8; ++rb) acc[rb] = MFMA16(acur[rb], bcur, acc[rb]);
            bcur = bnx;
#pragma unroll
            for (int rb = 0; rb < 8; ++rb) acur[rb] = anx[rb];
        }
    }
    float* P = (float*)smem;
#pragma unroll
    for (int rb = 0; rb < 8; ++rb)
#pragma unroll
        for (int j = 0; j < 4; ++j) P[(wid * 128 + rb * 16 + quad * 4 + j) * 16 + r16] = acc[rb][j];
    __syncthreads();
    if (tid < 256) {
        const int row = tid >> 1, c8 = (tid & 1) * 8;
        f32x4 s0 = (f32x4){0.f, 0.f, 0.f, 0.f}, s1 = s0;
#pragma unroll
        for (int w = 0; w < 8; ++w) { s0 += *(const f32x4*)&P[(w * 128 + row) * 16 + c8]; s1 += *(const f32x4*)&P[(w * 128 + row) * 16 + c8 + 4]; }
        f(row, n0 + c8, s0, s1);
    }
    __syncthreads();
}
template <class F>
DI void small_gemm_unit_h(char* smem, const bf16_t* A, int lda, const bf16_t* Wt, int ldw, int K, int n0, int row0, const F& f) {
    const int tid = ltid(), wid = tid >> 6, lane = tid & 63, r16 = lane & 15, quad = lane >> 4;
    f32x4 acc[4];
#pragma unroll
    for (int i = 0; i < 4; ++i) acc[i] = (f32x4){0.f, 0.f, 0.f, 0.f};
    {
        const int nks = K / 32;
        bf16x8 bcur, acur[4];
        if (wid < nks) { const int k0 = wid * 32 + quad * 8; bcur = ld8(Wt + (size_t)(n0 + r16) * ldw + k0);
#pragma unroll
            for (int rb = 0; rb < 4; ++rb) acur[rb] = ld8(A + (size_t)(row0 + rb * 16 + r16) * lda + k0); }
        for (int ks = wid; ks < nks; ks += 8) {
            bf16x8 bnx = bcur, anx[4];
#pragma unroll
            for (int rb = 0; rb < 4; ++rb) anx[rb] = acur[rb];
            if (ks + 8 < nks) { const int k1 = (ks + 8) * 32 + quad * 8; bnx = ld8(Wt + (size_t)(n0 + r16) * ldw + k1);
#pragma unroll
                for (int rb = 0; rb < 4; ++rb) anx[rb] = ld8(A + (size_t)(row0 + rb * 16 + r16) * lda + k1); }
#pragma unroll
            for (int rb = 0; rb < 4; ++rb) acc[rb] = MFMA16(acur[rb], bcur, acc[rb]);
            bcur = bnx;
#pragma unroll
            for (int rb = 0; rb < 4; ++rb) acur[rb] = anx[rb];
        }
    }
    float* P = (float*)smem;
#pragma unroll
    for (int rb = 0; rb < 4; ++rb)
#pragma unroll
        for (int j = 0; j < 4; ++j) P[(wid * 64 + rb * 16 + quad * 4 + j) * 16 + r16] = acc[rb][j];
    __syncthreads();
    if (tid < 128) {
        const int row = tid >> 1, c8 = (tid & 1) * 8;
        f32x4 s0 = (f32x4){0.f, 0.f, 0.f, 0.f}, s1 = s0;
#pragma unroll
        for (int w = 0; w < 8; ++w) { s0 += *(const f32x4*)&P[(w * 64 + row) * 16 + c8]; s1 += *(const f32x4*)&P[(w * 64 + row) * 16 + c8 + 4]; }
        f(row0 + row, n0 + c8, s0, s1);
    }
    __syncthreads();
}
template <class F>
DI void small_gemm_h(char* smem, const bf16_t* A, int lda, const bf16_t* Wt, int ldw, int K, int N, int bstart, const F& f) {
    const int G = gridDim.x; const int me = ((int)blockIdx.x - bstart % G + G) % G;
    for (int u = me; u < 2 * (N / 16); u += G) small_gemm_unit_h(smem, A, lda, Wt, ldw, K, (u >> 1) * 16, (u & 1) * 64, f);
}
template <class F>
DI void small_gemm_unit2(char* smem, const bf16_t* A, int lda, const bf16_t* Wt, int ldw, int K, int n0, const F& f) {
    const int tid = ltid(), wid = tid >> 6, lane = tid & 63, r16 = lane & 15, quad = lane >> 4;
    f32x4 acc[2][8];
#pragma unroll
    for (int c = 0; c < 2; ++c)
#pragma unroll
        for (int i = 0; i < 8; ++i) acc[c][i] = (f32x4){0.f, 0.f, 0.f, 0.f};
    {
        const int nks = K / 32;
        bf16x8 b0c, b1c, acur[8];
        if (wid < nks) { const int k0 = wid * 32 + quad * 8; b0c = ld8(Wt + (size_t)(n0 + r16) * ldw + k0); b1c = ld8(Wt + (size_t)(n0 + 16 + r16) * ldw + k0);
#pragma unroll
            for (int rb = 0; rb < 8; ++rb) acur[rb] = ld8(A + (size_t)(rb * 16 + r16) * lda + k0); }
        for (int ks = wid; ks < nks; ks += 8) {
            bf16x8 b0n = b0c, b1n = b1c, anx[8];
#pragma unroll
            for (int rb = 0; rb < 8; ++rb) anx[rb] = acur[rb];
            if (ks + 8 < nks) { const int k1 = (ks + 8) * 32 + quad * 8; b0n = ld8(Wt + (size_t)(n0 + r16) * ldw + k1); b1n = ld8(Wt + (size_t)(n0 + 16 + r16) * ldw + k1);
#pragma unroll
                for (int rb = 0; rb < 8; ++rb) anx[rb] = ld8(A + (size_t)(rb * 16 + r16) * lda + k1); }
#pragma unroll
            for (int rb = 0; rb < 8; ++rb) { acc[0][rb] = MFMA16(acur[rb], b0c, acc[0][rb]); acc[1][rb] = MFMA16(acur[rb], b1c, acc[1][rb]); }
            b0c = b0n; b1c = b1n;
#pragma unroll
            for (int rb = 0; rb < 8; ++rb) acur[rb] = anx[rb];
        }
    }
    float* P = (float*)smem;
#pragma unroll
    for (int c = 0; c < 2; ++c)
#pragma unroll
        for (int rb = 0; rb < 8; ++rb)
#pragma unroll
            for (int j = 0; j < 4; ++j) P[(wid * 128 + rb * 16 + quad * 4 + j) * 32 + c * 16 + r16] = acc[c][rb][j];
    __syncthreads();
    {
        const int row = tid >> 2, c8 = (tid & 3) * 8;
        f32x4 s0 = (f32x4){0.f, 0.f, 0.f, 0.f}, s1 = s0;
#pragma unroll
        for (int w = 0; w < 8; ++w) { s0 += *(const f32x4*)&P[(w * 128 + row) * 32 + c8]; s1 += *(const f32x4*)&P[(w * 128 + row) * 32 + c8 + 4]; }
        f(row, n0 + c8, s0, s1);
    }
    __syncthreads();
}
template <class F>
DI void small_gemm2(char* smem, const bf16_t* A, int lda, const bf16_t* Wt, int ldw, int K, int N, int bstart, const F& f) {
    const int G = gridDim.x; const int me = ((int)blockIdx.x - bstart % G + G) % G;
    for (int u = me; u < N / 32; u += G) small_gemm_unit2(smem, A, lda, Wt, ldw, K, u * 32, f);
}
template <class F>
DI void small_gemm(char* smem, const bf16_t* A, int lda, const bf16_t* Wt, int ldw, int K, int N, int bstart, const F& f) {
    const int G = gridDim.x; const int me = ((int)blockIdx.x - bstart % G + G) % G;
    for (int u = me; u < N / 16; u += G) small_gemm_unit(smem, A, lda, Wt, ldw, K, u * 16, f);
}

struct FZ {
    bf16_t* Z;
    DI void operator()(int row, int col, f32x4 v0, f32x4 v1) const {
        if (col >= ZC_GA && col < ZC_GB) { for (int j = 0; j < 4; ++j) { v0[j] = fgelu(v0[j]); v1[j] = fgelu(v1[j]); } }
        else if (col >= ZC_GB && col < ZC_Q) { for (int j = 0; j < 4; ++j) { v0[j] = fsilu(v0[j]); v1[j] = fsilu(v1[j]); } }
        u32x4 w; w.x = cvtpk(v0[0], v0[1]); w.y = cvtpk(v0[2], v0[3]); w.z = cvtpk(v1[0], v1[1]); w.w = cvtpk(v1[2], v1[3]);
        *(u32x4*)(Z + (size_t)row * NZ + col) = w;
    }
};
struct FB {
    bf16_t* O; int ldc;
    DI void operator()(int row, int col, f32x4 v0, f32x4 v1) const {
        u32x4 w; w.x = cvtpk(v0[0], v0[1]); w.y = cvtpk(v0[2], v0[3]); w.z = cvtpk(v1[0], v1[1]); w.w = cvtpk(v1[2], v1[3]);
        *(u32x4*)(O + (size_t)row * ldc + col) = w;
    }
};
struct FSw {
    bf16_t* G;
    DI void operator()(int row, int col, f32x4 v0, f32x4 v1) const {
        u32x2 w; w.x = cvtpk(fsilu(v0[0]) * v1[0], fsilu(v0[1]) * v1[1]); w.y = cvtpk(fsilu(v0[2]) * v1[2], fsilu(v0[3]) * v1[3]);
        *(u32x2*)(G + (size_t)row * DFF + (col >> 1)) = w;
    }
};
struct FF32 {
    float* C; int ldc;
    DI void operator()(int row, int col, f32x4 v0, f32x4 v1) const { *(f32x4*)(C + (size_t)row * ldc + col) = v0; *(f32x4*)(C + (size_t)row * ldc + col + 4) = v1; }
};
constexpr float QSCALE = 0.10206207261596575f * 1.4426950408889634f;
struct FQ {
    const float* rope; int sample; bf16_t* QN; bf16_t* QLAT;
    DI void operator()(int row, int col, f32x4 v0, f32x4 v1) const {
        if (col >= 1024) {
            const int m = col - 1024, i0 = (m & 31) >> 1;
            const int pidx = sample ? (2048 + (row & 15)) : (row & 2047);
            const f32x4 c = *(const f32x4*)(rope + pidx * 32 + i0), s = *(const f32x4*)(rope + pidx * 32 + 16 + i0);
            f32x4 a, b;
            a[0] = v0[0] * c[0] - v0[1] * s[0]; a[1] = v0[0] * s[0] + v0[1] * c[0]; a[2] = v0[2] * c[1] - v0[3] * s[1]; a[3] = v0[2] * s[1] + v0[3] * c[1];
            b[0] = v1[0] * c[2] - v1[1] * s[2]; b[1] = v1[0] * s[2] + v1[1] * c[2]; b[2] = v1[2] * c[3] - v1[3] * s[3]; b[3] = v1[2] * s[3] + v1[3] * c[3];
            v0 = a; v1 = b;
        }
        u32x4 w; w.x = cvtpk(v0[0] * QSCALE, v0[1] * QSCALE); w.y = cvtpk(v0[2] * QSCALE, v0[3] * QSCALE); w.z = cvtpk(v1[0] * QSCALE, v1[1] * QSCALE); w.w = cvtpk(v1[2] * QSCALE, v1[3] * QSCALE);
        if (!sample) *(u32x4*)(QN + (size_t)row * NQ + col) = w;
        else if (col < 1024) *(u32x4*)(QN + (size_t)row * 1024 + col) = w;
        else { const int m = col - 1024, h = m >> 5; *(u32x4*)(QLAT + ((size_t)row * 16 + h) * DLAT + 256 + (m & 31)) = w; }
    }
};
struct FQL {
    bf16_t* QLAT; int h;
    DI void operator()(int row, int col, f32x4 v0, f32x4 v1) const {
        u32x4 w; w.x = cvtpk(v0[0], v0[1]); w.y = cvtpk(v0[2], v0[3]); w.z = cvtpk(v1[0], v1[1]); w.w = cvtpk(v1[2], v1[3]);
        *(u32x4*)(QLAT + ((size_t)row * 16 + h) * DLAT + col) = w;
    }
};
struct FOS {
    bf16_t* O; int h;
    DI void operator()(int row, int col, f32x4 v0, f32x4 v1) const {
        u32x4 w; w.x = cvtpk(v0[0], v0[1]); w.y = cvtpk(v0[2], v0[3]); w.z = cvtpk(v1[0], v1[1]); w.w = cvtpk(v1[2], v1[3]);
        *(u32x4*)(O + (size_t)row * 1024 + h * 64 + col) = w;
    }
};

template <class SrcF>
DI void transpose_job(char* smem, int K, int Nout, bf16_t* WT, int ldwt, const SrcF& src, int& tile_base, int nw = -1, int me = 0) {
    float* T = (float*)smem;
    const int nkt = K / 64, ntiles = nkt * (Nout / 256), G = nw > 0 ? nw : (int)gridDim.x, tid = ltid();
    const int first = nw > 0 ? (me < 0 ? ntiles : (me - tile_base % G + G) % G) : ((int)blockIdx.x - tile_base % G + G) % G;
    float v[32];
    auto tload = [&](int t) { const int kt = t % nkt, nt = t / nkt; const int n = nt * 256 + (tid & 255), kb = kt * 64 + (tid >> 8);
#pragma unroll
        for (int j = 0; j < 32; ++j) v[j] = src(n, kb + 2 * j); };
    if (first < ntiles) tload(first);
    for (int t = first; t < ntiles; t += G) {
        const int kt = t % nkt, nt = t / nkt;
#pragma unroll
        for (int j = 0; j < 32; ++j) T[((tid >> 8) + 2 * j) * 257 + (tid & 255)] = v[j];
        if (t + G < ntiles) tload(t + G);
        __syncthreads();
#pragma unroll
        for (int i = 0; i < 4; ++i) {
            const int p = tid + 512 * i, nn = p >> 3, kp = (p & 7) * 8;
            u32x4 w;
            w.x = cvtpk(T[(kp + 0) * 257 + nn], T[(kp + 1) * 257 + nn]); w.y = cvtpk(T[(kp + 2) * 257 + nn], T[(kp + 3) * 257 + nn]);
            w.z = cvtpk(T[(kp + 4) * 257 + nn], T[(kp + 5) * 257 + nn]); w.w = cvtpk(T[(kp + 6) * 257 + nn], T[(kp + 7) * 257 + nn]);
            *(u32x4*)(WT + (size_t)(nt * 256 + nn) * ldwt + kt * 64 + kp) = w;
        }
        __syncthreads();
    }
    tile_base += ntiles;
}
struct SrcPlain { const float* W; int N; DI float operator()(int n, int k) const { return W[(size_t)k * N + n]; } };
struct SrcWin { const float* W; DI float operator()(int n, int k) const {
    int oc;
    if (n < 2048) oc = n; else if (n < 3072) oc = n - 2048 + 4096; else if (n < 3584) oc = n - 3072 + 2048; else if (n < 4096) oc = n - 3584 + 2560;
    else if (n < 5120) oc = n - 4096 + 3072; else if (n < IN_AB) oc = n; else oc = -1;
    return oc < 0 ? 0.f : W[(size_t)k * IN_AB + oc]; } };
struct SrcGU { const float* Wg; const float* Wu; DI float operator()(int n, int k) const { const int i = n >> 3, j = n & 7; return j < 4 ? Wg[(size_t)k * DFF + 4 * i + j] : Wu[(size_t)k * DFF + 4 * i + j - 4]; } };
struct SrcInc { const float* W; DI float operator()(int n, int k) const { return n < INC ? W[(size_t)k * INC + n] : 0.f; } };
struct SrcUq { const float* W; DI float operator()(int n, int k) const {
    int oc; if (n < 1024) { oc = (n >> 6) * 96 + (n & 63); } else { const int m = n - 1024, h = m >> 5, i = (m & 31) >> 1, p = m & 1; oc = h * 96 + 64 + p * 16 + i; }
    return W[(size_t)k * NQ + oc]; } };

DI void rms_rows_to_bf16(const float* X, const float* g, bf16_t* U, int nrows) {
    const int tid_ = ltid(); const int lane = tid_ & 63, gw = blockIdx.x * 8 + (tid_ >> 6), GW = gridDim.x * 8;
    f32x4 nx[4], gg4[4];
#pragma unroll
    for (int i = 0; i < 4; ++i) gg4[i] = *(const f32x4*)(g + i * 256 + lane * 4);
    if (gw < nrows) {
#pragma unroll
        for (int i = 0; i < 4; ++i) nx[i] = *(const f32x4*)(X + (size_t)gw * DM + i * 256 + lane * 4); }
    for (int r = gw; r < nrows; r += GW) {
        f32x4 a[4]; float ss = 0.f;
#pragma unroll
        for (int i = 0; i < 4; ++i) { a[i] = nx[i]; ss += a[i][0] * a[i][0] + a[i][1] * a[i][1] + a[i][2] * a[i][2] + a[i][3] * a[i][3]; }
        if (r + GW < nrows) {
#pragma unroll
            for (int i = 0; i < 4; ++i) nx[i] = *(const f32x4*)(X + (size_t)(r + GW) * DM + i * 256 + lane * 4); }
        ss = wave_sum(ss); const float rs = __builtin_amdgcn_rsqf(ss * (1.0f / DM) + EPS);
#pragma unroll
        for (int i = 0; i < 4; ++i) { const f32x4 gg = gg4[i];
            u32x2 w; w.x = cvtpk(a[i][0] * rs * gg[0], a[i][1] * rs * gg[1]); w.y = cvtpk(a[i][2] * rs * gg[2], a[i][3] * rs * gg[3]);
            *(u32x2*)(U + (size_t)r * DM + i * 256 + lane * 4) = w; }
    }
}
template <int HI, int HO>
DI void norm_rows(const bf16_t* Y, const void* Hin_, void* Hout_, const float* gpost, const float* gpre, bf16_t* U, int nrows, int dry = 0) {
    const int tid_ = ltid(); const int lane = tid_ & 63, gw = blockIdx.x * 8 + (tid_ >> 6), GW = gridDim.x * 8;
    u32x4 ry[2], rh[4];
    auto rload = [&](int r) {
#pragma unroll
        for (int i = 0; i < 2; ++i) { const int c = i * 512 + lane * 8;
            ry[i] = *(const u32x4*)(Y + (size_t)r * DM + c);
            if (HI == 0) { rh[2 * i] = *(const u32x4*)((const float*)Hin_ + (size_t)r * DM + c); rh[2 * i + 1] = *(const u32x4*)((const float*)Hin_ + (size_t)r * DM + c + 4); }
            else rh[2 * i] = *(const u32x4*)((const bf16_t*)Hin_ + (size_t)r * DM + c); }
    };
    f32x4 gp[4], gq[4];
#pragma unroll
    for (int i = 0; i < 2; ++i) { const int c = i * 512 + lane * 8; gp[2 * i] = *(const f32x4*)(gpost + c); gp[2 * i + 1] = *(const f32x4*)(gpost + c + 4);
        gq[2 * i] = gpre ? *(const f32x4*)(gpre + c) : (f32x4){0.f, 0.f, 0.f, 0.f}; gq[2 * i + 1] = gpre ? *(const f32x4*)(gpre + c + 4) : (f32x4){0.f, 0.f, 0.f, 0.f}; }
    if (gw < nrows) rload(gw);
    for (int r = gw; r < nrows; r += GW) {
        float y[16], hin[16]; float ss = 0.f;
#pragma unroll
        for (int i = 0; i < 2; ++i) { const u32x4 w = ry[i];
            y[i * 8 + 0] = lo2f(w.x); y[i * 8 + 1] = hi2f(w.x); y[i * 8 + 2] = lo2f(w.y); y[i * 8 + 3] = hi2f(w.y); y[i * 8 + 4] = lo2f(w.z); y[i * 8 + 5] = hi2f(w.z); y[i * 8 + 6] = lo2f(w.w); y[i * 8 + 7] = hi2f(w.w);
            if (HI == 0) { const f32x4 a0 = __builtin_bit_cast(f32x4, rh[2 * i]), a1 = __builtin_bit_cast(f32x4, rh[2 * i + 1]);
#pragma unroll
                for (int j = 0; j < 4; ++j) { hin[i * 8 + j] = a0[j]; hin[i * 8 + 4 + j] = a1[j]; } }
            else { const u32x4 v = rh[2 * i];
                hin[i * 8 + 0] = lo2f(v.x); hin[i * 8 + 1] = hi2f(v.x); hin[i * 8 + 2] = lo2f(v.y); hin[i * 8 + 3] = hi2f(v.y); hin[i * 8 + 4] = lo2f(v.z); hin[i * 8 + 5] = hi2f(v.z); hin[i * 8 + 6] = lo2f(v.w); hin[i * 8 + 7] = hi2f(v.w); }
        }
        if (r + GW < nrows) rload(r + GW);
#pragma unroll
        for (int i = 0; i < 16; ++i) ss += y[i] * y[i];
        ss = wave_sum(ss); const float rs = __builtin_amdgcn_rsqf(ss * (1.0f / DM) + EPS);
        float h[16]; float s2 = 0.f;
#pragma unroll
        for (int i = 0; i < 2; ++i) {
            const int c = i * 512 + lane * 8; const f32x4 g0 = gp[2 * i], g1 = gp[2 * i + 1];
#pragma unroll
            for (int j = 0; j < 4; ++j) { h[i * 8 + j] = hin[i * 8 + j] + y[i * 8 + j] * rs * g0[j]; h[i * 8 + 4 + j] = hin[i * 8 + 4 + j] + y[i * 8 + 4 + j] * rs * g1[j]; }
            if (HO == 1) {
                u32x4 w; w.x = cvtpk(h[i * 8 + 0], h[i * 8 + 1]); w.y = cvtpk(h[i * 8 + 2], h[i * 8 + 3]); w.z = cvtpk(h[i * 8 + 4], h[i * 8 + 5]); w.w = cvtpk(h[i * 8 + 6], h[i * 8 + 7]);
                if (!dry) *(u32x4*)((bf16_t*)Hout_ + (size_t)r * DM + c) = w;
                h[i * 8 + 0] = lo2f(w.x); h[i * 8 + 1] = hi2f(w.x); h[i * 8 + 2] = lo2f(w.y); h[i * 8 + 3] = hi2f(w.y); h[i * 8 + 4] = lo2f(w.z); h[i * 8 + 5] = hi2f(w.z); h[i * 8 + 6] = lo2f(w.w); h[i * 8 + 7] = hi2f(w.w);
            } else if (!dry) {
                *(f32x4*)((float*)Hout_ + (size_t)r * DM + c) = (f32x4){h[i * 8 + 0], h[i * 8 + 1], h[i * 8 + 2], h[i * 8 + 3]};
                *(f32x4*)((float*)Hout_ + (size_t)r * DM + c + 4) = (f32x4){h[i * 8 + 4], h[i * 8 + 5], h[i * 8 + 6], h[i * 8 + 7]};
            }
        }
        if (gpre) {
#pragma unroll
            for (int i = 0; i < 16; ++i) s2 += h[i] * h[i];
            s2 = wave_sum(s2); const float r2 = __builtin_amdgcn_rsqf(s2 * (1.0f / DM) + EPS);
#pragma unroll
            for (int i = 0; i < 2; ++i) { const int c = i * 512 + lane * 8; const f32x4 g0 = gq[2 * i], g1 = gq[2 * i + 1];
                u32x4 w; w.x = cvtpk(h[i * 8 + 0] * r2 * g0[0], h[i * 8 + 1] * r2 * g0[1]); w.y = cvtpk(h[i * 8 + 2] * r2 * g0[2], h[i * 8 + 3] * r2 * g0[3]);
                w.z = cvtpk(h[i * 8 + 4] * r2 * g1[0], h[i * 8 + 5] * r2 * g1[1]); w.w = cvtpk(h[i * 8 + 6] * r2 * g1[2], h[i * 8 + 7] * r2 * g1[3]);
                if (!dry) *(u32x4*)(U + (size_t)r * DM + c) = w; }
        }
    }
}

DI void lru_unit(char* smem, bf16_t* Zb, int L, int n, int half, const float* convw, const float* convb, const bf16_t* WAT, const bf16_t* WXT,
                 const float* ba, const float* bx, const float* lam, const float* conv0  , const float* h0  ,
                 float* conv_out  , float* h_out  , int dry = 0) {
    bf16_t* Xc = (bf16_t*)smem;
    float* SumA = (float*)(smem + 128 * 136 * 2);
    float* SumU = SumA + 256;
    float* Carry = SumU + 256;
    const int tid = ltid(), wid = tid >> 6, lane = tid & 63, r = lane & 31, hh = lane >> 5, tb = wid >> 1, cb = wid & 1;
    const int cl = half * 64 + cb * 32 + r;
    const int cg_ = n * 128 + cl;
    const float b_a = ba[cg_], b_x = bx[cg_], sp = fsoftplus(-lam[cg_]);
    if (tid < 64) Carry[tid] = h0 ? h0[n * 128 + half * 64 + tid] : 0.f;
    if (tid < 192 && !dry) { const int j = tid >> 6, c = n * 128 + half * 64 + (tid & 63); conv_out[j * 1024 + c] = bf2f(Zb[(size_t)(L - 3 + j) * NZ + ZC_XA + c]); }
    const int sc = (tid & 15) * 8, st = (tid >> 4) * 4;
    float cw[4][8], cbias[8];
#pragma unroll
    for (int j = 0; j < 4; ++j)
#pragma unroll
        for (int e = 0; e < 8; ++e) cw[j][e] = convw[j * 1024 + n * 128 + sc + e];
#pragma unroll
    for (int e = 0; e < 8; ++e) cbias[e] = convb[n * 128 + sc + e];
    const int nsteps = (L + 127) / 128;
    for (int step = 0; step < nsteps; ++step) {
        const int t0 = step * 128;
        {
            float xr[7][8];
#pragma unroll
            for (int j = 0; j < 7; ++j) {
                const int t = t0 + st - 3 + j;
                if (t >= 0 && t < L) { const u32x4 w = *(const u32x4*)(Zb + (size_t)t * NZ + ZC_XA + n * 128 + sc);
                    xr[j][0] = lo2f(w.x); xr[j][1] = hi2f(w.x); xr[j][2] = lo2f(w.y); xr[j][3] = hi2f(w.y); xr[j][4] = lo2f(w.z); xr[j][5] = hi2f(w.z); xr[j][6] = lo2f(w.w); xr[j][7] = hi2f(w.w); }
                else if (t < 0 && conv0) {
#pragma unroll
                    for (int e = 0; e < 8; ++e) xr[j][e] = conv0[(3 + t) * 1024 + n * 128 + sc + e]; }
                else {
#pragma unroll
                    for (int e = 0; e < 8; ++e) xr[j][e] = 0.f; }
            }
#pragma unroll
            for (int q = 0; q < 4; ++q) {
                float o[8];
#pragma unroll
                for (int e = 0; e < 8; ++e) o[e] = cbias[e] + cw[0][e] * xr[q][e] + cw[1][e] * xr[q + 1][e] + cw[2][e] * xr[q + 2][e] + cw[3][e] * xr[q + 3][e];
                u32x4 w; w.x = cvtpk(o[0], o[1]); w.y = cvtpk(o[2], o[3]); w.z = cvtpk(o[4], o[5]); w.w = cvtpk(o[6], o[7]);
                *(u32x4*)(Xc + (st + q) * 136 + sc) = w;
            }
        }
        __syncthreads();
        f32x16 accr = zero16(), acci = zero16();
#pragma unroll
        for (int ks = 0; ks < 8; ++ks) {
            const bf16x8 a = ld8(Xc + (tb * 32 + r) * 136 + ks * 16 + hh * 8);
            const bf16x8 wa = ld8(WAT + ((size_t)n * 128 + cl) * 128 + ks * 16 + hh * 8), wx = ld8(WXT + ((size_t)n * 128 + cl) * 128 + ks * 16 + hh * 8);
            accr = MFMA32(a, wa, accr); acci = MFMA32(a, wx, acci);
        }
        float av[16], uv[16];
#pragma unroll
        for (int i = 0; i < 16; ++i) {
            const int tl = tb * 32 + crow(i, hh);
            const float xf = bf2f(Xc[tl * 136 + cl]);
            const float rg = fsigmoid(accr[i] + b_a), ig = fsigmoid(acci[i] + b_x);
            const float la = -8.0f * rg * sp;
            float a = fexp(la), u = __builtin_sqrtf(neg_expm1(2.0f * la)) * (ig * xf);
            if (t0 + tl >= L) { a = 1.f; u = 0.f; }
            av[i] = a; uv[i] = u;
        }
        float PA[4], PU[4];
#pragma unroll
        for (int g = 0; g < 4; ++g) {
            float A = av[4 * g], U = uv[4 * g];
#pragma unroll
            for (int k = 1; k < 4; ++k) { U = av[4 * g + k] * U + uv[4 * g + k]; A *= av[4 * g + k]; uv[4 * g + k] = U; av[4 * g + k] = A; }
            PA[g] = A; PU[g] = U;
        }
        float QA[4], QU[4];
#pragma unroll
        for (int g = 0; g < 4; ++g) { QA[g] = __shfl_xor(PA[g], 32, 64); QU[g] = __shfl_xor(PU[g], 32, 64); }
        float CA = 1.f, CU = 0.f;
#pragma unroll
        for (int g = 0; g < 4; ++g) {
            const float A0 = hh == 0 ? PA[g] : QA[g], U0 = hh == 0 ? PU[g] : QU[g], A1 = hh == 0 ? QA[g] : PA[g], U1 = hh == 0 ? QU[g] : PU[g];
            CU = A0 * CU + U0; CA = A0 * CA;
            CU = A1 * CU + U1; CA = A1 * CA;
        }
        if (hh == 0) { SumA[tb * 64 + cb * 32 + r] = CA; SumU[tb * 64 + cb * 32 + r] = CU; }
        __syncthreads();
        float carry = Carry[(step & 1) * 64 + cb * 32 + r];
        for (int j = 0; j < tb; ++j) carry = SumA[j * 64 + cb * 32 + r] * carry + SumU[j * 64 + cb * 32 + r];
        float hcur = carry;
#pragma unroll
        for (int g = 0; g < 4; ++g) {
            float my_in;
            if (hh == 0) { my_in = hcur; hcur = PA[g] * hcur + PU[g]; hcur = QA[g] * hcur + QU[g]; }
            else { hcur = QA[g] * hcur + QU[g]; my_in = hcur; hcur = PA[g] * hcur + PU[g]; }
#pragma unroll
            for (int k = 0; k < 4; ++k) {
                const int i = 4 * g + k, tl = tb * 32 + crow(i, hh), t = t0 + tl;
                const float hv = uv[i] + av[i] * my_in;
                if (t < L && !dry) { bf16_t* p = Zb + (size_t)t * NZ + ZC_GA + cg_; *p = f2bf(hv * bf2f(*p)); }
            }
        }
        if (tb == 3 && hh == 0) { Carry[((step + 1) & 1) * 64 + cb * 32 + r] = hcur; if (step == nsteps - 1 && !dry) h_out[cg_] = hcur; }
        __syncthreads();
    }
}

DI void gla_unit(char* smem, bf16_t* Zb, int L, int hd, const float* wgate  , const float* bgate  , const float* gnorm  ,
                 const float* S0  , float* Sout  , int dry = 0) {
    float* BL = (float*)smem;
    bf16_t* Qs = (bf16_t*)(smem + 32768);
    bf16_t* Ks = Qs + 64 * 136;
    bf16_t* KTs = Ks + 64 * 136;
    bf16_t* VTs = KTs + 128 * 72;
    bf16_t* As = VTs + 256 * 72;
    float* ZRs = (float*)(As + 64 * 72);
    float* Seg = ZRs + 64 * 16;
    float* Dec = Seg + 512;
    float* SSq = Dec + 128;
    const int tid = ltid(), wid = tid >> 6, lane = tid & 63, r = lane & 31, hh = lane >> 5;
    f32x16 S[4];
#pragma unroll
    for (int d = 0; d < 4; ++d)
#pragma unroll
        for (int i = 0; i < 16; ++i) S[d][i] = S0 ? S0[(size_t)(32 * d + crow(i, hh)) * 256 + 32 * wid + r] : 0.f;
    const int gdk = tid & 127, gseg = tid >> 7;
    const float gn = gnorm[32 * wid + r];
    const int nch = (L + 63) / 64;
    for (int ch = 0; ch < nch; ++ch) {
        const int t0 = ch * 64;
        for (int e = tid; e < 64 * 16; e += 512) { const int t = e >> 4, j = e & 15; ZRs[e] = (t0 + t < L) ? bf2f(Zb[(size_t)(t0 + t) * NZ + ZC_ZR + j]) : 0.f; }
        __syncthreads();
        {
            float wg[16];
#pragma unroll
            for (int j = 0; j < 16; ++j) wg[j] = wgate[j * 512 + hd * 128 + gdk];
            const float bg = bgate[hd * 128 + gdk];
            float run = 0.f;
#pragma unroll 4
            for (int tt = 0; tt < 16; ++tt) {
                const int t = gseg * 16 + tt;
                float z = bg;
#pragma unroll
                for (int j = 0; j < 16; ++j) z += ZRs[t * 16 + j] * wg[j];
                const float lg = (t0 + t < L) ? -fsoftplus(-z) * (1.0f / 16.0f) : 0.f;
                run += lg; BL[t * 128 + gdk] = run;
            }
            Seg[gseg * 128 + gdk] = run;
        }
        __syncthreads();
        if (tid < 128) { const float s0 = Seg[tid], s1 = Seg[128 + tid], s2 = Seg[256 + tid], s3 = Seg[384 + tid]; Dec[tid] = fexp(s0 + s1 + s2 + s3); }
        {
            const int t = tid >> 3, d0 = (tid & 7) * 16, sg = t >> 4;
            const bool valid = (t0 + t) < L;
#pragma unroll 1
            for (int half8 = 0; half8 < 2; ++half8) {
                const int dk = d0 + half8 * 8;
                u32x4 qw = (u32x4){0, 0, 0, 0}, kw = qw;
                if (valid) { qw = *(const u32x4*)(Zb + (size_t)(t0 + t) * NZ + ZC_Q + hd * 128 + dk); kw = *(const u32x4*)(Zb + (size_t)(t0 + t) * NZ + ZC_K + hd * 128 + dk); }
                float q[8] = {lo2f(qw.x), hi2f(qw.x), lo2f(qw.y), hi2f(qw.y), lo2f(qw.z), hi2f(qw.z), lo2f(qw.w), hi2f(qw.w)};
                float k[8] = {lo2f(kw.x), hi2f(kw.x), lo2f(kw.y), hi2f(kw.y), lo2f(kw.z), hi2f(kw.z), lo2f(kw.w), hi2f(kw.w)};
                float qt[8], kt[8];
#pragma unroll
                for (int e = 0; e < 8; ++e) {
                    float off = 0.f, tot = 0.f;
#pragma unroll
                    for (int s = 0; s < 4; ++s) { const float sv = Seg[s * 128 + dk + e]; tot += sv; if (s < sg) off += sv; }
                    const float b = BL[t * 128 + dk + e] + off;
                    qt[e] = q[e] * fexp(b) * 0.08838834764831845f; kt[e] = k[e] * fexp(-b);
                    KTs[(dk + e) * 72 + t] = f2bf(k[e] * fexp(tot - b));
                }
                u32x4 w; w.x = cvtpk(qt[0], qt[1]); w.y = cvtpk(qt[2], qt[3]); w.z = cvtpk(qt[4], qt[5]); w.w = cvtpk(qt[6], qt[7]);
                *(u32x4*)(Qs + t * 136 + dk) = w;
                w.x = cvtpk(kt[0], kt[1]); w.y = cvtpk(kt[2], kt[3]); w.z = cvtpk(kt[4], kt[5]); w.w = cvtpk(kt[6], kt[7]);
                *(u32x4*)(Ks + t * 136 + dk) = w;
            }
        }
#pragma unroll 1
        for (int it = 0; it < 4; ++it) {
            const int p = tid + 512 * it, t = p >> 5, dv = (p & 31) * 8;
            u32x4 vw = (u32x4){0, 0, 0, 0};
            if (t0 + t < L) vw = *(const u32x4*)(Zb + (size_t)(t0 + t) * NZ + ZC_V + hd * 256 + dv);
            VTs[(dv + 0) * 72 + t] = (bf16_t)(vw.x & 0xffff); VTs[(dv + 1) * 72 + t] = (bf16_t)(vw.x >> 16); VTs[(dv + 2) * 72 + t] = (bf16_t)(vw.y & 0xffff); VTs[(dv + 3) * 72 + t] = (bf16_t)(vw.y >> 16);
            VTs[(dv + 4) * 72 + t] = (bf16_t)(vw.z & 0xffff); VTs[(dv + 5) * 72 + t] = (bf16_t)(vw.z >> 16); VTs[(dv + 6) * 72 + t] = (bf16_t)(vw.w & 0xffff); VTs[(dv + 7) * 72 + t] = (bf16_t)(vw.w >> 16);
        }
        __syncthreads();
        if (wid < 4) {
            const int tbk = wid >> 1, sbk = wid & 1;
            f32x16 a = zero16();
            if (tbk >= sbk) {
#pragma unroll
                for (int ks = 0; ks < 8; ++ks) a = MFMA32(ld8(Qs + (tbk * 32 + r) * 136 + ks * 16 + hh * 8), ld8(Ks + (sbk * 32 + r) * 136 + ks * 16 + hh * 8), a);
            }
#pragma unroll
            for (int i = 0; i < 16; ++i) { const int t = tbk * 32 + crow(i, hh), s = sbk * 32 + r; As[t * 72 + s] = f2bf(s <= t ? a[i] : 0.f); }
        }
        f32x16 o[2]; o[0] = zero16(); o[1] = zero16();
#pragma unroll
        for (int d = 0; d < 4; ++d)
#pragma unroll
            for (int s = 0; s < 2; ++s) {
                const bf16x8 bS = pack8(S[d], s);
#pragma unroll
                for (int tbk = 0; tbk < 2; ++tbk) {
                    const bf16_t* qp = Qs + (tbk * 32 + r) * 136 + d * 32 + 16 * s + 4 * hh;
                    o[tbk] = MFMA32(cat44(qp, qp + 8), bS, o[tbk]);
                }
            }
        __syncthreads();
#pragma unroll
        for (int ks = 0; ks < 4; ++ks) {
            const bf16x8 bv = ld8(VTs + (wid * 32 + r) * 72 + ks * 16 + hh * 8);
#pragma unroll
            for (int tbk = 0; tbk < 2; ++tbk) o[tbk] = MFMA32(ld8(As + (tbk * 32 + r) * 72 + ks * 16 + hh * 8), bv, o[tbk]);
        }
#pragma unroll
        for (int d = 0; d < 4; ++d)
#pragma unroll
            for (int i = 0; i < 16; ++i) S[d][i] *= Dec[32 * d + crow(i, hh)];
#pragma unroll
        for (int ks = 0; ks < 4; ++ks) {
            const bf16x8 bv = ld8(VTs + (wid * 32 + r) * 72 + ks * 16 + hh * 8);
#pragma unroll
            for (int d = 0; d < 4; ++d) S[d] = MFMA32(ld8(KTs + (d * 32 + r) * 72 + ks * 16 + hh * 8), bv, S[d]);
        }
#pragma unroll
        for (int tbk = 0; tbk < 2; ++tbk)
#pragma unroll
            for (int i = 0; i < 16; ++i) {
                float v = o[tbk][i] * o[tbk][i];
                v += __shfl_xor(v, 1, 64); v += __shfl_xor(v, 2, 64); v += __shfl_xor(v, 4, 64); v += __shfl_xor(v, 8, 64); v += __shfl_xor(v, 16, 64);
                if (r == 0) SSq[wid * 64 + tbk * 32 + crow(i, hh)] = v;
            }
        __syncthreads();
#pragma unroll
        for (int tbk = 0; tbk < 2; ++tbk)
#pragma unroll
            for (int i = 0; i < 16; ++i) {
                const int tl = tbk * 32 + crow(i, hh), t = t0 + tl;
                float ss = 0.f;
#pragma unroll
                for (int w = 0; w < 8; ++w) ss += SSq[w * 64 + tl];
                const float rs = __builtin_amdgcn_rsqf(ss * (1.0f / 256.0f) + EPS);
                if (t < L && !dry) { bf16_t* p = Zb + (size_t)t * NZ + ZC_GB + hd * 256 + 32 * wid + r; *p = f2bf(o[tbk][i] * rs * gn * bf2f(*p)); }
            }
        __syncthreads();
    }
#pragma unroll
    for (int d = 0; d < 4; ++d)
#pragma unroll
        for (int i = 0; i < 16; ++i) if (!dry) Sout[(size_t)(32 * d + crow(i, hh)) * 256 + 32 * wid + r] = S[d][i];
}


DI void gla_pre_unit(char* smem, bf16_t* Zc, int hd, const float* wgate, const float* bgate, bf16_t* OIc, float* decp, int dry = 0) {
    float* BL = (float*)smem;
    bf16_t* Qs = (bf16_t*)(smem + 33792);
    bf16_t* Ks = Qs + 64 * 136;
    bf16_t* KTs = Ks + 64 * 136;
    bf16_t* VTs = KTs + 128 * 72;
    bf16_t* As = VTs + 256 * 72;
    float* ZRs = (float*)(As + 64 * 72);
    float* Seg = ZRs + 64 * 16;
    float* Pre = Seg + 512;
    float* Tot = Pre + 512;
    const int tid = ltid(), wid = tid >> 6, lane = tid & 63, r = lane & 31, hh = lane >> 5;
    const int gdk = tid & 127, gseg = tid >> 7;
    float wg[16];
#pragma unroll
    for (int j = 0; j < 16; ++j) wg[j] = wgate[j * 512 + hd * 128 + gdk];
    const float bg = bgate[hd * 128 + gdk];
    u32x4 gq[2], gk[2], gvv[4];
    { const int t = tid >> 3, d0 = (tid & 7) * 16;
#pragma unroll
      for (int h8 = 0; h8 < 2; ++h8) { gq[h8] = *(const u32x4*)(Zc + (size_t)t * NZ + ZC_Q + hd * 128 + d0 + h8 * 8); gk[h8] = *(const u32x4*)(Zc + (size_t)t * NZ + ZC_K + hd * 128 + d0 + h8 * 8); }
#pragma unroll
      for (int it = 0; it < 4; ++it) { const int p = tid + 512 * it; gvv[it] = *(const u32x4*)(Zc + (size_t)(p >> 5) * NZ + ZC_V + hd * 256 + (p & 31) * 8); } }
    for (int e = tid; e < 64 * 16; e += 512) { const int t = e >> 4, j = e & 15; ZRs[e] = bf2f(Zc[(size_t)t * NZ + ZC_ZR + j]); }
    __syncthreads();
    {
        float run = 0.f;
#pragma unroll 4
        for (int tt = 0; tt < 16; ++tt) {
            const int t = gseg * 16 + tt;
            float z = bg;
#pragma unroll
            for (int j4 = 0; j4 < 4; ++j4) { const f32x4 zz = *(const f32x4*)(ZRs + t * 16 + j4 * 4); z += zz[0] * wg[j4 * 4] + zz[1] * wg[j4 * 4 + 1] + zz[2] * wg[j4 * 4 + 2] + zz[3] * wg[j4 * 4 + 3]; }
            run += -fsoftplus(-z) * (1.0f / 16.0f); BL[t * 132 + gdk] = run;
        }
        Seg[gseg * 128 + gdk] = run;
    }
    __syncthreads();
    if (tid < 128) { const float s0 = Seg[tid], s1 = Seg[128 + tid], s2 = Seg[256 + tid], s3 = Seg[384 + tid];
        Pre[tid] = 0.f; Pre[128 + tid] = s0; Pre[256 + tid] = s0 + s1; Pre[384 + tid] = s0 + s1 + s2; Tot[tid] = s0 + s1 + s2 + s3; decp[tid] = fexp(s0 + s1 + s2 + s3); }
    __syncthreads();
    {
        const int t = tid >> 3, d0 = (tid & 7) * 16, sg = t >> 4;
#pragma unroll
        for (int half8 = 0; half8 < 2; ++half8) {
            const int dk = d0 + half8 * 8;
            const u32x4 qw = gq[half8], kw = gk[half8];
            float q[8] = {lo2f(qw.x), hi2f(qw.x), lo2f(qw.y), hi2f(qw.y), lo2f(qw.z), hi2f(qw.z), lo2f(qw.w), hi2f(qw.w)};
            float k[8] = {lo2f(kw.x), hi2f(kw.x), lo2f(kw.y), hi2f(kw.y), lo2f(kw.z), hi2f(kw.z), lo2f(kw.w), hi2f(kw.w)};
            float qt[8], kt[8];
            const f32x4 bl0 = *(const f32x4*)(BL + t * 132 + dk), bl1 = *(const f32x4*)(BL + t * 132 + dk + 4), pr0 = *(const f32x4*)(Pre + sg * 128 + dk), pr1 = *(const f32x4*)(Pre + sg * 128 + dk + 4);
            const f32x4 to0 = *(const f32x4*)(Tot + dk), to1 = *(const f32x4*)(Tot + dk + 4);
            const int kcol = (((t >> 3) ^ ((dk >> 3) & 7)) << 3) + (t & 7);
#pragma unroll
            for (int e = 0; e < 8; ++e) {
                const float b = (e < 4 ? bl0[e & 3] + pr0[e & 3] : bl1[e & 3] + pr1[e & 3]), tot = (e < 4 ? to0[e & 3] : to1[e & 3]);
                qt[e] = q[e] * fexp(b) * 0.08838834764831845f; kt[e] = k[e] * fexp(-b);
                KTs[(dk + e) * 72 + kcol] = f2bf(k[e] * fexp(tot - b));
            }
            u32x4 w; w.x = cvtpk(qt[0], qt[1]); w.y = cvtpk(qt[2], qt[3]); w.z = cvtpk(qt[4], qt[5]); w.w = cvtpk(qt[6], qt[7]);
            *(u32x4*)(Qs + t * 136 + dk) = w;
            w.x = cvtpk(kt[0], kt[1]); w.y = cvtpk(kt[2], kt[3]); w.z = cvtpk(kt[4], kt[5]); w.w = cvtpk(kt[6], kt[7]);
            *(u32x4*)(Ks + t * 136 + dk) = w;
        }
    }
#pragma unroll
    for (int it = 0; it < 4; ++it) {
        const int p = tid + 512 * it, t = p >> 5, dv = (p & 31) * 8;
        const u32x4 vw = gvv[it];
        const int vcol = (((t >> 3) ^ ((dv >> 3) & 7)) << 3) + (t & 7);
        VTs[(dv + 0) * 72 + vcol] = (bf16_t)(vw.x & 0xffff); VTs[(dv + 1) * 72 + vcol] = (bf16_t)(vw.x >> 16); VTs[(dv + 2) * 72 + vcol] = (bf16_t)(vw.y & 0xffff); VTs[(dv + 3) * 72 + vcol] = (bf16_t)(vw.y >> 16);
        VTs[(dv + 4) * 72 + vcol] = (bf16_t)(vw.z & 0xffff); VTs[(dv + 5) * 72 + vcol] = (bf16_t)(vw.z >> 16); VTs[(dv + 6) * 72 + vcol] = (bf16_t)(vw.w & 0xffff); VTs[(dv + 7) * 72 + vcol] = (bf16_t)(vw.w >> 16);
    }
    __syncthreads();
    if (wid < 4) {
        const int tbk = wid >> 1, sbk = wid & 1;
        f32x16 a = zero16();
        if (tbk >= sbk) {
#pragma unroll
            for (int ks = 0; ks < 8; ++ks) a = MFMA32(ld8(Qs + (tbk * 32 + r) * 136 + ks * 16 + hh * 8), ld8(Ks + (sbk * 32 + r) * 136 + ks * 16 + hh * 8), a);
        }
#pragma unroll
        for (int i = 0; i < 16; ++i) { const int t = tbk * 32 + crow(i, hh), s2 = sbk * 32 + r; As[t * 72 + s2] = f2bf(s2 <= t ? a[i] : 0.f); }
    }
    if (!dry) {
#pragma unroll
    for (int it = 0; it < 2; ++it) { const int p = tid + 512 * it;
        { const int t = p >> 4, pc = p & 15; *(u32x4*)(Zc + (size_t)t * NZ + ZC_Q + hd * 128 + pc * 8) = *(const u32x4*)(Qs + t * 136 + pc * 8); }
        { const int dk = p >> 3, tp = p & 7, idx = dk * 64 + tp * 8; *(u32x4*)(Zc + (size_t)(idx >> 7) * NZ + ZC_K + hd * 128 + (idx & 127)) = *(const u32x4*)(KTs + dk * 72 + ((tp ^ ((dk >> 3) & 7)) << 3)); } }
#pragma unroll
    for (int it = 0; it < 4; ++it) { const int p = tid + 512 * it, dv = p >> 3, tp = p & 7, idx = dv * 64 + tp * 8;
        *(u32x4*)(Zc + (size_t)(idx >> 8) * NZ + ZC_V + hd * 256 + (idx & 255)) = *(const u32x4*)(VTs + dv * 72 + ((tp ^ ((dv >> 3) & 7)) << 3)); }
    }
    __syncthreads();
    f32x16 o[2]; o[0] = zero16(); o[1] = zero16();
#pragma unroll
    for (int ks = 0; ks < 4; ++ks) {
        const int dvr = wid * 32 + r; const bf16x8 bv = ld8(VTs + dvr * 72 + (((ks * 2 + hh) ^ ((dvr >> 3) & 7)) << 3));
#pragma unroll
        for (int tbk = 0; tbk < 2; ++tbk) o[tbk] = MFMA32(ld8(As + (tbk * 32 + r) * 72 + ks * 16 + hh * 8), bv, o[tbk]);
    }
    {
        bf16_t* op = OIc + ((size_t)wid * 64 + lane) * 32;
#pragma unroll
        for (int tbk = 0; tbk < 2; ++tbk)
#pragma unroll
            for (int g = 0; g < 2; ++g) { u32x4 w; w.x = cvtpk(o[tbk][8 * g], o[tbk][8 * g + 1]); w.y = cvtpk(o[tbk][8 * g + 2], o[tbk][8 * g + 3]); w.z = cvtpk(o[tbk][8 * g + 4], o[tbk][8 * g + 5]); w.w = cvtpk(o[tbk][8 * g + 6], o[tbk][8 * g + 7]);
                if (!dry) *(u32x4*)(op + tbk * 16 + g * 8) = w; }
    }
    __syncthreads();
}

DI void gla_seq_unit(char* smem, const bf16_t* Zb, int hd, bf16_t* OIb  , const float* DECb, float* Sout, int dry = 0) {
    constexpr int SEQBUF = 64 * 136 + 128 * 72 + 256 * 72;
    bf16_t* Qt = (bf16_t*)smem;
    bf16_t* KTt = Qt + 64 * 136;
    bf16_t* VTt = KTt + 128 * 72;
    float* Dec = (float*)(Qt + 2 * SEQBUF);
    const int tid = ltid(), wid = tid >> 6, lane = tid & 63, r = lane & 31, hh = lane >> 5;
    f32x16 S[4];
#pragma unroll
    for (int d = 0; d < 4; ++d) S[d] = zero16();
    u32x4 pq[2], pk[2], pv[4]; float pd = 0.f;
    auto gload = [&](int ch) {
        const bf16_t* Zc = Zb + (size_t)ch * 64 * NZ;
#pragma unroll
        for (int it = 0; it < 2; ++it) { const int p = tid + 512 * it, row = p >> 4, col = (p & 15) * 8;
            pq[it] = *(const u32x4*)(Zc + (size_t)row * NZ + ZC_Q + hd * 128 + col); pk[it] = *(const u32x4*)(Zc + (size_t)row * NZ + ZC_K + hd * 128 + col); }
#pragma unroll
        for (int it = 0; it < 4; ++it) { const int p = tid + 512 * it, row = p >> 5, col = (p & 31) * 8; pv[it] = *(const u32x4*)(Zc + (size_t)row * NZ + ZC_V + hd * 256 + col); }
        if (tid < 128) pd = DECb[ch * 128 + tid];
    };
    auto lstore = [&](int bsel) {
        const int bo = bsel * SEQBUF;
#pragma unroll
        for (int it = 0; it < 2; ++it) { const int p = tid + 512 * it;
            *(u32x4*)(Qt + bo + (p >> 4) * 136 + (p & 15) * 8) = pq[it];
            *(u32x4*)(KTt + bo + (p >> 3) * 72 + (p & 7) * 8) = pk[it]; }
#pragma unroll
        for (int it = 0; it < 4; ++it) { const int p = tid + 512 * it; *(u32x4*)(VTt + bo + (p >> 3) * 72 + (p & 7) * 8) = pv[it]; }
        if (tid < 128) Dec[bsel * 128 + tid] = pd;
    };
    gload(0); lstore(0);
    if (SEQ / 64 > 1) gload(1);
    __syncthreads();
    for (int ch = 0; ch < SEQ / 64; ++ch) {
        const int bo = (ch & 1) * SEQBUF;
        bf16_t* op = OIb + (((size_t)ch * 8 + wid) * 64 + lane) * 32;
        u32x4 oi[4];
#pragma unroll
        for (int g = 0; g < 4; ++g) oi[g] = *(const u32x4*)(op + g * 8);
        f32x16 o[2], o2[2]; o[0] = zero16(); o[1] = zero16(); o2[0] = zero16(); o2[1] = zero16();
#pragma unroll
        for (int d = 0; d < 4; ++d)
#pragma unroll
            for (int s = 0; s < 2; ++s) {
                const bf16x8 bS = pack8(S[d], s);
#pragma unroll
                for (int tbk = 0; tbk < 2; ++tbk) { const bf16_t* qp = Qt + bo + (tbk * 32 + r) * 136 + d * 32 + 16 * s + 4 * hh;
                    if (d < 2) o[tbk] = MFMA32(cat44(qp, qp + 8), bS, o[tbk]); else o2[tbk] = MFMA32(cat44(qp, qp + 8), bS, o2[tbk]); }
            }
        o[0] = o[0] + o2[0]; o[1] = o[1] + o2[1];
#pragma unroll
        for (int d = 0; d < 4; ++d)
#pragma unroll
            for (int g = 0; g < 4; ++g) { const f32x4 dv4 = *(const f32x4*)(Dec + (ch & 1) * 128 + 32 * d + 8 * g + 4 * hh);
                S[d][4 * g] *= dv4[0]; S[d][4 * g + 1] *= dv4[1]; S[d][4 * g + 2] *= dv4[2]; S[d][4 * g + 3] *= dv4[3]; }
#pragma unroll
        for (int ks = 0; ks < 4; ++ks) {
            const bf16x8 bv = ld8(VTt + bo + (wid * 32 + r) * 72 + ks * 16 + hh * 8);
#pragma unroll
            for (int d = 0; d < 4; ++d) S[d] = MFMA32(ld8(KTt + bo + (d * 32 + r) * 72 + ks * 16 + hh * 8), bv, S[d]);
        }
#pragma unroll
        for (int g = 0; g < 4; ++g) { const int tbk = g >> 1, i0 = (g & 1) * 8; const unsigned ou[4] = {oi[g].x, oi[g].y, oi[g].z, oi[g].w}; u32x4 w;
            w.x = cvtpk(o[tbk][i0 + 0] + lo2f(ou[0]), o[tbk][i0 + 1] + hi2f(ou[0])); w.y = cvtpk(o[tbk][i0 + 2] + lo2f(ou[1]), o[tbk][i0 + 3] + hi2f(ou[1]));
            w.z = cvtpk(o[tbk][i0 + 4] + lo2f(ou[2]), o[tbk][i0 + 5] + hi2f(ou[2])); w.w = cvtpk(o[tbk][i0 + 6] + lo2f(ou[3]), o[tbk][i0 + 7] + hi2f(ou[3]));
            if (!dry) *(u32x4*)(op + g * 8) = w; }
        if (ch + 1 < SEQ / 64) lstore((ch + 1) & 1);
        if (ch + 2 < SEQ / 64) gload(ch + 2);
        __syncthreads();
    }
#pragma unroll
    for (int d = 0; d < 4; ++d)
#pragma unroll
        for (int i = 0; i < 16; ++i) Sout[(size_t)(32 * d + crow(i, hh)) * 256 + 32 * wid + r] = S[d][i];
}
DI void gla_post_unit(char* smem, bf16_t* Zc, int hd, const bf16_t* OIc, const float* gnorm, int dry = 0) {
    float* SSq = (float*)smem;
    float* RS = SSq + 512;
    const int tid = ltid(), wid = tid >> 6, lane = tid & 63, r = lane & 31, hh = lane >> 5;
    const float gn = gnorm[32 * wid + r];
    float o[32];
    const bf16_t* op = OIc + ((size_t)wid * 64 + lane) * 32;
#pragma unroll
    for (int g = 0; g < 4; ++g) { const u32x4 w = *(const u32x4*)(op + g * 8);
        o[g * 8 + 0] = lo2f(w.x); o[g * 8 + 1] = hi2f(w.x); o[g * 8 + 2] = lo2f(w.y); o[g * 8 + 3] = hi2f(w.y); o[g * 8 + 4] = lo2f(w.z); o[g * 8 + 5] = hi2f(w.z); o[g * 8 + 6] = lo2f(w.w); o[g * 8 + 7] = hi2f(w.w); }
    bf16_t gv[32];
#pragma unroll
    for (int e = 0; e < 32; ++e) gv[e] = Zc[(size_t)((e >> 4) * 32 + crow(e & 15, hh)) * NZ + ZC_GB + hd * 256 + 32 * wid + r];
    float v[32];
#pragma unroll
    for (int e = 0; e < 32; ++e) v[e] = o[e] * o[e];
#pragma unroll
    for (int k = 0; k < 16; ++k) { const bool up = (r & 16) != 0; const float keep = up ? v[16 + k] : v[k], send = up ? v[k] : v[16 + k]; v[k] = keep + __shfl_xor(send, 16, 64); }
#pragma unroll
    for (int k = 0; k < 8; ++k) { const bool up = (r & 8) != 0; const float keep = up ? v[8 + k] : v[k], send = up ? v[k] : v[8 + k]; v[k] = keep + __shfl_xor(send, 8, 64); }
#pragma unroll
    for (int k = 0; k < 4; ++k) { const bool up = (r & 4) != 0; const float keep = up ? v[4 + k] : v[k], send = up ? v[k] : v[4 + k]; v[k] = keep + __shfl_xor(send, 4, 64); }
#pragma unroll
    for (int k = 0; k < 2; ++k) { const bool up = (r & 2) != 0; const float keep = up ? v[2 + k] : v[k], send = up ? v[k] : v[2 + k]; v[k] = keep + __shfl_xor(send, 2, 64); }
    { const bool up = (r & 1) != 0; const float keep = up ? v[1] : v[0], send = up ? v[0] : v[1]; v[0] = keep + __shfl_xor(send, 1, 64); }
    SSq[wid * 64 + (r >> 4) * 32 + crow(r & 15, hh)] = v[0];
    __syncthreads();
    if (tid < 64) { float ss = 0.f;
#pragma unroll
        for (int w = 0; w < 8; ++w) ss += SSq[w * 64 + tid];
        RS[tid] = __builtin_amdgcn_rsqf(ss * (1.0f / 256.0f) + EPS); }
    __syncthreads();
#pragma unroll
    for (int e = 0; e < 32; ++e) {
        const int tl = (e >> 4) * 32 + crow(e & 15, hh);
        bf16_t* p = Zc + (size_t)tl * NZ + ZC_GB + hd * 256 + 32 * wid + r; const float v_ = o[e] * RS[tl] * gn * bf2f(gv[e]); if (!dry) *p = f2bf(v_);
    }
    __syncthreads();
}

DI void lru_pre_multi(char* smem, const bf16_t* Z, int idx0, int cnt, int n, int half, const float* convw, const float* convb, const bf16_t* WAT, const bf16_t* WXT,
                      const float* ba, const float* bx, const float* lam, bf16_t* HL, bf16_t* AC, float* TA, float* TU, float* conv_all) {
    bf16_t* Xc = (bf16_t*)smem;
    float* SumA = (float*)(smem + 128 * 136 * 2);
    float* SumU = SumA + 256;
    const int tid = ltid(), wid = tid >> 6, lane = tid & 63, r = lane & 31, hh = lane >> 5, tb = wid >> 1, cb = wid & 1;
    const int cl = half * 64 + cb * 32 + r, cg_ = n * 128 + cl;
    const float b_a = ba[cg_], b_x = bx[cg_], sp = fsoftplus(-lam[cg_]);
    bf16x8 wa[8], wx[8];
#pragma unroll
    for (int ks = 0; ks < 8; ++ks) { wa[ks] = ld8(WAT + ((size_t)n * 128 + cl) * 128 + ks * 16 + hh * 8); wx[ks] = ld8(WXT + ((size_t)n * 128 + cl) * 128 + ks * 16 + hh * 8); }
    const int sc = (tid & 15) * 8, st = (tid >> 4) * 4;
    float cw[4][8], cbias[8];
#pragma unroll
    for (int j = 0; j < 4; ++j) { const f32x4 w0 = *(const f32x4*)(convw + j * 1024 + n * 128 + sc), w1 = *(const f32x4*)(convw + j * 1024 + n * 128 + sc + 4);
#pragma unroll
        for (int e = 0; e < 4; ++e) { cw[j][e] = w0[e]; cw[j][4 + e] = w1[e]; } }
    { const f32x4 w0 = *(const f32x4*)(convb + n * 128 + sc), w1 = *(const f32x4*)(convb + n * 128 + sc + 4);
#pragma unroll
        for (int e = 0; e < 4; ++e) { cbias[e] = w0[e]; cbias[4 + e] = w1[e]; } }
    u32x4 xw[7];
    auto xload = [&](int idx_) { const int bb_ = idx_ >> 4, t0_ = (idx_ & 15) * 128; const bf16_t* Zb_ = Z + (size_t)bb_ * SEQ * NZ;
#pragma unroll
        for (int j = 0; j < 7; ++j) { const int t = t0_ + st - 3 + j; xw[j] = (u32x4){0u, 0u, 0u, 0u}; if (t >= 0) xw[j] = *(const u32x4*)(Zb_ + (size_t)t * NZ + ZC_XA + n * 128 + sc); } };
    xload(idx0);
    for (int kk = 0; kk < cnt; ++kk) {
    const int idx = idx0 + kk, bb = idx >> 4, step = idx & 15;
    const bf16_t* Zb = Z + (size_t)bb * SEQ * NZ; bf16_t* HLb = HL + (size_t)bb * SEQ * 1024; bf16_t* ACb = AC + (size_t)bb * SEQ * 1024;
    float* TAp = TA + (size_t)idx * 1024; float* TUp = TU + (size_t)idx * 1024; float* conv_out = step == 15 ? conv_all + (size_t)bb * 3 * 1024 : nullptr;
    const int t0 = step * 128;
    if (conv_out && tid < 192) { const int j = tid >> 6, c = n * 128 + half * 64 + (tid & 63); conv_out[j * 1024 + c] = bf2f(Zb[(size_t)(SEQ - 3 + j) * NZ + ZC_XA + c]); }
    {
        float xr[7][8];
#pragma unroll
        for (int j = 0; j < 7; ++j) { const u32x4 w = xw[j];
            xr[j][0] = lo2f(w.x); xr[j][1] = hi2f(w.x); xr[j][2] = lo2f(w.y); xr[j][3] = hi2f(w.y); xr[j][4] = lo2f(w.z); xr[j][5] = hi2f(w.z); xr[j][6] = lo2f(w.w); xr[j][7] = hi2f(w.w); }
#pragma unroll
        for (int q = 0; q < 4; ++q) {
            float o[8];
#pragma unroll
            for (int e = 0; e < 8; ++e) o[e] = cbias[e] + cw[0][e] * xr[q][e] + cw[1][e] * xr[q + 1][e] + cw[2][e] * xr[q + 2][e] + cw[3][e] * xr[q + 3][e];
            u32x4 w; w.x = cvtpk(o[0], o[1]); w.y = cvtpk(o[2], o[3]); w.z = cvtpk(o[4], o[5]); w.w = cvtpk(o[6], o[7]);
            *(u32x4*)(Xc + (st + q) * 136 + sc) = w;
        }
    }
    if (kk + 1 < cnt) xload(idx + 1);
    __syncthreads();
    f32x16 accr = zero16(), acci = zero16();
#pragma unroll
    for (int ks = 0; ks < 8; ++ks) {
        const bf16x8 a = ld8(Xc + (tb * 32 + r) * 136 + ks * 16 + hh * 8);
        accr = MFMA32(a, wa[ks], accr); acci = MFMA32(a, wx[ks], acci);
    }
    float av[16], uv[16];
#pragma unroll
    for (int i = 0; i < 16; ++i) {
        const int tl = tb * 32 + crow(i, hh);
        const float xf = bf2f(Xc[tl * 136 + cl]);
        const float rg = fsigmoid(accr[i] + b_a), ig = fsigmoid(acci[i] + b_x);
        const float la = -8.0f * rg * sp;
        av[i] = fexp(la); uv[i] = __builtin_sqrtf(neg_expm1(2.0f * la)) * (ig * xf);
    }
    float PA[4], PU[4];
#pragma unroll
    for (int g = 0; g < 4; ++g) {
        float A = av[4 * g], U = uv[4 * g];
#pragma unroll
        for (int k = 1; k < 4; ++k) { U = av[4 * g + k] * U + uv[4 * g + k]; A *= av[4 * g + k]; uv[4 * g + k] = U; av[4 * g + k] = A; }
        PA[g] = A; PU[g] = U;
    }
    float QA[4], QU[4];
#pragma unroll
    for (int g = 0; g < 4; ++g) { QA[g] = __shfl_xor(PA[g], 32, 64); QU[g] = __shfl_xor(PU[g], 32, 64); }
    float gA[4], gU[4]; float CA = 1.f, CU = 0.f;
#pragma unroll
    for (int g = 0; g < 4; ++g) {
        if (hh == 0) { gA[g] = CA; gU[g] = CU; CU = PA[g] * CU + PU[g]; CA = PA[g] * CA; CU = QA[g] * CU + QU[g]; CA = QA[g] * CA; }
        else { CU = QA[g] * CU + QU[g]; CA = QA[g] * CA; gA[g] = CA; gU[g] = CU; CU = PA[g] * CU + PU[g]; CA = PA[g] * CA; }
    }
    if (hh == 0) { SumA[tb * 64 + cb * 32 + r] = CA; SumU[tb * 64 + cb * 32 + r] = CU; }
    __syncthreads();
    float pA = 1.f, pU = 0.f;
    for (int j = 0; j < tb; ++j) { const float sa = SumA[j * 64 + cb * 32 + r], su = SumU[j * 64 + cb * 32 + r]; pU = sa * pU + su; pA = sa * pA; }
#pragma unroll
    for (int g = 0; g < 4; ++g)
#pragma unroll
        for (int k = 0; k < 4; ++k) {
            const int i = 4 * g + k, t = t0 + tb * 32 + crow(i, hh);
            HLb[(size_t)t * 1024 + cg_] = f2bf(uv[i] + av[i] * (gA[g] * pU + gU[g]));
            ACb[(size_t)t * 1024 + cg_] = f2bf(av[i] * gA[g] * pA);
        }
    if (tb == 3 && hh == 0) { TAp[cg_] = CA * pA; TUp[cg_] = CA * pU + CU; }
    __syncthreads();
    }
}
DI void lru_fix_seq(bf16_t* Zb, int n, int q4, const bf16_t* HLb, const bf16_t* ACb, const float* TAb  , const float* TUb, float* h_out, int dry = 0) {
    const int tid = ltid(), c0 = n * 128 + q4 * 32 + (tid & 3) * 8, tl = tid >> 2;
    float carry[8];
#pragma unroll
    for (int e = 0; e < 8; ++e) carry[e] = 0.f;
    for (int s0 = 0; s0 < 16; s0 += 4) {
        u32x4 hw[4], aw[4], gw[4]; f32x4 ta0[4], ta1[4], tu0[4], tu1[4];
#pragma unroll
        for (int k = 0; k < 4; ++k) { const int stp = s0 + k, t = stp * 128 + tl;
            hw[k] = *(const u32x4*)(HLb + (size_t)t * 1024 + c0); aw[k] = *(const u32x4*)(ACb + (size_t)t * 1024 + c0); gw[k] = *(const u32x4*)(Zb + (size_t)t * NZ + ZC_GA + c0);
            ta0[k] = *(const f32x4*)(TAb + stp * 1024 + c0); ta1[k] = *(const f32x4*)(TAb + stp * 1024 + c0 + 4); tu0[k] = *(const f32x4*)(TUb + stp * 1024 + c0); tu1[k] = *(const f32x4*)(TUb + stp * 1024 + c0 + 4); }
#pragma unroll
        for (int k = 0; k < 4; ++k) {
            const int t = (s0 + k) * 128 + tl;
            const unsigned hu[4] = {hw[k].x, hw[k].y, hw[k].z, hw[k].w}, au[4] = {aw[k].x, aw[k].y, aw[k].z, aw[k].w}, gu[4] = {gw[k].x, gw[k].y, gw[k].z, gw[k].w};
            float h[8]; unsigned ou[4];
#pragma unroll
            for (int e = 0; e < 4; ++e) {
                h[2 * e] = lo2f(hu[e]) + lo2f(au[e]) * carry[2 * e]; h[2 * e + 1] = hi2f(hu[e]) + hi2f(au[e]) * carry[2 * e + 1];
                ou[e] = cvtpk(h[2 * e] * lo2f(gu[e]), h[2 * e + 1] * hi2f(gu[e]));
            }
            if (!dry) *(u32x4*)(Zb + (size_t)t * NZ + ZC_GA + c0) = (u32x4){ou[0], ou[1], ou[2], ou[3]};
            if (t == SEQ - 1) {
#pragma unroll
                for (int e = 0; e < 8; ++e) h_out[c0 + e] = h[e];
            }
#pragma unroll
            for (int e = 0; e < 4; ++e) { carry[e] = ta0[k][e] * carry[e] + tu0[k][e]; carry[4 + e] = ta1[k][e] * carry[4 + e] + tu1[k][e]; }
        }
    }
}

template <int NKS, class QF>
DI void qk_tile(const bf16_t* Kt, int kstr, const QF& qf, f32x16& s0, f32x16& s1, int r, int hh) {
    s0 = zero16(); s1 = zero16();
#pragma unroll
    for (int s = 0; s < NKS; ++s) {
        const bf16x8 q = qf(s);
        s0 = MFMA32(ld8(Kt + r * kstr + s * 16 + hh * 8), q, s0);
        s1 = MFMA32(ld8(Kt + (32 + r) * kstr + s * 16 + hh * 8), q, s1);
    }
}
template <int NKS, int NBATCH>
DI void qk_tile_stream(const bf16_t* Kt, int kstr, const bf16_t* qrow, f32x16& s0, f32x16& s1, int r, int hh) {
    s0 = zero16(); s1 = zero16();
#pragma unroll
    for (int b0 = 0; b0 < NKS; b0 += NBATCH) {
        bf16x8 q[NBATCH];
#pragma unroll
        for (int k = 0; k < NBATCH; ++k) q[k] = ld8(qrow + (b0 + k) * 16 + hh * 8);
#pragma unroll
        for (int k = 0; k < NBATCH; ++k) { const int s = b0 + k;
            s0 = MFMA32(ld8(Kt + r * kstr + s * 16 + hh * 8), q[k], s0);
            s1 = MFMA32(ld8(Kt + (32 + r) * kstr + s * 16 + hh * 8), q[k], s1); }
    }
}
template <int NDB>
DI void softmax_pv_tile(f32x16 s0, f32x16 s1, const bf16_t* Vt, int vstr, f32x16 (&o)[NDB], float& m, float& l, int nvalid, int r, int hh) {
    if (nvalid < 64) {
#pragma unroll
        for (int i = 0; i < 16; ++i) { if (crow(i, hh) >= nvalid) s0[i] = -INFINITY; if (32 + crow(i, hh) >= nvalid) s1[i] = -INFINITY; }
    }
    float mx = s0[0];
#pragma unroll
    for (int i = 1; i < 16; ++i) mx = fmaxf(mx, s0[i]);
#pragma unroll
    for (int i = 0; i < 16; ++i) mx = fmaxf(mx, s1[i]);
    mx = fmaxf(mx, __shfl_xor(mx, 32, 64));
    const float mn = fmaxf(m, mx), alpha = __builtin_amdgcn_exp2f(m - mn);
    float rs = 0.f;
#pragma unroll
    for (int i = 0; i < 16; ++i) { s0[i] = __builtin_amdgcn_exp2f(s0[i] - mn); s1[i] = __builtin_amdgcn_exp2f(s1[i] - mn); rs += s0[i] + s1[i]; }
    rs += __shfl_xor(rs, 32, 64);
    l = l * alpha + rs; m = mn;
#pragma unroll
    for (int d = 0; d < NDB; ++d)
#pragma unroll
        for (int i = 0; i < 16; ++i) o[d][i] *= alpha;
    const bf16x8 p00 = pack8(s0, 0), p01 = pack8(s0, 1), p10 = pack8(s1, 0), p11 = pack8(s1, 1);
#pragma unroll
    for (int d = 0; d < NDB; ++d) {
        const bf16_t* vp = Vt + (d * 32 + r) * vstr + 4 * hh;
        o[d] = MFMA32(cat44(vp, vp + 8), p00, o[d]);
        o[d] = MFMA32(cat44(vp + 16, vp + 24), p01, o[d]);
        o[d] = MFMA32(cat44(vp + 32, vp + 40), p10, o[d]);
        o[d] = MFMA32(cat44(vp + 48, vp + 56), p11, o[d]);
    }
}
template <int NKS, int NDB, class QF>
DI void flash_tile(const bf16_t* Kt, int kstr, const bf16_t* Vt, int vstr, const QF& qf, f32x16 (&o)[NDB], float& m, float& l, int nvalid, int r, int hh) {
    f32x16 s0, s1;
    qk_tile<NKS>(Kt, kstr, qf, s0, s1, r, hh);
    softmax_pv_tile<NDB>(s0, s1, Vt, vstr, o, m, l, nvalid, r, hh);
}

DI void attn_prompt_unit(char* smem, int b, int hd, int qb, bf16_t* QN, const bf16_t* KN, const bf16_t* KPE, const bf16_t* VT, int dry = 0) {
    constexpr int KSTR = 104, VSTR = 72, KB = 64 * KSTR, VB = 64 * VSTR;
    bf16_t* Kb = (bf16_t*)smem;
    bf16_t* Vb = Kb + 3 * KB;
    const int tid = ltid(), wid = tid >> 6, lane = tid & 63, r = lane & 31, hh = lane >> 5;
    const size_t tok0 = (size_t)b * SEQ;
    const int qrow = qb * 256 + wid * 32 + r;
    bf16x8 qf[6];
#pragma unroll
    for (int s = 0; s < 4; ++s) qf[s] = ld8(QN + (tok0 + qrow) * NQ + hd * 64 + s * 16 + hh * 8);
#pragma unroll
    for (int s = 0; s < 2; ++s) qf[4 + s] = ld8(QN + (tok0 + qrow) * NQ + 1024 + hd * 32 + s * 16 + hh * 8);
    f32x16 o[2]; o[0] = zero16(); o[1] = zero16();
    float m = -INFINITY, l = 0.f;
    const int ntiles = 4 * qb + 4, myl = 4 * qb + (wid >> 1);
    const int sr = tid >> 3, sp = tid & 7;
    u32x4 kreg, vreg, preg = (u32x4){0, 0, 0, 0};
    auto gloadK = [&](int kt) { const size_t key = tok0 + (size_t)kt * 64;
        kreg = *(const u32x4*)(KN + (key + sr) * 1024 + hd * 64 + sp * 8);
        if (tid < 256) preg = *(const u32x4*)(KPE + (key + (tid >> 2)) * 32 + (tid & 3) * 8); };
    auto gloadV = [&](int kt) { const size_t key = tok0 + (size_t)kt * 64; vreg = *(const u32x4*)(VT + (size_t)(hd * 64 + sr) * MP + key + sp * 8); };
    auto lstoreK = [&](int bi) { *(u32x4*)(Kb + bi * KB + sr * KSTR + sp * 8) = kreg; if (tid < 256) *(u32x4*)(Kb + bi * KB + (tid >> 2) * KSTR + 64 + (tid & 3) * 8) = preg; };
    auto lstoreV = [&](int bi) { *(u32x4*)(Vb + bi * VB + sr * VSTR + sp * 8) = vreg; };
    {
        gloadK(0); gloadV(0);
        const u32x4 k0 = kreg, p0 = preg;
        gloadK(1);
        const u32x4 k1 = kreg, p1 = preg;
        kreg = k0; preg = p0; lstoreK(0); lstoreV(0);
        kreg = k1; preg = p1; lstoreK(1);
    }
    __syncthreads();
    f32x16 c0 = zero16(), c1 = zero16(), n0 = zero16(), n1 = zero16();
    qk_tile<6>(Kb, KSTR, [&](int s) { return qf[s]; }, c0, c1, r, hh);
    for (int kt = 0; kt < ntiles; ++kt) {
        if (kt + 2 < ntiles) gloadK(kt + 2);
        if (kt + 1 < ntiles) gloadV(kt + 1);
        if (kt + 1 < ntiles && kt + 1 <= myl) qk_tile<6>(Kb + ((kt + 1) % 3) * KB, KSTR, [&](int s) { return qf[s]; }, n0, n1, r, hh);
        if (kt <= myl) softmax_pv_tile<2>(c0, c1, Vb + (kt & 1) * VB, VSTR, o, m, l, 64, r, hh);
        if (kt + 2 < ntiles) lstoreK((kt + 2) % 3);
        if (kt + 1 < ntiles) lstoreV((kt + 1) & 1);
        __syncthreads();
        c0 = n0; c1 = n1;
    }
    const float inv = frcp(l);
#pragma unroll
    for (int d = 0; d < 2; ++d)
#pragma unroll
        for (int g = 0; g < 4; ++g) {
            u32x2 w; w.x = cvtpk(o[d][4 * g] * inv, o[d][4 * g + 1] * inv); w.y = cvtpk(o[d][4 * g + 2] * inv, o[d][4 * g + 3] * inv);
            if (!dry) *(u32x2*)(QN + (tok0 + qrow) * NQ + hd * 64 + d * 32 + 8 * g + 4 * hh) = w;
        }
    __syncthreads();
}

DI void attn_sample_unit(char* smem, int b, int sp, const bf16_t* QLAT, const bf16_t* CC, const bf16_t* CCT, bf16_t* OP, float* ML) {
    constexpr int KSTR = 296, VSTR = 72;
    bf16_t* Kt = (bf16_t*)smem;
    bf16_t* Vt = (bf16_t*)(smem + 64 * KSTR * 2);
    const int tid = ltid(), wid = tid >> 6, lane = tid & 63, r = lane & 31, hh = lane >> 5;
    const bf16_t* qrow = QLAT + ((size_t)b * 256 + wid * 32 + r) * DLAT;
    f32x16 o[8];
#pragma unroll
    for (int d = 0; d < 8; ++d) o[d] = zero16();
    float m = -INFINITY, l = 0.f;
    for (int kt = (NKT * sp) / NSPLIT; kt < (NKT * (sp + 1)) / NSPLIT; ++kt) {
        const int key0 = kt * 64;
        {
            u32x4 kk[5], vv[4];
#pragma unroll
            for (int it = 0; it < 5; ++it) { const int p = tid + 512 * it; kk[it] = (u32x4){0u, 0u, 0u, 0u}; if (p < 64 * 36) { const int row = p / 36, pc = p % 36; kk[it] = *(const u32x4*)(CC + ((size_t)b * KEYP + key0 + row) * DLAT + pc * 8); } }
#pragma unroll
            for (int it = 0; it < 4; ++it) { const int p = tid + 512 * it, row = p >> 3, pc = p & 7; vv[it] = *(const u32x4*)(CCT + ((size_t)b * 256 + row) * KEYP + key0 + pc * 8); }
#pragma unroll
            for (int it = 0; it < 5; ++it) { const int p = tid + 512 * it; if (p < 64 * 36) { const int row = p / 36, pc = p % 36; *(u32x4*)(Kt + row * KSTR + pc * 8) = kk[it]; } }
#pragma unroll
            for (int it = 0; it < 4; ++it) { const int p = tid + 512 * it, row = p >> 3, pc = p & 7; *(u32x4*)(Vt + row * VSTR + pc * 8) = vv[it]; }
        }
        __syncthreads();
        const int nvalid = (KEYS - key0) < 64 ? (KEYS - key0) : 64;
        { f32x16 s0, s1; qk_tile_stream<18, 9>(Kt, KSTR, qrow, s0, s1, r, hh); softmax_pv_tile<8>(s0, s1, Vt, VSTR, o, m, l, nvalid, r, hh); }
        __syncthreads();
    }
    bf16_t* op = OP + (((size_t)b * NSPLIT + sp) * 256 + wid * 32 + r) * 256;
#pragma unroll
    for (int d = 0; d < 8; ++d)
#pragma unroll
        for (int g = 0; g < 4; ++g) { u32x2 w; w.x = cvtpk(o[d][4 * g], o[d][4 * g + 1]); w.y = cvtpk(o[d][4 * g + 2], o[d][4 * g + 3]); *(u32x2*)(op + d * 32 + 8 * g + 4 * hh) = w; }
    if (hh == 0) { float* ml = ML + (((size_t)b * NSPLIT + sp) * 256 + wid * 32 + r) * 2; ml[0] = m; ml[1] = l; }
}


#define XB_TMO      128
#define XB_XCNT(j)  (256  + 64 * (j))
#define XB_XSUB(j)  (1280 + 64 * (j))
#define XB_XGEN(j)  (2304 + 64 * (j))
#define XB_TOP      3328
#define XB_TOPGEN   3392
#define XCD_BAR_WORDS 3456
#define XB_SPIN_CAP (1u << 18)
DI unsigned xb_ld(unsigned* p)              { return __hip_atomic_load(p, __ATOMIC_RELAXED, __HIP_MEMORY_SCOPE_AGENT); }
DI unsigned xb_add(unsigned* p, unsigned v) { return __hip_atomic_fetch_add(p, v, __ATOMIC_RELAXED, __HIP_MEMORY_SCOPE_AGENT); }
DI unsigned xb_xcc_id() { return (unsigned)__builtin_amdgcn_s_getreg((3 << 11) | 20) & 0xFu; }
#define XB_SPIN(cond, bar) do { unsigned _sp = 0; while (cond) { __builtin_amdgcn_s_sleep(1); \
    if ((++_sp & 255u) == 0u) { if (xb_ld(&(bar)[XB_TMO])) break; if (_sp > XB_SPIN_CAP) { atomicAdd(&(bar)[XB_TMO], 1u); break; } } } } while (0)
struct XcdBarrier { unsigned* bar; unsigned x; volatile LAS unsigned* st; };
DI XcdBarrier xcd_barrier_post(unsigned* bar, volatile LAS unsigned* st) {
    XcdBarrier b; b.bar = bar; b.x = xb_xcc_id(); b.st = st;
    if (threadIdx.x == 0) (void)xb_add(&bar[XB_XCNT(b.x)], 1u);
    return b;
}
DI void xcd_barrier_complete(unsigned* bar, unsigned x, unsigned& nloc, unsigned& nx) {
    const unsigned G = gridDim.x * gridDim.y * gridDim.z;
    unsigned sum, cnt, mine, sp = 0u;
    for (;;) {
        sum = 0u; cnt = 0u; mine = 0u;
#pragma unroll
        for (unsigned j = 0; j < 16; ++j) { const unsigned c = xb_ld(&bar[XB_XCNT(j)]); sum += c; cnt += (c > 0u) ? 1u : 0u; mine = (j == x) ? c : mine; }
        if (sum == G) break;
        __builtin_amdgcn_s_sleep(1);
        if ((++sp & 255u) == 0u) { if (xb_ld(&bar[XB_TMO])) break; if (sp > XB_SPIN_CAP) { atomicAdd(&bar[XB_TMO], 1u); break; } }
    }
    nloc = mine > 0u ? mine : 1u; nx = cnt > 0u ? cnt : 1u;
}
DI void xcd_barrier(const XcdBarrier& b) {
    asm volatile("s_waitcnt vmcnt(0)" ::: "memory");
    __syncthreads();
    if (threadIdx.x == 0) {
        unsigned* bar = b.bar;
        __builtin_amdgcn_s_waitcnt(0);
        unsigned nloc = b.st[0], nx = b.st[1];
        if (nloc == 0u) { xcd_barrier_complete(bar, b.x, nloc, nx); b.st[0] = nloc; b.st[1] = nx; }
        const unsigned old = xb_add(&bar[XB_XSUB(b.x)], 1u);
        const unsigned gen = old / nloc;
        if (old + 1u == (gen + 1u) * nloc) {
            __builtin_amdgcn_fence(__ATOMIC_RELEASE, "agent");
            asm volatile("s_waitcnt vmcnt(0)" ::: "memory");
            const unsigned og = xb_add(&bar[XB_TOP], 1u);
            const unsigned tg = og / nx;
            if (og + 1u == (tg + 1u) * nx) xb_add(&bar[XB_TOPGEN], 1u);
            else XB_SPIN(xb_ld(&bar[XB_TOPGEN]) == tg, bar);
            __builtin_amdgcn_fence(__ATOMIC_ACQUIRE, "agent");
            xb_add(&bar[XB_XGEN(b.x)], 1u);
            asm volatile("s_waitcnt vmcnt(0)" ::: "memory");
        } else {
            XB_SPIN(xb_ld(&bar[XB_XGEN(b.x)]) == gen, bar);
            __builtin_amdgcn_fence(__ATOMIC_ACQUIRE, "agent");
            asm volatile("s_waitcnt vmcnt(0)" ::: "memory");
        }
    }
    __syncthreads();
}
struct Args { const float* in[33]; float* out; char* ws; int ph_lo, ph_hi; };
enum { I_XP = 0, I_XS, I_SCONV, I_SLRU, I_SGLA, I_CCKV, I_CKPE, I_NMPRE, I_NMPOST, I_NFPRE, I_NFPOST, I_WINAB, I_CONVW, I_CONVB, I_LWA, I_LBA, I_LWX, I_LBX, I_LAM,
       I_GWG, I_GBG, I_GNORM, I_WOUTAB, I_WINC, I_QNORM, I_WUQ, I_KVNORM, I_WUK, I_WUV, I_WOUTC, I_FG, I_FU, I_FD };
constexpr int NPHASE = 21;
__device__ const int PH_ORDER_unused = 0;
#ifndef PH_MASK
#define PH_MASK 0x3FFFFF
#endif
#define PHM(n) ((PH_MASK >> (n)) & 1)
#ifndef PROBE_DUP
#define PROBE_DUP 0
#endif

extern __shared__ __attribute__((aligned(16))) unsigned char dyn_lds[];

__global__ void __launch_bounds__(512, 2) mk_fwd(Args a) {
    char* smem = (char*)dyn_lds;
    char* ws = a.ws; float* out = a.out;
    const int G = gridDim.x, bid = blockIdx.x;
    bf16_t* WIN = (bf16_t*)(ws + WS_WIN); bf16_t* WOUT = (bf16_t*)(ws + WS_WOUT); bf16_t* WGU0 = (bf16_t*)(ws + WS_WGU0); bf16_t* WDN0 = (bf16_t*)(ws + WS_WDN0);
    bf16_t* WAT = (bf16_t*)(ws + WS_WAT); bf16_t* WXT = WAT + 8 * 128 * 128; float* ROPE = (float*)(ws + WS_ROPE);
    bf16_t* Us = (bf16_t*)(ws + WS_US); bf16_t* Zs = (bf16_t*)(ws + WS_ZS); bf16_t* Gs = (bf16_t*)(ws + WS_GS); float* CQs = (float*)(ws + WS_CQS);
    bf16_t* CQNs = (bf16_t*)(ws + WS_CQNS); bf16_t* QNs = (bf16_t*)(ws + WS_QNS); bf16_t* QLAT = (bf16_t*)(ws + WS_QLAT); float* ML = (float*)(ws + WS_ML);
    bf16_t* OLAT = (bf16_t*)(ws + WS_OLAT); bf16_t* Os = (bf16_t*)(ws + WS_OS);
    bf16_t* U = (bf16_t*)(ws + WS_U); bf16_t* Z = (bf16_t*)(ws + WS_Z);
    bf16_t* WGU1 = (bf16_t*)(ws + ZR_WGU1); bf16_t* WDN1 = (bf16_t*)(ws + ZR_WDN1); bf16_t* WINC = (bf16_t*)(ws + WS_WINC); bf16_t* WUQ = (bf16_t*)(ws + WS_WUQ);
    bf16_t* WUKT = (bf16_t*)(ws + WS_WUKT); bf16_t* WUVT = (bf16_t*)(ws + WS_WUVT); bf16_t* WOC = (bf16_t*)(ws + WS_WOC); bf16_t* WUK = (bf16_t*)(ws + WS_WUKP);
    bf16_t* CC = (bf16_t*)(ws + ZR_CC); bf16_t* CCT = (bf16_t*)(ws + ZR_CCT); bf16_t* Gp = (bf16_t*)(ws + ZR_G);
    float* CQ = (float*)(ws + ZR_QN); bf16_t* QN = (bf16_t*)(ws + ZR_QN); bf16_t* VT = (bf16_t*)(ws + ZR_VT); bf16_t* OP = (bf16_t*)(ws + WS_WIN);
    bf16_t* CQN = (bf16_t*)(ws + ZR_CQN); bf16_t* CKVN = (bf16_t*)(ws + ZR_CKVN); bf16_t* KPE = (bf16_t*)(ws + ZR_KPE);
    bf16_t* U0 = (bf16_t*)(out + O_YP);
    float* Hp = out + O_YP; float* Hs = out + O_YS;
    bf16_t* Hb = (bf16_t*)(out + O_YP);
    bf16_t* Hb2 = (bf16_t*)(ws + ZR_CC);

    volatile LAS unsigned* bst = (volatile LAS unsigned*)(dyn_lds + LDS_BYTES - 16);
    if (threadIdx.x == 0) { bst[0] = 0u; bst[1] = 0u; }
    __syncthreads();
    XcdBarrier xb = xcd_barrier_post((unsigned*)(ws + WS_CTL), bst);
    if (a.ph_hi > NPHASE) cg::this_grid().sync();
    for (int ph = a.ph_lo; ph < a.ph_hi; ++ph) {
        if (ph > a.ph_lo) xcd_barrier(xb);
        const int phc = ph < 2 ? ph : (ph == 2 ? 20 : (ph == 3 ? 2 : (ph == 4 ? 21 : ph - 2)));
        for (int rep_ = 0; rep_ < (((PROBE_DUP >> phc) & 1) ? 2 : 1); ++rep_) {
        if (rep_) __syncthreads();
        const int dry_ = (((PROBE_DUP >> phc) & 1) && rep_ == 0) ? 1 : 0;
        int r9lo = 0, r9hi = 0;
        switch (phc) {
        case 0: if (PHM(0)) {
            const int tid = ltid(), wid = tid >> 6, lane = tid & 63; (void)wid; (void)lane;
            int tb = 0;
            transpose_job(smem, 1024, NZ, WIN, 1024, SrcWin{a.in[I_WINAB]}, tb);
            transpose_job(smem, 2048, 1024, WOUT, 2048, SrcPlain{a.in[I_WOUTAB], 1024}, tb);
            for (int e = bid * 512 + tid; e < 2 * 8 * 128 * 16; e += G * 512) {
                const int which = e >> 14, idx = e & 16383, n = idx >> 11, cg8 = (idx >> 7) & 15, d = idx & 127;
                const float* wsrc = a.in[which ? I_LWX : I_LWA] + ((size_t)(n * 128 + cg8 * 8)) * 128 + d;
                float v[8];
#pragma unroll
                for (int k = 0; k < 8; ++k) v[k] = wsrc[k * 128];
                u32x4 w; w.x = cvtpk(v[0], v[1]); w.y = cvtpk(v[2], v[3]); w.z = cvtpk(v[4], v[5]); w.w = cvtpk(v[6], v[7]);
                *(u32x4*)(WAT + (size_t)which * 131072 + ((size_t)(n * 128 + d)) * 128 + cg8 * 8) = w;
            }
            for (int e = bid * 512 + tid; e < 2064 * 16; e += G * 512) {
                const int pi = e >> 4, i = e & 15; const int pos = pi < 2048 ? pi : PAST + (pi - 2048);
                const float inv = __builtin_amdgcn_exp2f(-(float)i * 0.830482023721841f);
                const float ang = (float)pos * inv;
                const double rev = (double)ang * 0.15915494309189535; const float fr = (float)(rev - floor(rev));
                ROPE[pi * 32 + i] = __builtin_amdgcn_cosf(fr); ROPE[pi * 32 + 16 + i] = __builtin_amdgcn_sinf(fr);
            }
            rms_rows_to_bf16(a.in[I_XP], a.in[I_NMPRE], U0, MP);
            rms_rows_to_bf16(a.in[I_XS], a.in[I_NMPRE], Us, MS);
        } break;
        case 1: if (PHM(1)) {
            big_gemm(smem, U0, 1024, WIN, MP, 5120, 1024, 0, FZ{Z});
            for (int u = (bid + G - 64 % G) % G; u < MP / 128; u += G) small_gemm_unit(smem, U0 + (size_t)u * 128 * 1024, 1024, WIN, 1024, 1024, ZC_ZR, FZ{Z + (size_t)u * 128 * NZ});
            small_gemm(smem, Us, 1024, WIN, 1024, 1024, IN_AB, 192, FZ{Zs});
        } break;
        case 20: if (PHM(20)) {
            bf16_t* HL = (bf16_t*)(out + O_YP); bf16_t* AC = HL + (size_t)MP * 1024; float* DEC = (float*)(ws + WS_DEC); float* TA = (float*)(ws + WS_TA); float* TU = (float*)(ws + WS_TU);
            for (int u = bid; u < 1024; u += G) { const int b = u >> 7, hd = (u >> 5) & 3, ch = u & 31;
                gla_pre_unit(smem, Z + ((size_t)b * SEQ + ch * 64) * NZ, hd, a.in[I_GWG], a.in[I_GBG], U + ((size_t)(b * 4 + hd) * 32 + ch) * 16384, DEC + ((size_t)(b * 4 + hd) * 32 + ch) * 128, dry_); }
        } break;
        case 2: if (PHM(2)) {
            bf16_t* HL = (bf16_t*)(out + O_YP); bf16_t* AC = HL + (size_t)MP * 1024; float* DEC = (float*)(ws + WS_DEC); float* TA = (float*)(ws + WS_TA); float* TU = (float*)(ws + WS_TU);
            if (bid < 32) { const int b = bid >> 2, hd = bid & 3;
                gla_seq_unit(smem, Z + (size_t)b * SEQ * NZ, hd, U + (size_t)(b * 4 + hd) * 32 * 16384, DEC + (size_t)(b * 4 + hd) * 32 * 128, out + O_PS + ((size_t)b * 4 + hd) * 128 * 256, dry_);
            }
            const int nb2 = G > 64 ? G - 32 : G, me2 = G > 64 ? (int)bid - 32 : (int)bid;
            if (me2 >= 0) for (int u = me2; u < 32 + 128; u += nb2) {
                if (u < 32) { const int b = u >> 2, hd = u & 3;
                    gla_unit(smem, Zs + (size_t)b * DSEQ * NZ, DSEQ, hd, a.in[I_GWG], a.in[I_GBG], a.in[I_GNORM], a.in[I_SGLA] + ((size_t)b * 4 + hd) * 128 * 256, out + O_SS + ((size_t)b * 4 + hd) * 128 * 256, dry_);
                } else { const int w = u - 32, b = w >> 4, n = (w >> 1) & 7, half = w & 1;
                    lru_unit(smem, Zs + (size_t)b * DSEQ * NZ, DSEQ, n, half, a.in[I_CONVW], a.in[I_CONVB], WAT, WXT, a.in[I_LBA], a.in[I_LBX], a.in[I_LAM],
                             a.in[I_SCONV] + (size_t)b * 3 * 1024, a.in[I_SLRU] + (size_t)b * 1024, out + O_SCONV + (size_t)b * 3 * 1024, out + O_SH + (size_t)b * 1024, dry_);
                }
                __syncthreads();
            }
            const int sk2 = nb2 >= 96 ? 32 : 0;
            if (me2 >= sk2) { const int m3 = me2 - sk2, n3 = nb2 - sk2; const int nh = m3 & 15, grp = m3 >> 4, ngrp = (n3 + 15 - nh) / 16;
              if (ngrp > 0) { const int per = (128 + ngrp - 1) / ngrp, i0 = grp * per, i1 = (i0 + per < 128) ? i0 + per : 128;
                if (i0 < i1) lru_pre_multi(smem, Z, i0, i1 - i0, nh >> 1, nh & 1, a.in[I_CONVW], a.in[I_CONVB], WAT, WXT, a.in[I_LBA], a.in[I_LBX], a.in[I_LAM], HL, AC, TA, TU, out + O_PCONV); } }
            { int tb2 = 0;
              transpose_job(smem, 1024, NGU, WGU0, 1024, SrcGU{a.in[I_FG], a.in[I_FU]}, tb2, nb2, G > 64 ? me2 : (int)bid);
              transpose_job(smem, DFF, 1024, WDN0, DFF, SrcPlain{a.in[I_FD], 1024}, tb2, nb2, G > 64 ? me2 : (int)bid);
              const int mw = G > 64 ? me2 : (int)bid;
              transpose_job(smem, 1024, NINC, WINC, 1024, SrcInc{a.in[I_WINC]}, tb2, nb2, mw);
              transpose_job(smem, 384, NQ, WUQ, 384, SrcUq{a.in[I_WUQ]}, tb2, nb2, mw);
              transpose_job(smem, 256, 1024, WUKT, 256, SrcPlain{a.in[I_WUK], 1024}, tb2, nb2, mw);
              transpose_job(smem, 256, 1024, WUVT, 256, SrcPlain{a.in[I_WUV], 1024}, tb2, nb2, mw);
              transpose_job(smem, 1024, 1024, WOC, 1024, SrcPlain{a.in[I_WOUTC], 1024}, tb2, nb2, mw);
              if (mw >= 0) { const int tid = ltid(); for (int e = mw * 512 + tid; e < 256 * 1024 / 4; e += nb2 * 512) { const f32x4 v = *(const f32x4*)(a.in[I_WUK] + (size_t)e * 4); u32x2 w; w.x = cvtpk(v[0], v[1]); w.y = cvtpk(v[2], v[3]); *(u32x2*)(WUK + (size_t)e * 4) = w; } } }
        } break;
        case 21: if (PHM(21)) {
            for (int u = bid; u < 1024; u += G) { const int b = u >> 7, hd = (u >> 5) & 3, ch = u & 31;
                gla_post_unit(smem, Z + ((size_t)b * SEQ + ch * 64) * NZ, hd, U + ((size_t)(b * 4 + hd) * 32 + ch) * 16384, a.in[I_GNORM], dry_); }
            { bf16_t* HL = (bf16_t*)(out + O_YP); bf16_t* AC = HL + (size_t)MP * 1024; float* TA = (float*)(ws + WS_TA); float* TU = (float*)(ws + WS_TU);
              for (int v = bid; v < 256; v += G) { const int b = v >> 5, n = (v >> 2) & 7, q4 = v & 3;
                lru_fix_seq(Z + (size_t)b * SEQ * NZ, n, q4, HL + (size_t)b * SEQ * 1024, AC + (size_t)b * SEQ * 1024, TA + (size_t)b * 16 * 1024, TU + (size_t)b * 16 * 1024, out + O_PH + (size_t)b * 1024, dry_); } }
            small_gemm_h(smem, Zs + ZC_GA, NZ, WOUT, 2048, 2048, 1024, 0, FB{Us, 1024});
        } break;
        case 3: if (PHM(3)) {
            big_gemm(smem, Z + ZC_GA, NZ, WOUT, MP, 1024, 2048, 0, FB{U, 1024});
            norm_rows<0, 0>(Us, a.in[I_XS], Hs, a.in[I_NMPOST], a.in[I_NFPRE], Us, MS, dry_);
        } break;
        case 4: if (PHM(4)) {
            const int tid = ltid(), wid = tid >> 6, lane = tid & 63; (void)wid; (void)lane;
            norm_rows<0, 1>(U, a.in[I_XP], Hb, a.in[I_NMPOST], a.in[I_NFPRE], U, MP, dry_);
            { int tb = 0; for (int b = 0; b < NB; ++b) transpose_job(smem, PAST, 256, CCT + (size_t)b * 256 * KEYP, KEYP, SrcPlain{a.in[I_CCKV] + (size_t)b * PAST * 256, 256}, tb); }
            for (int e0 = bid * 512 + tid; e0 < NB * PAST * 64; e0 += 4 * G * 512) {
                f32x4 v[4];
#pragma unroll
                for (int k = 0; k < 4; ++k) { const int e = e0 + k * G * 512; v[k] = (f32x4){0.f, 0.f, 0.f, 0.f}; if (e < NB * PAST * 64) v[k] = *(const f32x4*)(a.in[I_CCKV] + (size_t)(e >> 6) * 256 + (e & 63) * 4); }
#pragma unroll
                for (int k = 0; k < 4; ++k) { const int e = e0 + k * G * 512; if (e < NB * PAST * 64) { const int row = e >> 6, c4 = (e & 63) * 4; const int b = row >> 12, key = row & 4095;
                    u32x2 w; w.x = cvtpk(v[k][0], v[k][1]); w.y = cvtpk(v[k][2], v[k][3]); *(u32x2*)(CC + ((size_t)b * KEYP + key) * DLAT + c4) = w; } }
            }
            {
                float x1[4], x2[4];
#pragma unroll
                for (int k = 0; k < 4; ++k) { const int e = bid * 512 + tid + k * G * 512; x1[k] = 0.f; x2[k] = 0.f;
                    if (e < NB * PAST * 16) { const int row = e >> 4, i = e & 15; x1[k] = a.in[I_CKPE][(size_t)row * 32 + i]; x2[k] = a.in[I_CKPE][(size_t)row * 32 + 16 + i]; } }
#pragma unroll
                for (int k = 0; k < 4; ++k) { const int e = bid * 512 + tid + k * G * 512;
                    if (e < NB * PAST * 16) { const int row = e >> 4, i = e & 15; const int b = row >> 12, key = row & 4095; *(unsigned*)(CC + ((size_t)b * KEYP + key) * DLAT + 256 + 2 * i) = cvtpk(x1[k], x2[k]); } }
                for (int e = bid * 512 + tid + 4 * G * 512; e < NB * PAST * 16; e += G * 512) { const int row = e >> 4, i = e & 15; const int b = row >> 12, key = row & 4095;
                    *(unsigned*)(CC + ((size_t)b * KEYP + key) * DLAT + 256 + 2 * i) = cvtpk(a.in[I_CKPE][(size_t)row * 32 + i], a.in[I_CKPE][(size_t)row * 32 + 16 + i]); }
            }
            small_gemm2(smem, Us, 1024, WGU0, 1024, 1024, NGU, 0, FSw{Gs});
        } break;
        case 5: if (PHM(5)) {
            big_gemm(smem, U, 1024, WGU0, MP, NGU, 1024, 0, FSw{Gp});
            { int tb5 = 0; const int nw5 = G > 128 ? G - 128 : G, me5 = G > 128 ? (int)bid - 128 : (int)bid;
              transpose_job(smem, 1024, NGU, WGU1, 1024, SrcGU{a.in[I_FG] + (size_t)1024 * DFF, a.in[I_FU] + (size_t)1024 * DFF}, tb5, nw5, me5);
              transpose_job(smem, DFF, 1024, WDN1, DFF, SrcPlain{a.in[I_FD] + (size_t)DFF * 1024, 1024}, tb5, nw5, me5); }
            small_gemm(smem, Gs, DFF, WDN0, DFF, DFF, 1024, 128, FB{Us, 1024});
        } break;
        case 6: if (PHM(6)) {
            big_gemm(smem, Gp, DFF, WDN0, MP, 1024, DFF, 0, FB{U, 1024});
            norm_rows<0, 0>(Us, Hs, Hs, a.in[I_NFPOST], a.in[I_NMPRE] + 1024, Us, MS, dry_);
        } break;
        case 7: if (PHM(7)) {
            norm_rows<1, 1>(U, Hb, Hb, a.in[I_NFPOST], a.in[I_NMPRE] + 1024, U, MP, dry_);
            small_gemm(smem, Us, 1024, WINC, 1024, 1024, INC, 0, FF32{CQs, NINC});
        } break;
        case 8: if (PHM(8)) {
            big_gemm(smem, U, 1024, WINC, MP, NINC, 1024, 0, FF32{CQ, NINC});
            r9lo = MP; r9hi = MP + MS;
        } break;
        case 9: if (PHM(9)) {
            r9lo = 0; r9hi = MP;
            small_gemm(smem, CQNs, 384, WUQ, 384, 384, NQ, 0, FQ{ROPE, 1, QNs, QLAT});
        } break;
        case 10: if (PHM(10)) {
            big_gemm(smem, CQN, 384, WUQ, MP, NQ, 384, 0, FQ{ROPE, 0, QN, nullptr});
            big_gemm(smem, CKVN, 256, WUKT, MP, 1024, 256, 128, FB{U, 1024});
            big_gemm(smem, WUVT, 256, CKVN, 1024, MP, 256, 128, FB{VT, MP});
            for (int u = bid; u < 256; u += G) { const int hd = u >> 4, nt = u & 15; small_gemm_unit(smem, QNs + hd * 64, 1024, WUK + hd * 64, 1024, 64, nt * 16, FQL{QLAT, hd}); }
        } break;
        case 11: if (PHM(11)) {
            { const int bh = bid >> 1, set = bid & 1, b = bh >> 4, hd = bh & 15;
              if (bid < 256) for (int i = 0; i < 4; ++i) { const int qb = set ? (i & 1 ? 2 + (i >> 1) : 5 - (i >> 1)) : (i & 1 ? (i >> 1) : 7 - (i >> 1)); attn_prompt_unit(smem, b, hd, qb, QN, U, KPE, VT, dry_); }
              if (G < 256) {   for (int u = G + bid; u < 256; u += G) { const int bh2 = u >> 1, s2 = u & 1; for (int i = 0; i < 4; ++i) { const int qb = s2 ? (i & 1 ? 2 + (i >> 1) : 5 - (i >> 1)) : (i & 1 ? (i >> 1) : 7 - (i >> 1)); attn_prompt_unit(smem, bh2 >> 4, bh2 & 15, qb, QN, U, KPE, VT, dry_); } } } }
            for (int u = bid; u < NB * NSPLIT; u += G) attn_sample_unit(smem, u / NSPLIT, u % NSPLIT, QLAT, CC, CCT, OP, ML);
        } break;
        case 12: if (PHM(12)) {
            big_gemm(smem, QN, NQ, WOC, MP, 1024, 1024, 0, FB{U, 1024});
            { const int tid = ltid(), wid = tid >> 6, lane = tid & 63; (void)lane;
            const int gw = bid * 8 + wid, GW = G * 8;
            for (int rr = gw; rr < 2048; rr += GW) { const int b = rr >> 8, qr = rr & 255;
                float mm[NSPLIT], ll[NSPLIT]; float M = -INFINITY;
#pragma unroll
                for (int j = 0; j < NSPLIT; ++j) { const float* ml = ML + (((size_t)b * NSPLIT + j) * 256 + qr) * 2; mm[j] = ml[0]; ll[j] = ml[1]; M = fmaxf(M, mm[j]); }
                float Lt = 0.f; f32x4 acc = (f32x4){0.f, 0.f, 0.f, 0.f};
#pragma unroll
                for (int j = 0; j < NSPLIT; ++j) { const float w = __builtin_amdgcn_exp2f(mm[j] - M); Lt += w * ll[j];
                    const u32x2 pv = *(const u32x2*)(OP + (((size_t)b * NSPLIT + j) * 256 + qr) * 256 + lane * 4); acc += (f32x4){lo2f(pv.x), hi2f(pv.x), lo2f(pv.y), hi2f(pv.y)} * w; }
                const float inv = frcp(Lt); u32x2 w; w.x = cvtpk(acc[0] * inv, acc[1] * inv); w.y = cvtpk(acc[2] * inv, acc[3] * inv);
                *(u32x2*)(OLAT + (size_t)rr * 256 + lane * 4) = w; }
            }
        } break;
        case 13: if (PHM(13)) {
            const int tid = ltid(), wid = tid >> 6, lane = tid & 63; (void)wid; (void)lane;
            norm_rows<1, 1>(U, Hb, Hb2, a.in[I_NMPOST] + 1024, a.in[I_NFPRE] + 1024, U, MP, dry_);
            for (int u = bid; u < 64; u += G) { const int hd = u >> 2, nt = u & 3; small_gemm_unit(smem, OLAT + hd * 256, 4096, WUVT + (size_t)hd * 64 * 256, 256, 256, nt * 16, FOS{Os, hd}); }
        } break;
        case 14: if (PHM(14)) {
            big_gemm(smem, U, 1024, WGU1, MP, NGU, 1024, 0, FSw{Gp});
            small_gemm(smem, Os, 1024, WOC, 1024, 1024, 1024, 128, FB{Us, 1024});
        } break;
        case 15: if (PHM(15)) {
            big_gemm(smem, Gp, DFF, WDN1, MP, 1024, DFF, 0, FB{U, 1024});
            norm_rows<0, 0>(Us, Hs, Hs, a.in[I_NMPOST] + 1024, a.in[I_NFPRE] + 1024, Us, MS, dry_);
        } break;
        case 16: if (PHM(16)) {
            norm_rows<1, 0>(U, Hb2, Hp, a.in[I_NFPOST] + 1024, nullptr, nullptr, MP, dry_);
            small_gemm2(smem, Us, 1024, WGU1, 1024, 1024, NGU, 0, FSw{Gs});
        } break;
        case 17: if (PHM(17)) small_gemm_h(smem, Gs, DFF, WDN1, DFF, DFF, 1024, 0, FB{Us, 1024}); break;
        case 18: if (PHM(18)) norm_rows<0, 0>(Us, Hs, Hs, a.in[I_NFPOST] + 1024, nullptr, nullptr, MS, dry_); break;
        default: break;
        }
        if (r9hi > r9lo) {
            const int tid = ltid(), wid = tid >> 6, lane = tid & 63; (void)wid; (void)lane;
            const int gw = bid * 8 + wid, GW = G * 8;
            float nq[6]; f32x4 nkv = (f32x4){0.f, 0.f, 0.f, 0.f}; float nx1 = 0.f, nx2 = 0.f;
            auto p9load = [&](int rr_) { const bool smp_ = rr_ >= MP; const float* cq_ = (smp_ ? CQs + (size_t)(rr_ - MP) * NINC : CQ + (size_t)rr_ * NINC);
#pragma unroll
                for (int i = 0; i < 6; ++i) nq[i] = cq_[i * 64 + lane];
                nkv = *(const f32x4*)(cq_ + 384 + lane * 4); nx1 = cq_[640 + (lane & 15)]; nx2 = cq_[656 + (lane & 15)]; };
            float gqn[6];
#pragma unroll
            for (int i = 0; i < 6; ++i) gqn[i] = a.in[I_QNORM][i * 64 + lane];
            const f32x4 gkn = *(const f32x4*)(a.in[I_KVNORM] + lane * 4);
            if (r9lo + gw < r9hi) p9load(r9lo + gw);
            for (int rr = r9lo + gw; rr < r9hi; rr += GW) {
                const bool smp = rr >= MP; const int row = smp ? rr - MP : rr;
                const float* cq = (smp ? CQs : CQ) + (size_t)row * NINC;
                float q[6]; float ss = 0.f;
#pragma unroll
                for (int i = 0; i < 6; ++i) { q[i] = nq[i]; ss += q[i] * q[i]; }
                const f32x4 kv = nkv; const float x1 = nx1, x2 = nx2;
                if (rr + GW < r9hi) p9load(rr + GW);
                ss = wave_sum(ss); const float rq = __builtin_amdgcn_rsqf(ss * (1.0f / 384.0f) + EPS);
                bf16_t* cqn = (smp ? CQNs : CQN) + (size_t)row * 384;
#pragma unroll
                for (int i = 0; i < 6; ++i) cqn[i * 64 + lane] = f2bf(q[i] * rq * gqn[i]);
                float s2 = kv[0] * kv[0] + kv[1] * kv[1] + kv[2] * kv[2] + kv[3] * kv[3]; s2 = wave_sum(s2); const float rk = __builtin_amdgcn_rsqf(s2 * (1.0f / 256.0f) + EPS);
                const f32x4 gk = gkn;
                const f32x4 kn = (f32x4){kv[0] * rk * gk[0], kv[1] * rk * gk[1], kv[2] * rk * gk[2], kv[3] * rk * gk[3]};
                *(f32x4*)(out + (smp ? O_SCKV : O_PCKV) + (size_t)row * 256 + lane * 4) = kn;
                u32x2 w; w.x = cvtpk(kn[0], kn[1]); w.y = cvtpk(kn[2], kn[3]);
                const int b = row >> 4, t = row & 15;
                if (!smp) *(u32x2*)(CKVN + (size_t)row * 256 + lane * 4) = w;
                else { *(u32x2*)(CC + ((size_t)b * KEYP + PAST + t) * DLAT + lane * 4) = w;
#pragma unroll
                    for (int j = 0; j < 4; ++j) CCT[((size_t)b * 256 + lane * 4 + j) * KEYP + PAST + t] = f2bf(kn[j]); }
                if (lane < 16) {
                    const int pidx = smp ? 2048 + t : (row & 2047);
                    const float c = ROPE[pidx * 32 + lane], s = ROPE[pidx * 32 + 16 + lane];
                    const float o1 = x1 * c - x2 * s, o2 = x1 * s + x2 * c;
                    float* ko = out + (smp ? O_SKPE : O_PKPE) + (size_t)row * 32; ko[lane] = o1; ko[16 + lane] = o2;
                    if (!smp) *(unsigned*)(KPE + (size_t)row * 32 + 2 * lane) = cvtpk(o1, o2);
                    else *(unsigned*)(CC + ((size_t)b * KEYP + PAST + t) * DLAT + 256 + 2 * lane) = cvtpk(o1, o2);
                }
            }
            }
        }
    }
}

#ifndef MK_COOP
#define MK_COOP 1
#endif
extern "C" void kernel_launch(void* const* d_in, const int* in_sizes, int n_in, void* d_out, int out_size, void* d_ws, size_t ws_size, hipStream_t stream) {
    static int grid = 0;
    if (grid == 0) {
        if (n_in != 33 || ws_size < WS_END) { fprintf(stderr, "kernel_launch: unexpected n_in %d / ws %zu\n", n_in, ws_size); grid = -1; return; }
        int dev = 0, cus = 0, per_cu = 0;
        hipGetDevice(&dev); hipDeviceGetAttribute(&cus, hipDeviceAttributeMultiprocessorCount, dev);
        if (hipFuncSetAttribute((const void*)mk_fwd, hipFuncAttributeMaxDynamicSharedMemorySize, LDS_BYTES) != hipSuccess) { fprintf(stderr, "hipFuncSetAttribute failed\n"); grid = -1; return; }
        hipOccupancyMaxActiveBlocksPerMultiprocessor(&per_cu, (const void*)mk_fwd, 512, LDS_BYTES);
        (void)hipGetLastError();
        if (per_cu < 1) per_cu = 1;
        grid = cus;
    }
    if (grid < 0) return;
    if (hipMemsetAsync((char*)d_ws + WS_CTL, 0, CTL_BYTES, stream) != hipSuccess) { fprintf(stderr, "memset failed\n"); return; }
    Args a{};
    for (int i = 0; i < 33; ++i) a.in[i] = (const float*)d_in[i];
    a.out = (float*)d_out; a.ws = (char*)d_ws;
#if MK_COOP
    a.ph_lo = 0; a.ph_hi = NPHASE;
    void* args[] = {&a};
    hipError_t e = hipLaunchCooperativeKernel((const void*)mk_fwd, dim3(grid), dim3(512), args, LDS_BYTES, stream);
    if (e != hipSuccess) fprintf(stderr, "cooperative launch failed: %s (grid %d)\n", hipGetErrorString(e), grid);
#else
    for (int ph = 0; ph < NPHASE; ++ph) { a.ph_lo = ph; a.ph_hi = ph + 1; hipLaunchKernelGGL(mk_fwd, dim3(grid), dim3(512), LDS_BYTES, stream, a); }
#endif
}
```

```cpp
#include <hip/hip_runtime.h>
#include <hip/hip_cooperative_groups.h>
#include <cstdio>
#include <cstdint>
namespace cg = cooperative_groups;

#define DI __device__ __forceinline__
#define LAS __attribute__((address_space(3)))
typedef unsigned short bf16_t;
typedef short bf16x8 __attribute__((ext_vector_type(8)));
typedef short s16x4 __attribute__((ext_vector_type(4)));
typedef float f32x2 __attribute__((ext_vector_type(2)));
typedef float f32x4 __attribute__((ext_vector_type(4)));
typedef float f32x16 __attribute__((ext_vector_type(16)));
typedef unsigned u32x2 __attribute__((ext_vector_type(2)));
typedef unsigned u32x4 __attribute__((ext_vector_type(4)));
typedef __bf16 bf16x2_t __attribute__((ext_vector_type(2)));

constexpr int DM = 1024, MP = 16384, MS = 128, SEQ = 2048, NB = 8, DSEQ = 16, PAST = 4096;
constexpr int NZ = 5376;
constexpr int ZC_XA = 0, ZC_GA = 1024, ZC_GB = 2048, ZC_Q = 3072, ZC_K = 3584, ZC_V = 4096, ZC_ZR = 5120;
constexpr int IN_AB = 5136, DFF = 2816, NGU = 5632, INC = 672, NINC = 768, NQ = 1536;
constexpr int KEYS = 4112, KEYP = 4160, DLAT = 288;
constexpr int NSPLIT = 30, NKT = 65;
constexpr float EPS = 1e-6f;
constexpr int LDS_BYTES = 147456;

constexpr size_t O_YP = 0, O_YS = 16777216, O_PCONV = 16908288, O_PH = 16932864, O_PS = 16941056, O_PCKV = 17989632, O_PKPE = 22183936,
                 O_SCONV = 22708224, O_SH = 22732800, O_SS = 22740992, O_SCKV = 23789568, O_SKPE = 23822336;

constexpr size_t al(size_t x) { return (x + 255) & ~(size_t)255; }
constexpr size_t WS_WIN = 0;
constexpr size_t WS_WOUT = WS_WIN + (size_t)NZ * 1024 * 2;
constexpr size_t WS_WGU0 = WS_WOUT + (size_t)1024 * 2048 * 2;
constexpr size_t WS_WDN0 = WS_WGU0 + (size_t)NGU * 1024 * 2;
constexpr size_t WS_WAT = WS_WDN0 + (size_t)1024 * DFF * 2;
constexpr size_t WS_ROPE = WS_WAT + (size_t)2 * 8 * 128 * 128 * 2;
constexpr size_t WS_US = al(WS_ROPE + (size_t)2064 * 32 * 4);
constexpr size_t WS_ZS = WS_US + (size_t)MS * 1024 * 2;
constexpr size_t WS_GS = WS_ZS + (size_t)MS * NZ * 2;
constexpr size_t WS_CQS = WS_GS + (size_t)MS * DFF * 2;
constexpr size_t WS_CQNS = WS_CQS + (size_t)MS * NINC * 4;
constexpr size_t WS_QNS = WS_CQNS + (size_t)MS * 384 * 2;
constexpr size_t WS_QLAT = WS_QNS + (size_t)MS * 1024 * 2;
constexpr size_t WS_ML = WS_QLAT + (size_t)2048 * DLAT * 2;
constexpr size_t WS_OLAT = al(WS_ML + (size_t)8 * NSPLIT * 256 * 2 * 4);
constexpr size_t WS_OS = WS_OLAT + (size_t)2048 * 256 * 2;
constexpr size_t WS_U = al(WS_OS + (size_t)MS * 1024 * 2);
constexpr size_t WS_Z = WS_U + (size_t)MP * 1024 * 2;
constexpr size_t Z_BYTES = (size_t)MP * NZ * 2;
constexpr size_t WS_CTL = WS_Z + Z_BYTES;
constexpr size_t CTL_BYTES = 16384;
constexpr size_t WS_DEC = WS_CTL + CTL_BYTES;
constexpr size_t WS_TA = WS_DEC + (size_t)1024 * 128 * 4;
constexpr size_t WS_TU = WS_TA + (size_t)128 * 1024 * 4;
constexpr size_t WS_WINC = WS_TU + (size_t)128 * 1024 * 4;
constexpr size_t WS_WUQ = WS_WINC + (size_t)NINC * 1024 * 2;
constexpr size_t WS_WUKT = WS_WUQ + (size_t)NQ * 384 * 2;
constexpr size_t WS_WUVT = WS_WUKT + (size_t)1024 * 256 * 2;
constexpr size_t WS_WOC = WS_WUVT + (size_t)1024 * 256 * 2;
constexpr size_t WS_WUKP = WS_WOC + (size_t)1024 * 1024 * 2;
constexpr size_t WS_END = WS_WUKP + (size_t)256 * 1024 * 2;
constexpr size_t ZR_WGU1 = WS_Z;
constexpr size_t ZR_WDN1 = ZR_WGU1 + (size_t)NGU * 1024 * 2;
constexpr size_t ZR_WUK = ZR_WDN1 + (size_t)1024 * DFF * 2;
constexpr size_t ZR_CC = ZR_WUK;
constexpr size_t ZR_CCT = ZR_CC + (size_t)NB * KEYP * DLAT * 2;
constexpr size_t ZR_G = al(ZR_CCT + (size_t)NB * 256 * KEYP * 2);
constexpr size_t ZR_QN = ZR_G;
constexpr size_t ZR_VT = ZR_QN + (size_t)MP * NQ * 2;
constexpr size_t ZR_CQN = ZR_VT + (size_t)MP * 1024 * 2;
constexpr size_t ZR_CKVN = ZR_CQN + (size_t)MP * 384 * 2;
constexpr size_t ZR_KPE = ZR_CKVN + (size_t)MP * 256 * 2;
constexpr size_t ZR_END = ZR_KPE + (size_t)MP * 32 * 2;
static_assert(ZR_END <= WS_CTL && ZR_G + (size_t)MP * DFF * 2 <= WS_CTL && WS_END <= 268435456, "ws map");
static_assert((size_t)NB * NSPLIT * 256 * 256 * 2 <= WS_WAT, "OP fits the layer-0 weight area");
static_assert((size_t)MP * NINC * 4 <= (size_t)MP * NQ * 2, "CQ fits QN");
static_assert(ZR_CC + (size_t)MP * 1024 * 2 <= ZR_G, "Hb2 fits the latent cache image");

DI unsigned cvtpk(float lo, float hi) { f32x2 v = {lo, hi}; bf16x2_t b = __builtin_convertvector(v, bf16x2_t); return __builtin_bit_cast(unsigned, b); }
DI float bf2f(bf16_t b) { return __uint_as_float(((unsigned)b) << 16); }
DI bf16_t f2bf(float f) { return (bf16_t)(cvtpk(f, 0.f) & 0xffffu); }
DI float lo2f(unsigned u) { return __uint_as_float(u << 16); }
DI float hi2f(unsigned u) { return __uint_as_float(u & 0xffff0000u); }
DI float fexp(float x) { return __builtin_amdgcn_exp2f(x * 1.44269504089f); }
DI float frcp(float x) { return __builtin_amdgcn_rcpf(x); }
DI float fsigmoid(float x) { return frcp(1.0f + fexp(-x)); }
DI float fsilu(float x) { return x * fsigmoid(x); }
DI float fgelu(float x) { const float u = 0.7978845608f * (x + 0.044715f * x * x * x); const float t = 1.0f - 2.0f * frcp(1.0f + fexp(2.0f * u)); return 0.5f * x * (1.0f + t); }
DI float flog(float x) { return __builtin_amdgcn_logf(x) * 0.69314718056f; }
DI float flog1p_small(float e) { return e < 0.03f ? e * (1.0f - e * (0.5f - e * (0.33333333f - 0.25f * e))) : flog(1.0f + e); }
DI float fsoftplus(float x) { return fmaxf(x, 0.f) + flog1p_small(fexp(-fabsf(x))); }
DI float neg_expm1(float y) {
    return (y > -0.1f) ? -y * (1.0f + y * 0.5f * (1.0f + y * 0.33333333f * (1.0f + y * 0.25f * (1.0f + y * 0.2f)))) : 1.0f - fexp(y); }
DI float wave_sum(float v) {
#pragma unroll
    for (int o = 32; o >= 1; o >>= 1) v += __shfl_xor(v, o, 64);
    return v; }
DI int ltid() { int t = threadIdx.x; asm volatile("" : "+v"(t)); return t; }
DI int crow(int i, int h) { return (i & 3) + 8 * (i >> 2) + 4 * h; }
DI bf16x8 pack8(const f32x16& x, int s) {
    u32x4 p; p.x = cvtpk(x[8 * s], x[8 * s + 1]); p.y = cvtpk(x[8 * s + 2], x[8 * s + 3]); p.z = cvtpk(x[8 * s + 4], x[8 * s + 5]); p.w = cvtpk(x[8 * s + 6], x[8 * s + 7]);
    return __builtin_bit_cast(bf16x8, p); }
DI bf16x8 ld8(const void* p) { return *(const bf16x8*)p; }
DI bf16x8 cat44(const void* lo, const void* hi) { const s16x4 a = *(const s16x4*)lo, b = *(const s16x4*)hi; return __builtin_shufflevector(a, b, 0, 1, 2, 3, 4, 5, 6, 7); }
#define MFMA32(a, b, c) __builtin_amdgcn_mfma_f32_32x32x16_bf16((a), (b), (c), 0, 0, 0)
#define MFMA16(a, b, c) __builtin_amdgcn_mfma_f32_16x16x32_bf16((a), (b), (c), 0, 0, 0)
DI f32x16 zero16() { f32x16 z; for (int i = 0; i < 16; ++i) z[i] = 0.f; return z; }

namespace pg8 {
constexpr int BM = 256, BK = 64, HALF = 128, HTB = HALF * BK * 2, STAGE_BYTES = 8 * HTB, NXCD = 8, WGM = 8;
DI int lds_byte(int r, int c) { const int st = (r >> 4) * 2 + (c >> 5), rr = r & 15, cc = c & 31, ob = rr * 64 + cc * 2; return st * 1024 + (ob ^ (((ob >> 9) & 1) << 5)); }
DI void stage_rc(int b, int& R, int& C) { const int st = b / 1024, sb = b % 1024, swz = sb ^ (((sb >> 9) & 1) << 5); R = (st >> 1) * 16 + swz / 64; C = (st & 1) * 32 + (swz % 64) / 2; }
DI int perm32(int rho) { const int n = rho >> 4, i = rho & 15; return 8 * (i >> 2) + 4 * n + (i & 3); }
struct Unit { int pm, pn; };
struct Gemm { const bf16_t* A; const bf16_t* Bt; int M, N, K, lda; };
struct StaticOrder {
    int nM, nN, nwg, G, c;
    DI void init(int M, int N, int G_, int c_) { nM = M / BM; nN = N / BM; nwg = nM * nN; G = G_; c = c_; }
    DI bool next(int i, Unit& u) const {
        const long L = (long)i * G + c; if (L >= nwg) return false;
        int wgid = (int)L; { const int q = nwg / NXCD, r = nwg % NXCD, xcd = wgid % NXCD, off = wgid / NXCD; wgid = (xcd < r ? xcd * (q + 1) : r * (q + 1) + (xcd - r) * q) + off; }
        const int nig = WGM * nN, gid = wgid / nig, fm = gid * WGM, gsz = (nM - fm) < WGM ? (nM - fm) : WGM;
        u.pm = fm + ((wgid % nig) % gsz); u.pn = (wgid % nig) / gsz; return true;
    }
};
template <class F> struct Epi {
    F f;
    DI void operator()(const f32x4 (&acc)[2][2][4][2], const Unit& u, int wr, int wc, int fr, int fq) const {
        int frl = fr, fql = fq; asm volatile("" : "+v"(frl), "+v"(fql));
        const int row0 = u.pm * BM + wr * 64 + frl, col0 = u.pn * BM + wc * 32 + 8 * fql;
#pragma unroll
        for (int ai = 0; ai < 2; ++ai)
#pragma unroll
            for (int m = 0; m < 4; ++m)
#pragma unroll
                for (int bj = 0; bj < 2; ++bj) f(row0 + ai * HALF + m * 16, col0 + bj * HALF, acc[ai][bj][m][0], acc[ai][bj][m][1]);
    }
};
template <class EpiT>
DI void gemm_phase(LAS unsigned char* lds, const Gemm g, const StaticOrder& S, const EpiT& E) {
    const int tid = ltid(), wid = __builtin_amdgcn_readfirstlane(tid >> 6), lane = tid & 63, wr = wid >> 2, wc = wid & 3, fr = lane & 15, fq = lane >> 4;
    int K_ = g.K, lda_ = g.lda; asm volatile("" : "+s"(K_), "+s"(lda_));
    const int K = K_, nt = K / BK, lda = lda_;
    unsigned voffA[2], voffB[2];
#pragma unroll
    for (int i = 0; i < 2; ++i) { int R, C; stage_rc(tid * 16 + i * 8192, R, C); const int Rb = (R & ~31) + perm32(R & 31);
        voffA[i] = (unsigned)(R * lda + C) * 2u; voffB[i] = (unsigned)(Rb * K + C) * 2u; }
    const size_t kstep = (size_t)(BK * 2);
    const size_t hstepA = (size_t)HALF * lda * 2, hstepB = (size_t)HALF * K * 2;
    const size_t tstepA = 2 * hstepA, tstepB = 2 * hstepB;
    const unsigned ldsw = (unsigned)wid * 1024u;
    const int aoff = lds_byte(wr * 64 + fr, fq * 8), boff = lds_byte(wc * 32 + fr, fq * 8);
#define PG8_SA(b, h) (((b) * 2 + (h)) * HTB)
#define PG8_SB(b, h) ((4 + (b) * 2 + (h)) * HTB)
#define PG8_STAGE(bufoff, gbase, voff) do { _Pragma("unroll") for (int _i = 0; _i < 2; ++_i) \
        __builtin_amdgcn_global_load_lds((const unsigned*)((const char*)(gbase) + (voff)[_i]), (LAS unsigned*)(lds + (bufoff) + ldsw + _i * 8192), 16, 0, 0); } while (0)
#define PG8_LDA(dst, b, h) do { _Pragma("unroll") for (int m = 0; m < 4; ++m) _Pragma("unroll") for (int k = 0; k < 2; ++k) dst[m][k] = *(const LAS bf16x8*)(lds + PG8_SA(b, h) + aoff + m * 2048 + k * 1024); } while (0)
#define PG8_LDB(dst, b, h) do { _Pragma("unroll") for (int n = 0; n < 2; ++n) _Pragma("unroll") for (int k = 0; k < 2; ++k) dst[n][k] = *(const LAS bf16x8*)(lds + PG8_SB(b, h) + boff + n * 2048 + k * 1024); } while (0)
#define PG8_MMA(ai, bj, At, Bt) do { __builtin_amdgcn_s_setprio(1); _Pragma("unroll") for (int m = 0; m < 4; ++m) _Pragma("unroll") for (int n = 0; n < 2; ++n) _Pragma("unroll") for (int k = 0; k < 2; ++k) \
        acc[ai][bj][m][n] = __builtin_amdgcn_mfma_f32_16x16x32_bf16(Bt[n][k], At[m][k], acc[ai][bj][m][n], 0, 0, 0); __builtin_amdgcn_s_setprio(0); } while (0)
#define PG8_WAIT_V(n) asm volatile("s_waitcnt vmcnt(" #n ")" ::: "memory")
#define PG8_WAIT_L(n) asm volatile("s_waitcnt lgkmcnt(" #n ")" ::: "memory")
#define PG8_BAR __builtin_amdgcn_s_barrier()
#define PG8_SCHED __builtin_amdgcn_sched_barrier(0)
    Unit cur, nxt; int ui = 0;
    if (!S.next(0, cur)) return;
    f32x4 acc[2][2][4][2];
#pragma unroll
    for (int a = 0; a < 2; ++a)
#pragma unroll
        for (int b = 0; b < 2; ++b)
#pragma unroll
            for (int m = 0; m < 4; ++m)
#pragma unroll
                for (int n = 0; n < 2; ++n) acc[a][b][m][n] = (f32x4){0.f, 0.f, 0.f, 0.f};
    bf16x8 At[4][2], B0[2][2], B1[2][2];
    const char* cA = (const char*)g.A + (size_t)cur.pm * tstepA; const char* cB = (const char*)g.Bt + (size_t)cur.pn * tstepB;
    PG8_STAGE(PG8_SB(0, 0), cB, voffB); PG8_STAGE(PG8_SA(0, 0), cA, voffA); PG8_STAGE(PG8_SB(0, 1), cB + hstepB, voffB); PG8_STAGE(PG8_SA(0, 1), cA + hstepA, voffA);
    if (wr == 1) PG8_BAR;
    PG8_WAIT_V(4); PG8_BAR;
    PG8_STAGE(PG8_SB(1, 0), cB + kstep, voffB); PG8_STAGE(PG8_SA(1, 0), cA + kstep, voffA); PG8_STAGE(PG8_SB(1, 1), cB + hstepB + kstep, voffB);
    PG8_WAIT_V(6); PG8_BAR;
    for (;;) {
        const bool has_next = S.next(ui + 1, nxt);
        const char* nA = has_next ? (const char*)g.A + (size_t)nxt.pm * tstepA : cA; const char* nB = has_next ? (const char*)g.Bt + (size_t)nxt.pn * tstepB : cB;
        for (int t = 0; t < nt; t += 2) {
            const bool last = (t == nt - 2);
            const char* a1 = cA + (size_t)(t + 1) * kstep;
            const char* a2 = last ? nA : cA + (size_t)(t + 2) * kstep; const char* b2 = last ? nB : cB + (size_t)(t + 2) * kstep;
            const char* a3 = a2 + kstep; const char* b3 = b2 + kstep;
            PG8_LDB(B0, 0, 0); PG8_SCHED; PG8_LDA(At, 0, 0); PG8_STAGE(PG8_SA(1, 1), a1 + hstepA, voffA);
            PG8_WAIT_L(8); PG8_BAR; PG8_WAIT_L(0); PG8_MMA(0, 0, At, B0); PG8_BAR; PG8_SCHED;
            PG8_LDB(B1, 0, 1); PG8_STAGE(PG8_SB(0, 0), b2, voffB);
            PG8_BAR; PG8_WAIT_L(0); PG8_MMA(0, 1, At, B1); PG8_BAR;
            PG8_LDA(At, 0, 1); PG8_STAGE(PG8_SA(0, 0), a2, voffA);
            PG8_BAR; PG8_WAIT_L(0); PG8_MMA(1, 0, At, B0); PG8_BAR; PG8_SCHED;
            PG8_STAGE(PG8_SB(0, 1), b2 + hstepB, voffB);
            PG8_WAIT_V(6); PG8_BAR; PG8_MMA(1, 1, At, B1); PG8_BAR;
            PG8_LDB(B0, 1, 0); PG8_SCHED; PG8_LDA(At, 1, 0); PG8_STAGE(PG8_SA(0, 1), a2 + hstepA, voffA);
            PG8_WAIT_L(8); PG8_BAR; PG8_WAIT_L(0); PG8_MMA(0, 0, At, B0); PG8_BAR; PG8_SCHED;
            PG8_LDB(B1, 1, 1); PG8_STAGE(PG8_SB(1, 0), b3, voffB);
            PG8_BAR; PG8_WAIT_L(0); PG8_MMA(0, 1, At, B1); PG8_BAR;
            PG8_LDA(At, 1, 1); PG8_STAGE(PG8_SA(1, 0), a3, voffA);
            PG8_BAR; PG8_WAIT_L(0); PG8_MMA(1, 0, At, B0); PG8_BAR; PG8_SCHED;
            PG8_STAGE(PG8_SB(1, 1), b3 + hstepB, voffB);
            PG8_WAIT_V(6); PG8_BAR; PG8_MMA(1, 1, At, B1); PG8_BAR;
        }
        E(acc, cur, wr, wc, fr, fq);
        if (!has_next) break;
#pragma unroll
        for (int a = 0; a < 2; ++a)
#pragma unroll
            for (int b = 0; b < 2; ++b)
#pragma unroll
                for (int m = 0; m < 4; ++m)
#pragma unroll
                    for (int n = 0; n < 2; ++n) acc[a][b][m][n] = (f32x4){0.f, 0.f, 0.f, 0.f};
        cur = nxt; cA = nA; cB = nB; ++ui;
    }
    PG8_WAIT_V(0);
    if (wr == 0) PG8_BAR;
    PG8_BAR;
#undef PG8_SA
#undef PG8_SB
#undef PG8_STAGE
#undef PG8_LDA
#undef PG8_LDB
#undef PG8_MMA
#undef PG8_WAIT_V
#undef PG8_WAIT_L
#undef PG8_BAR
#undef PG8_SCHED
}
}

template <class F>
DI void big_gemm(char* smem, const bf16_t* A, int lda, const bf16_t* Bt, int M, int N, int K, int crot, const F& f) {
    pg8::Gemm g{A, Bt, M, N, K, lda};
    pg8::StaticOrder S; S.init(M, N, (int)gridDim.x, (int)((blockIdx.x + crot) % gridDim.x));
    pg8::Epi<F> E{f};
    pg8::gemm_phase(( LAS unsigned char*)smem, g, S, E);
}

template <class F>
DI void small_gemm_unit(char* smem, const bf16_t* A, int lda, const bf16_t* Wt, int ldw, int K, int n0, const F& f) {
    const int tid = ltid(), wid = tid >> 6, lane = tid & 63, r16 = lane & 15, quad = lane >> 4;
    f32x4 acc[8];
#pragma unroll
    for (int i = 0; i < 8; ++i) acc[i] = (f32x4){0.f, 0.f, 0.f, 0.f};
    {
        const int nks = K / 32;
        bf16x8 bcur, acur[8];
        if (wid < nks) { const int k0 = wid * 32 + quad * 8; bcur = ld8(Wt + (size_t)(n0 + r16) * ldw + k0);
#pragma unroll
            for (int rb = 0; rb < 8; ++rb) acur[rb] = ld8(A + (size_t)(rb * 16 + r16) * lda + k0); }
        for (int ks = wid; ks < nks; ks += 8) {
            bf16x8 bnx = bcur, anx[8];
#pragma unroll
            for (int rb = 0; rb < 8; ++rb) anx[rb] = acur[rb];
            if (ks + 8 < nks) { const int k1 = (ks + 8) * 32 + quad * 8; bnx = ld8(Wt + (size_t)(n0 + r16) * ldw + k1);
#pragma unroll
                for (int rb = 0; rb < 8; ++rb) anx[rb] = ld8(A + (size_t)(rb * 16 + r16) * lda + k1); }
#pragma unroll
            for (int rb = 0; rb < 8; ++rb) acc[rb] = MFMA16(acur[rb], bcur, acc[rb]);
            bcur = bnx;
#pragma unroll
            for (int rb = 0; rb < 8; ++rb) acur[rb] = anx[rb];
        }
    }
    float* P = (float*)smem;
#pragma unroll
    for (int rb = 0; rb < 8; ++rb)
#pragma unroll
        for (int j = 0; j < 4; ++j) P[(wid * 128 + rb * 16 + quad * 4 + j) * 16 + r16] = acc[rb][j];
    __syncthreads();
    if (tid < 256) {
        const int row = tid >> 1, c8 = (tid & 1) * 8;
        f32x4 s0 = (f32x4){0.f, 0.f, 0.f, 0.f}, s1 = s0;
#pragma unroll
        for (int w = 0; w < 8; ++w) { s0 += *(const f32x4*)&P[(w * 128 + row) * 16 + c8]; s1 += *(const f32x4*)&P[(w * 128 + row) * 16 + c8 + 4]; }
        f(row, n0 + c8, s0, s1);
    }
    __syncthreads();
}
template <class F>
DI void small_gemm_unit_h(char* smem, const bf16_t* A, int lda, const bf16_t* Wt, int ldw, int K, int n0, int row0, const F& f) {
    const int tid = ltid(), wid = tid >> 6, lane = tid & 63, r16 = lane & 15, quad = lane >> 4;
    f32x4 acc[4];
#pragma unroll
    for (int i = 0; i < 4; ++i) acc[i] = (f32x4){0.f, 0.f, 0.f, 0.f};
    {
        const int nks = K / 32;
        bf16x8 bcur, acur[4];
        if (wid < nks) { const int k0 = wid * 32 + quad * 8; bcur = ld8(Wt + (size_t)(n0 + r16) * ldw + k0);
#pragma unroll
            for (int rb = 0; rb < 4; ++rb) acur[rb] = ld8(A + (size_t)(row0 + rb * 16 + r16) * lda + k0); }
        for (int ks = wid; ks < nks; ks += 8) {
            bf16x8 bnx = bcur, anx[4];
#pragma unroll
            for (int rb = 0; rb < 4; ++rb) anx[rb] = acur[rb];
            if (ks + 8 < nks) { const int k1 = (ks + 8) * 32 + quad * 8; bnx = ld8(Wt + (size_t)(n0 + r16) * ldw + k1);
#pragma unroll
                for (int rb = 0; rb < 4; ++rb) anx[rb] = ld8(A + (size_t)(row0 + rb * 16 + r16) * lda + k1); }
#pragma unroll
            for (int rb = 0; rb < 4; ++rb) acc[rb] = MFMA16(acur[rb], bcur, acc[rb]);
            bcur = bnx;
#pragma unroll
            for (int rb = 0; rb < 4; ++rb) acur[rb] = anx[rb];
        }
    }
    float* P = (float*)smem;
#pragma unroll
    for (int rb = 0; rb < 4; ++rb)
#pragma unroll
        for (int j = 0; j < 4; ++j) P[(wid * 64 + rb * 16 + quad * 4 + j) * 16 + r16] = acc[rb][j];
    __syncthreads();
    if (tid < 128) {
        const int row = tid >> 1, c8 = (tid & 1) * 8;
        f32x4 s0 = (f32x4){0.f, 0.f, 0.f, 0.f}, s1 = s0;
#pragma unroll
        for (int w = 0; w < 8; ++w) { s0 += *(const f32x4*)&P[(w * 64 + row) * 16 + c8]; s1 += *(const f32x4*)&P[(w * 64 + row) * 16 + c8 + 4]; }
        f(row0 + row, n0 + c8, s0, s1);
    }
    __syncthreads();
}
template <class F>
DI void small_gemm_h(char* smem, const bf16_t* A, int lda, const bf16_t* Wt, int ldw, int K, int N, int bstart, const F& f) {
    const int G = gridDim.x; const int me = ((int)blockIdx.x - bstart % G + G) % G;
    for (int u = me; u < 2 * (N / 16); u += G) small_gemm_unit_h(smem, A, lda, Wt, ldw, K, (u >> 1) * 16, (u & 1) * 64, f);
}
template <class F>
DI void small_gemm_unit2(char* smem, const bf16_t* A, int lda, const bf16_t* Wt, int ldw, int K, int n0, const F& f) {
    const int tid = ltid(), wid = tid >> 6, lane = tid & 63, r16 = lane & 15, quad = lane >> 4;
    f32x4 acc[2][8];
#pragma unroll
    for (int c = 0; c < 2; ++c)
#pragma unroll
        for (int i = 0; i < 8; ++i) acc[c][i] = (f32x4){0.f, 0.f, 0.f, 0.f};
    {
        const int nks = K / 32;
        bf16x8 b0c, b1c, acur[8];
        if (wid < nks) { const int k0 = wid * 32 + quad * 8; b0c = ld8(Wt + (size_t)(n0 + r16) * ldw + k0); b1c = ld8(Wt + (size_t)(n0 + 16 + r16) * ldw + k0);
#pragma unroll
            for (int rb = 0; rb < 8; ++rb) acur[rb] = ld8(A + (size_t)(rb * 16 + r16) * lda + k0); }
        for (int ks = wid; ks < nks; ks += 8) {
            bf16x8 b0n = b0c, b1n = b1c, anx[8];
#pragma unroll
            for (int rb = 0; rb < 8; ++rb) anx[rb] = acur[rb];
            if (ks + 8 < nks) { const int k1 = (ks + 8) * 32 + quad * 8; b0n = ld8(Wt + (size_t)(n0 + r16) * ldw + k1); b1n = ld8(Wt + (size_t)(n0 + 16 + r16) * ldw + k1);
#pragma unroll
                for (int rb = 0; rb < 8; ++rb) anx[rb] = ld8(A + (size_t)(rb * 16 + r16) * lda + k1); }
#pragma unroll
            for (int rb = 0; rb < 8; ++rb) { acc[0][rb] = MFMA16(acur[rb], b0c, acc[0][rb]); acc[1][rb] = MFMA16(acur[rb], b1c, acc[1][rb]); }
            b0c = b0n; b1c = b1n;
#pragma unroll
            for (int rb = 0; rb < 8; ++rb) acur[rb] = anx[rb];
        }
    }
    float* P = (float*)smem;
#pragma unroll
    for (int c = 0; c < 2; ++c)
#pragma unroll
        for (int rb = 0; rb < 8; ++rb)
#pragma unroll
            for (int j = 0; j < 4; ++j) P[(wid * 128 + rb * 16 + quad * 4 + j) * 32 + c * 16 + r16] = acc[c][rb][j];
    __syncthreads();
    {
        const int row = tid >> 2, c8 = (tid & 3) * 8;
        f32x4 s0 = (f32x4){0.f, 0.f, 0.f, 0.f}, s1 = s0;
#pragma unroll
        for (int w = 0; w < 8; ++w) { s0 += *(const f32x4*)&P[(w * 128 + row) * 32 + c8]; s1 += *(const f32x4*)&P[(w * 128 + row) * 32 + c8 + 4]; }
        f(row, n0 + c8, s0, s1);
    }
    __syncthreads();
}
template <class F>
DI void small_gemm2(char* smem, const bf16_t* A, int lda, const bf16_t* Wt, int ldw, int K, int N, int bstart, const F& f) {
    const int G = gridDim.x; const int me = ((int)blockIdx.x - bstart % G + G) % G;
    for (int u = me; u < N / 32; u += G) small_gemm_unit2(smem, A, lda, Wt, ldw, K, u * 32, f);
}
template <class F>
DI void small_gemm(char* smem, const bf16_t* A, int lda, const bf16_t* Wt, int ldw, int K, int N, int bstart, const F& f) {
    const int G = gridDim.x; const int me = ((int)blockIdx.x - bstart % G + G) % G;
    for (int u = me; u < N / 16; u += G) small_gemm_unit(smem, A, lda, Wt, ldw, K, u * 16, f);
}

struct FZ {
    bf16_t* Z;
    DI void operator()(int row, int col, f32x4 v0, f32x4 v1) const {
        if (col >= ZC_GA && col < ZC_GB) { for (int j = 0; j < 4; ++j) { v0[j] = fgelu(v0[j]); v1[j] = fgelu(v1[j]); } }
        else if (col >= ZC_GB && col < ZC_Q) { for (int j = 0; j < 4; ++j) { v0[j] = fsilu(v0[j]); v1[j] = fsilu(v1[j]); } }
        u32x4 w; w.x = cvtpk(v0[0], v0[1]); w.y = cvtpk(v0[2], v0[3]); w.z = cvtpk(v1[0], v1[1]); w.w = cvtpk(v1[2], v1[3]);
        *(u32x4*)(Z + (size_t)row * NZ + col) = w;
    }
};
struct FB {
    bf16_t* O; int ldc;
    DI void operator()(int row, int col, f32x4 v0, f32x4 v1) const {
        u32x4 w; w.x = cvtpk(v0[0], v0[1]); w.y = cvtpk(v0[2], v0[3]); w.z = cvtpk(v1[0], v1[1]); w.w = cvtpk(v1[2], v1[3]);
        *(u32x4*)(O + (size_t)row * ldc + col) = w;
    }
};
struct FSw {
    bf16_t* G;
    DI void operator()(int row, int col, f32x4 v0, f32x4 v1) const {
        u32x2 w; w.x = cvtpk(fsilu(v0[0]) * v1[0], fsilu(v0[1]) * v1[1]); w.y = cvtpk(fsilu(v0[2]) * v1[2], fsilu(v0[3]) * v1[3]);
        *(u32x2*)(G + (size_t)row * DFF + (col >> 1)) = w;
    }
};
struct FF32 {
    float* C; int ldc;
    DI void operator()(int row, int col, f32x4 v0, f32x4 v1) const { *(f32x4*)(C + (size_t)row * ldc + col) = v0; *(f32x4*)(C + (size_t)row * ldc + col + 4) = v1; }
};
constexpr float QSCALE = 0.10206207261596575f * 1.4426950408889634f;
struct FQ {
    const float* rope; int sample; bf16_t* QN; bf16_t* QLAT;
    DI void operator()(int row, int col, f32x4 v0, f32x4 v1) const {
        if (col >= 1024) {
            const int m = col - 1024, i0 = (m & 31) >> 1;
            const int pidx = sample ? (2048 + (row & 15)) : (row & 2047);
            const f32x4 c = *(const f32x4*)(rope + pidx * 32 + i0), s = *(const f32x4*)(rope + pidx * 32 + 16 + i0);
            f32x4 a, b;
            a[0] = v0[0] * c[0] - v0[1] * s[0]; a[1] = v0[0] * s[0] + v0[1] * c[0]; a[2] = v0[2] * c[1] - v0[3] * s[1]; a[3] = v0[2] * s[1] + v0[3] * c[1];
            b[0] = v1[0] * c[2] - v1[1] * s[2]; b[1] = v1[0] * s[2] + v1[1] * c[2]; b[2] = v1[2] * c[3] - v1[3] * s[3]; b[3] = v1[2] * s[3] + v1[3] * c[3];
            v0 = a; v1 = b;
        }
        u32x4 w; w.x = cvtpk(v0[0] * QSCALE, v0[1] * QSCALE); w.y = cvtpk(v0[2] * QSCALE, v0[3] * QSCALE); w.z = cvtpk(v1[0] * QSCALE, v1[1] * QSCALE); w.w = cvtpk(v1[2] * QSCALE, v1[3] * QSCALE);
        if (!sample) *(u32x4*)(QN + (size_t)row * NQ + col) = w;
        else if (col < 1024) *(u32x4*)(QN + (size_t)row * 1024 + col) = w;
        else { const int m = col - 1024, h = m >> 5; *(u32x4*)(QLAT + ((size_t)row * 16 + h) * DLAT + 256 + (m & 31)) = w; }
    }
};
struct FQL {
    bf16_t* QLAT; int h;
    DI void operator()(int row, int col, f32x4 v0, f32x4 v1) const {
        u32x4 w; w.x = cvtpk(v0[0], v0[1]); w.y = cvtpk(v0[2], v0[3]); w.z = cvtpk(v1[0], v1[1]); w.w = cvtpk(v1[2], v1[3]);
        *(u32x4*)(QLAT + ((size_t)row * 16 + h) * DLAT + col) = w;
    }
};
struct FOS {
    bf16_t* O; int h;
    DI void operator()(int row, int col, f32x4 v0, f32x4 v1) const {
        u32x4 w; w.x = cvtpk(v0[0], v0[1]); w.y = cvtpk(v0[2], v0[3]); w.z = cvtpk(v1[0], v1[1]); w.w = cvtpk(v1[2], v1[3]);
        *(u32x4*)(O + (size_t)row * 1024 + h * 64 + col) = w;
    }
};

template <class SrcF>
DI void transpose_job(char* smem, int K, int Nout, bf16_t* WT, int ldwt, const SrcF& src, int& tile_base, int nw = -1, int me = 0) {
    float* T = (float*)smem;
    const int nkt = K / 64, ntiles = nkt * (Nout / 256), G = nw > 0 ? nw : (int)gridDim.x, tid = ltid();
    const int first = nw > 0 ? (me < 0 ? ntiles : (me - tile_base % G + G) % G) : ((int)blockIdx.x - tile_base % G + G) % G;
    float v[32];
    auto tload = [&](int t) { const int kt = t % nkt, nt = t / nkt; const int n = nt * 256 + (tid & 255), kb = kt * 64 + (tid >> 8);
#pragma unroll
        for (int j = 0; j < 32; ++j) v[j] = src(n, kb + 2 * j); };
    if (first < ntiles) tload(first);
    for (int t = first; t < ntiles; t += G) {
        const int kt = t % nkt, nt = t / nkt;
#pragma unroll
        for (int j = 0; j < 32; ++j) T[((tid >> 8) + 2 * j) * 257 + (tid & 255)] = v[j];
        if (t + G < ntiles) tload(t + G);
        __syncthreads();
#pragma unroll
        for (int i = 0; i < 4; ++i) {
            const int p = tid + 512 * i, nn = p >> 3, kp = (p & 7) * 8;
            u32x4 w;
            w.x = cvtpk(T[(kp + 0) * 257 + nn], T[(kp + 1) * 257 + nn]); w.y = cvtpk(T[(kp + 2) * 257 + nn], T[(kp + 3) * 257 + nn]);
            w.z = cvtpk(T[(kp + 4) * 257 + nn], T[(kp + 5) * 257 + nn]); w.w = cvtpk(T[(kp + 6) * 257 + nn], T[(kp + 7) * 257 + nn]);
            *(u32x4*)(WT + (size_t)(nt * 256 + nn) * ldwt + kt * 64 + kp) = w;
        }
        __syncthreads();
    }
    tile_base += ntiles;
}
struct SrcPlain { const float* W; int N; DI float operator()(int n, int k) const { return W[(size_t)k * N + n]; } };
struct SrcWin { const float* W; DI float operator()(int n, int k) const {
    int oc;
    if (n < 2048) oc = n; else if (n < 3072) oc = n - 2048 + 4096; else if (n < 3584) oc = n - 3072 + 2048; else if (n < 4096) oc = n - 3584 + 2560;
    else if (n < 5120) oc = n - 4096 + 3072; else if (n < IN_AB) oc = n; else oc = -1;
    return oc < 0 ? 0.f : W[(size_t)k * IN_AB + oc]; } };
struct SrcGU { const float* Wg; const float* Wu; DI float operator()(int n, int k) const { const int i = n >> 3, j = n & 7; return j < 4 ? Wg[(size_t)k * DFF + 4 * i + j] : Wu[(size_t)k * DFF + 4 * i + j - 4]; } };
struct SrcInc { const float* W; DI float operator()(int n, int k) const { return n < INC ? W[(size_t)k * INC + n] : 0.f; } };
struct SrcUq { const float* W; DI float operator()(int n, int k) const {
    int oc; if (n < 1024) { oc = (n >> 6) * 96 + (n & 63); } else { const int m = n - 1024, h = m >> 5, i = (m & 31) >> 1, p = m & 1; oc = h * 96 + 64 + p * 16 + i; }
    return W[(size_t)k * NQ + oc]; } };

DI void rms_rows_to_bf16(const float* X, const float* g, bf16_t* U, int nrows) {
    const int tid_ = ltid(); const int lane = tid_ & 63, gw = blockIdx.x * 8 + (tid_ >> 6), GW = gridDim.x * 8;
    f32x4 nx[4], gg4[4];
#pragma unroll
    for (int i = 0; i < 4; ++i) gg4[i] = *(const f32x4*)(g + i * 256 + lane * 4);
    if (gw < nrows) {
#pragma unroll
        for (int i = 0; i < 4; ++i) nx[i] = *(const f32x4*)(X + (size_t)gw * DM + i * 256 + lane * 4); }
    for (int r = gw; r < nrows; r += GW) {
        f32x4 a[4]; float ss = 0.f;
#pragma unroll
        for (int i = 0; i < 4; ++i) { a[i] = nx[i]; ss += a[i][0] * a[i][0] + a[i][1] * a[i][1] + a[i][2] * a[i][2] + a[i][3] * a[i][3]; }
        if (r + GW < nrows) {
#pragma unroll
            for (int i = 0; i < 4; ++i) nx[i] = *(const f32x4*)(X + (size_t)(r + GW) * DM + i * 256 + lane * 4); }
        ss = wave_sum(ss); const float rs = __builtin_amdgcn_rsqf(ss * (1.0f / DM) + EPS);
#pragma unroll
        for (int i = 0; i < 4; ++i) { const f32x4 gg = gg4[i];
            u32x2 w; w.x = cvtpk(a[i][0] * rs * gg[0], a[i][1] * rs * gg[1]); w.y = cvtpk(a[i][2] * rs * gg[2], a[i][3] * rs * gg[3]);
            *(u32x2*)(U + (size_t)r * DM + i * 256 + lane * 4) = w; }
    }
}
template <int HI, int HO>
DI void norm_rows(const bf16_t* Y, const void* Hin_, void* Hout_, const float* gpost, const float* gpre, bf16_t* U, int nrows, int dry = 0) {
    const int tid_ = ltid(); const int lane = tid_ & 63, gw = blockIdx.x * 8 + (tid_ >> 6), GW = gridDim.x * 8;
    u32x4 ry[2], rh[4];
    auto rload = [&](int r) {
#pragma unroll
        for (int i = 0; i < 2; ++i) { const int c = i * 512 + lane * 8;
            ry[i] = *(const u32x4*)(Y + (size_t)r * DM + c);
            if (HI == 0) { rh[2 * i] = *(const u32x4*)((const float*)Hin_ + (size_t)r * DM + c); rh[2 * i + 1] = *(const u32x4*)((const float*)Hin_ + (size_t)r * DM + c + 4); }
            else rh[2 * i] = *(const u32x4*)((const bf16_t*)Hin_ + (size_t)r * DM + c); }
    };
    f32x4 gp[4], gq[4];
#pragma unroll
    for (int i = 0; i < 2; ++i) { const int c = i * 512 + lane * 8; gp[2 * i] = *(const f32x4*)(gpost + c); gp[2 * i + 1] = *(const f32x4*)(gpost + c + 4);
        gq[2 * i] = gpre ? *(const f32x4*)(gpre + c) : (f32x4){0.f, 0.f, 0.f, 0.f}; gq[2 * i + 1] = gpre ? *(const f32x4*)(gpre + c + 4) : (f32x4){0.f, 0.f, 0.f, 0.f}; }
    if (gw < nrows) rload(gw);
    for (int r = gw; r < nrows; r += GW) {
        float y[16], hin[16]; float ss = 0.f;
#pragma unroll
        for (int i = 0; i < 2; ++i) { const u32x4 w = ry[i];
            y[i * 8 + 0] = lo2f(w.x); y[i * 8 + 1] = hi2f(w.x); y[i * 8 + 2] = lo2f(w.y); y[i * 8 + 3] = hi2f(w.y); y[i * 8 + 4] = lo2f(w.z); y[i * 8 + 5] = hi2f(w.z); y[i * 8 + 6] = lo2f(w.w); y[i * 8 + 7] = hi2f(w.w);
            if (HI == 0) { const f32x4 a0 = __builtin_bit_cast(f32x4, rh[2 * i]), a1 = __builtin_bit_cast(f32x4, rh[2 * i + 1]);
#pragma unroll
                for (int j = 0; j < 4; ++j) { hin[i * 8 + j] = a0[j]; hin[i * 8 + 4 + j] = a1[j]; } }
            else { const u32x4 v = rh[2 * i];
                hin[i * 8 + 0] = lo2f(v.x); hin[i * 8 + 1] = hi2f(v.x); hin[i * 8 + 2] = lo2f(v.y); hin[i * 8 + 3] = hi2f(v.y); hin[i * 8 + 4] = lo2f(v.z); hin[i * 8 + 5] = hi2f(v.z); hin[i * 8 + 6] = lo2f(v.w); hin[i * 8 + 7] = hi2f(v.w); }
        }
        if (r + GW < nrows) rload(r + GW);
#pragma unroll
        for (int i = 0; i < 16; ++i) ss += y[i] * y[i];
        ss = wave_sum(ss); const float rs = __builtin_amdgcn_rsqf(ss * (1.0f / DM) + EPS);
        float h[16]; float s2 = 0.f;
#pragma unroll
        for (int i = 0; i < 2; ++i) {
            const int c = i * 512 + lane * 8; const f32x4 g0 = gp[2 * i], g1 = gp[2 * i + 1];
#pragma unroll
            for (int j = 0; j < 4; ++j) { h[i * 8 + j] = hin[i * 8 + j] + y[i * 8 + j] * rs * g0[j]; h[i * 8 + 4 + j] = hin[i * 8 + 4 + j] + y[i * 8 + 4 + j] * rs * g1[j]; }
            if (HO == 1) {
                u32x4 w; w.x = cvtpk(h[i * 8 + 0], h[i * 8 + 1]); w.y = cvtpk(h[i * 8 + 2], h[i * 8 + 3]); w.z = cvtpk(h[i * 8 + 4], h[i * 8 + 5]); w.w = cvtpk(h[i * 8 + 6], h[i * 8 + 7]);
                if (!dry) *(u32x4*)((bf16_t*)Hout_ + (size_t)r * DM + c) = w;
                h[i * 8 + 0] = lo2f(w.x); h[i * 8 + 1] = hi2f(w.x); h[i * 8 + 2] = lo2f(w.y); h[i * 8 + 3] = hi2f(w.y); h[i * 8 + 4] = lo2f(w.z); h[i * 8 + 5] = hi2f(w.z); h[i * 8 + 6] = lo2f(w.w); h[i * 8 + 7] = hi2f(w.w);
            } else if (!dry) {
                *(f32x4*)((float*)Hout_ + (size_t)r * DM + c) = (f32x4){h[i * 8 + 0], h[i * 8 + 1], h[i * 8 + 2], h[i * 8 + 3]};
                *(f32x4*)((float*)Hout_ + (size_t)r * DM + c + 4) = (f32x4){h[i * 8 + 4], h[i * 8 + 5], h[i * 8 + 6], h[i * 8 + 7]};
            }
        }
        if (gpre) {
#pragma unroll
            for (int i = 0; i < 16; ++i) s2 += h[i] * h[i];
            s2 = wave_sum(s2); const float r2 = __builtin_amdgcn_rsqf(s2 * (1.0f / DM) + EPS);
#pragma unroll
            for (int i = 0; i < 2; ++i) { const int c = i * 512 + lane * 8; const f32x4 g0 = gq[2 * i], g1 = gq[2 * i + 1];
                u32x4 w; w.x = cvtpk(h[i * 8 + 0] * r2 * g0[0], h[i * 8 + 1] * r2 * g0[1]); w.y = cvtpk(h[i * 8 + 2] * r2 * g0[2], h[i * 8 + 3] * r2 * g0[3]);
                w.z = cvtpk(h[i * 8 + 4] * r2 * g1[0], h[i * 8 + 5] * r2 * g1[1]); w.w = cvtpk(h[i * 8 + 6] * r2 * g1[2], h[i * 8 + 7] * r2 * g1[3]);
                if (!dry) *(u32x4*)(U + (size_t)r * DM + c) = w; }
        }
    }
}

DI void lru_unit(char* smem, bf16_t* Zb, int L, int n, int half, const float* convw, const float* convb, const bf16_t* WAT, const bf16_t* WXT,
                 const float* ba, const float* bx, const float* lam, const float* conv0  , const float* h0  ,
                 float* conv_out  , float* h_out  , int dry = 0) {
    bf16_t* Xc = (bf16_t*)smem;
    float* SumA = (float*)(smem + 128 * 136 * 2);
    float* SumU = SumA + 256;
    float* Carry = SumU + 256;
    const int tid = ltid(), wid = tid >> 6, lane = tid & 63, r = lane & 31, hh = lane >> 5, tb = wid >> 1, cb = wid & 1;
    const int cl = half * 64 + cb * 32 + r;
    const int cg_ = n * 128 + cl;
    const float b_a = ba[cg_], b_x = bx[cg_], sp = fsoftplus(-lam[cg_]);
    if (tid < 64) Carry[tid] = h0 ? h0[n * 128 + half * 64 + tid] : 0.f;
    if (tid < 192 && !dry) { const int j = tid >> 6, c = n * 128 + half * 64 + (tid & 63); conv_out[j * 1024 + c] = bf2f(Zb[(size_t)(L - 3 + j) * NZ + ZC_XA + c]); }
    const int sc = (tid & 15) * 8, st = (tid >> 4) * 4;
    float cw[4][8], cbias[8];
#pragma unroll
    for (int j = 0; j < 4; ++j)
#pragma unroll
        for (int e = 0; e < 8; ++e) cw[j][e] = convw[j * 1024 + n * 128 + sc + e];
#pragma unroll
    for (int e = 0; e < 8; ++e) cbias[e] = convb[n * 128 + sc + e];
    const int nsteps = (L + 127) / 128;
    for (int step = 0; step < nsteps; ++step) {
        const int t0 = step * 128;
        {
            float xr[7][8];
#pragma unroll
            for (int j = 0; j < 7; ++j) {
                const int t = t0 + st - 3 + j;
                if (t >= 0 && t < L) { const u32x4 w = *(const u32x4*)(Zb + (size_t)t * NZ + ZC_XA + n * 128 + sc);
                    xr[j][0] = lo2f(w.x); xr[j][1] = hi2f(w.x); xr[j][2] = lo2f(w.y); xr[j][3] = hi2f(w.y); xr[j][4] = lo2f(w.z); xr[j][5] = hi2f(w.z); xr[j][6] = lo2f(w.w); xr[j][7] = hi2f(w.w); }
                else if (t < 0 && conv0) {
#pragma unroll
                    for (int e = 0; e < 8; ++e) xr[j][e] = conv0[(3 + t) * 1024 + n * 128 + sc + e]; }
                else {
#pragma unroll
                    for (int e = 0; e < 8; ++e) xr[j][e] = 0.f; }
            }
#pragma unroll
            for (int q = 0; q < 4; ++q) {
                float o[8];
#pragma unroll
                for (int e = 0; e < 8; ++e) o[e] = cbias[e] + cw[0][e] * xr[q][e] + cw[1][e] * xr[q + 1][e] + cw[2][e] * xr[q + 2][e] + cw[3][e] * xr[q + 3][e];
                u32x4 w; w.x = cvtpk(o[0], o[1]); w.y = cvtpk(o[2], o[3]); w.z = cvtpk(o[4], o[5]); w.w = cvtpk(o[6], o[7]);
                *(u32x4*)(Xc + (st + q) * 136 + sc) = w;
            }
        }
        __syncthreads();
        f32x16 accr = zero16(), acci = zero16();
#pragma unroll
        for (int ks = 0; ks < 8; ++ks) {
            const bf16x8 a = ld8(Xc + (tb * 32 + r) * 136 + ks * 16 + hh * 8);
            const bf16x8 wa = ld8(WAT + ((size_t)n * 128 + cl) * 128 + ks * 16 + hh * 8), wx = ld8(WXT + ((size_t)n * 128 + cl) * 128 + ks * 16 + hh * 8);
            accr = MFMA32(a, wa, accr); acci = MFMA32(a, wx, acci);
        }
        float av[16], uv[16];
#pragma unroll
        for (int i = 0; i < 16; ++i) {
            const int tl = tb * 32 + crow(i, hh);
            const float xf = bf2f(Xc[tl * 136 + cl]);
            const float rg = fsigmoid(accr[i] + b_a), ig = fsigmoid(acci[i] + b_x);
            const float la = -8.0f * rg * sp;
            float a = fexp(la), u = __builtin_sqrtf(neg_expm1(2.0f * la)) * (ig * xf);
            if (t0 + tl >= L) { a = 1.f; u = 0.f; }
            av[i] = a; uv[i] = u;
        }
        float PA[4], PU[4];
#pragma unroll
        for (int g = 0; g < 4; ++g) {
            float A = av[4 * g], U = uv[4 * g];
#pragma unroll
            for (int k = 1; k < 4; ++k) { U = av[4 * g + k] * U + uv[4 * g + k]; A *= av[4 * g + k]; uv[4 * g + k] = U; av[4 * g + k] = A; }
            PA[g] = A; PU[g] = U;
        }
        float QA[4], QU[4];
#pragma unroll
        for (int g = 0; g < 4; ++g) { QA[g] = __shfl_xor(PA[g], 32, 64); QU[g] = __shfl_xor(PU[g], 32, 64); }
        float CA = 1.f, CU = 0.f;
#pragma unroll
        for (int g = 0; g < 4; ++g) {
            const float A0 = hh == 0 ? PA[g] : QA[g], U0 = hh == 0 ? PU[g] : QU[g], A1 = hh == 0 ? QA[g] : PA[g], U1 = hh == 0 ? QU[g] : PU[g];
            CU = A0 * CU + U0; CA = A0 * CA;
            CU = A1 * CU + U1; CA = A1 * CA;
        }
        if (hh == 0) { SumA[tb * 64 + cb * 32 + r] = CA; SumU[tb * 64 + cb * 32 + r] = CU; }
        __syncthreads();
        float carry = Carry[(step & 1) * 64 + cb * 32 + r];
        for (int j = 0; j < tb; ++j) carry = SumA[j * 64 + cb * 32 + r] * carry + SumU[j * 64 + cb * 32 + r];
        float hcur = carry;
#pragma unroll
        for (int g = 0; g < 4; ++g) {
            float my_in;
            if (hh == 0) { my_in = hcur; hcur = PA[g] * hcur + PU[g]; hcur = QA[g] * hcur + QU[g]; }
            else { hcur = QA[g] * hcur + QU[g]; my_in = hcur; hcur = PA[g] * hcur + PU[g]; }
#pragma unroll
            for (int k = 0; k < 4; ++k) {
                const int i = 4 * g + k, tl = tb * 32 + crow(i, hh), t = t0 + tl;
                const float hv = uv[i] + av[i] * my_in;
                if (t < L && !dry) { bf16_t* p = Zb + (size_t)t * NZ + ZC_GA + cg_; *p = f2bf(hv * bf2f(*p)); }
            }
        }
        if (tb == 3 && hh == 0) { Carry[((step + 1) & 1) * 64 + cb * 32 + r] = hcur; if (step == nsteps - 1 && !dry) h_out[cg_] = hcur; }
        __syncthreads();
    }
}

DI void gla_unit(char* smem, bf16_t* Zb, int L, int hd, const float* wgate  , const float* bgate  , const float* gnorm  ,
                 const float* S0  , float* Sout  , int dry = 0) {
    float* BL = (float*)smem;
    bf16_t* Qs = (bf16_t*)(smem + 32768);
    bf16_t* Ks = Qs + 64 * 136;
    bf16_t* KTs = Ks + 64 * 136;
    bf16_t* VTs = KTs + 128 * 72;
    bf16_t* As = VTs + 256 * 72;
    float* ZRs = (float*)(As + 64 * 72);
    float* Seg = ZRs + 64 * 16;
    float* Dec = Seg + 512;
    float* SSq = Dec + 128;
    const int tid = ltid(), wid = tid >> 6, lane = tid & 63, r = lane & 31, hh = lane >> 5;
    f32x16 S[4];
#pragma unroll
    for (int d = 0; d < 4; ++d)
#pragma unroll
        for (int i = 0; i < 16; ++i) S[d][i] = S0 ? S0[(size_t)(32 * d + crow(i, hh)) * 256 + 32 * wid + r] : 0.f;
    const int gdk = tid & 127, gseg = tid >> 7;
    const float gn = gnorm[32 * wid + r];
    const int nch = (L + 63) / 64;
    for (int ch = 0; ch < nch; ++ch) {
        const int t0 = ch * 64;
        for (int e = tid; e < 64 * 16; e += 512) { const int t = e >> 4, j = e & 15; ZRs[e] = (t0 + t < L) ? bf2f(Zb[(size_t)(t0 + t) * NZ + ZC_ZR + j]) : 0.f; }
        __syncthreads();
        {
            float wg[16];
#pragma unroll
            for (int j = 0; j < 16; ++j) wg[j] = wgate[j * 512 + hd * 128 + gdk];
            const float bg = bgate[hd * 128 + gdk];
            float run = 0.f;
#pragma unroll 4
            for (int tt = 0; tt < 16; ++tt) {
                const int t = gseg * 16 + tt;
                float z = bg;
#pragma unroll
                for (int j = 0; j < 16; ++j) z += ZRs[t * 16 + j] * wg[j];
                const float lg = (t0 + t < L) ? -fsoftplus(-z) * (1.0f / 16.0f) : 0.f;
                run += lg; BL[t * 128 + gdk] = run;
            }
            Seg[gseg * 128 + gdk] = run;
        }
        __syncthreads();
        if (tid < 128) { const float s0 = Seg[tid], s1 = Seg[128 + tid], s2 = Seg[256 + tid], s3 = Seg[384 + tid]; Dec[tid] = fexp(s0 + s1 + s2 + s3); }
        {
            const int t = tid >> 3, d0 = (tid & 7) * 16, sg = t >> 4;
            const bool valid = (t0 + t) < L;
#pragma unroll 1
            for (int half8 = 0; half8 < 2; ++half8) {
                const int dk = d0 + half8 * 8;
                u32x4 qw = (u32x4){0, 0, 0, 0}, kw = qw;
                if (valid) { qw = *(const u32x4*)(Zb + (size_t)(t0 + t) * NZ + ZC_Q + hd * 128 + dk); kw = *(const u32x4*)(Zb + (size_t)(t0 + t) * NZ + ZC_K + hd * 128 + dk); }
                float q[8] = {lo2f(qw.x), hi2f(qw.x), lo2f(qw.y), hi2f(qw.y), lo2f(qw.z), hi2f(qw.z), lo2f(qw.w), hi2f(qw.w)};
                float k[8] = {lo2f(kw.x), hi2f(kw.x), lo2f(kw.y), hi2f(kw.y), lo2f(kw.z), hi2f(kw.z), lo2f(kw.w), hi2f(kw.w)};
                float qt[8], kt[8];
#pragma unroll
                for (int e = 0; e < 8; ++e) {
                    float off = 0.f, tot = 0.f;
#pragma unroll
                    for (int s = 0; s < 4; ++s) { const float sv = Seg[s * 128 + dk + e]; tot += sv; if (s < sg) off += sv; }
                    const float b = BL[t * 128 + dk + e] + off;
                    qt[e] = q[e] * fexp(b) * 0.08838834764831845f; kt[e] = k[e] * fexp(-b);
                    KTs[(dk + e) * 72 + t] = f2bf(k[e] * fexp(tot - b));
                }
                u32x4 w; w.x = cvtpk(qt[0], qt[1]); w.y = cvtpk(qt[2], qt[3]); w.z = cvtpk(qt[4], qt[5]); w.w = cvtpk(qt[6], qt[7]);
                *(u32x4*)(Qs + t * 136 + dk) = w;
                w.x = cvtpk(kt[0], kt[1]); w.y = cvtpk(kt[2], kt[3]); w.z = cvtpk(kt[4], kt[5]); w.w = cvtpk(kt[6], kt[7]);
                *(u32x4*)(Ks + t * 136 + dk) = w;
            }
        }
#pragma unroll 1
        for (int it = 0; it < 4; ++it) {
            const int p = tid + 512 * it, t = p >> 5, dv = (p & 31) * 8;
            u32x4 vw = (u32x4){0, 0, 0, 0};
            if (t0 + t < L) vw = *(const u32x4*)(Zb + (size_t)(t0 + t) * NZ + ZC_V + hd * 256 + dv);
            VTs[(dv + 0) * 72 + t] = (bf16_t)(vw.x & 0xffff); VTs[(dv + 1) * 72 + t] = (bf16_t)(vw.x >> 16); VTs[(dv + 2) * 72 + t] = (bf16_t)(vw.y & 0xffff); VTs[(dv + 3) * 72 + t] = (bf16_t)(vw.y >> 16);
            VTs[(dv + 4) * 72 + t] = (bf16_t)(vw.z & 0xffff); VTs[(dv + 5) * 72 + t] = (bf16_t)(vw.z >> 16); VTs[(dv + 6) * 72 + t] = (bf16_t)(vw.w & 0xffff); VTs[(dv + 7) * 72 + t] = (bf16_t)(vw.w >> 16);
        }
        __syncthreads();
        if (wid < 4) {
            const int tbk = wid >> 1, sbk = wid & 1;
            f32x16 a = zero16();
            if (tbk >= sbk) {
#pragma unroll
                for (int ks = 0; ks < 8; ++ks) a = MFMA32(ld8(Qs + (tbk * 32 + r) * 136 + ks * 16 + hh * 8), ld8(Ks + (sbk * 32 + r) * 136 + ks * 16 + hh * 8), a);
            }
#pragma unroll
            for (int i = 0; i < 16; ++i) { const int t = tbk * 32 + crow(i, hh), s = sbk * 32 + r; As[t * 72 + s] = f2bf(s <= t ? a[i] : 0.f); }
        }
        f32x16 o[2]; o[0] = zero16(); o[1] = zero16();
#pragma unroll
        for (int d = 0; d < 4; ++d)
#pragma unroll
            for (int s = 0; s < 2; ++s) {
                const bf16x8 bS = pack8(S[d], s);
#pragma unroll
                for (int tbk = 0; tbk < 2; ++tbk) {
                    const bf16_t* qp = Qs + (tbk * 32 + r) * 136 + d * 32 + 16 * s + 4 * hh;
                    o[tbk] = MFMA32(cat44(qp, qp + 8), bS, o[tbk]);
                }
            }
        __syncthreads();
#pragma unroll
        for (int ks = 0; ks < 4; ++ks) {
            const bf16x8 bv = ld8(VTs + (wid * 32 + r) * 72 + ks * 16 + hh * 8);
#pragma unroll
            for (int tbk = 0; tbk < 2; ++tbk) o[tbk] = MFMA32(ld8(As + (tbk * 32 + r) * 72 + ks * 16 + hh * 8), bv, o[tbk]);
        }
#pragma unroll
        for (int d = 0; d < 4; ++d)
#pragma unroll
            for (int i = 0; i < 16; ++i) S[d][i] *= Dec[32 * d + crow(i, hh)];
#pragma unroll
        for (int ks = 0; ks < 4; ++ks) {
            const bf16x8 bv = ld8(VTs + (wid * 32 + r) * 72 + ks * 16 + hh * 8);
#pragma unroll
            for (int d = 0; d < 4; ++d) S[d] = MFMA32(ld8(KTs + (d * 32 + r) * 72 + ks * 16 + hh * 8), bv, S[d]);
        }
#pragma unroll
        for (int tbk = 0; tbk < 2; ++tbk)
#pragma unroll
            for (int i = 0; i < 16; ++i) {
                float v = o[tbk][i] * o[tbk][i];
                v += __shfl_xor(v, 1, 64); v += __shfl_xor(v, 2, 64); v += __shfl_xor(v, 4, 64); v += __shfl_xor(v, 8, 64); v += __shfl_xor(v, 16, 64);
                if (r == 0) SSq[wid * 64 + tbk * 32 + crow(i, hh)] = v;
            }
        __syncthreads();
#pragma unroll
        for (int tbk = 0; tbk < 2; ++tbk)
#pragma unroll
            for (int i = 0; i < 16; ++i) {
                const int tl = tbk * 32 + crow(i, hh), t = t0 + tl;
                float ss = 0.f;
#pragma unroll
                for (int w = 0; w < 8; ++w) ss += SSq[w * 64 + tl];
                const float rs = __builtin_amdgcn_rsqf(ss * (1.0f / 256.0f) + EPS);
                if (t < L && !dry) { bf16_t* p = Zb + (size_t)t * NZ + ZC_GB + hd * 256 + 32 * wid + r; *p = f2bf(o[tbk][i] * rs * gn * bf2f(*p)); }
            }
        __syncthreads();
    }
#pragma unroll
    for (int d = 0; d < 4; ++d)
#pragma unroll
        for (int i = 0; i < 16; ++i) if (!dry) Sout[(size_t)(32 * d + crow(i, hh)) * 256 + 32 * wid + r] = S[d][i];
}


DI void gla_pre_unit(char* smem, bf16_t* Zc, int hd, const float* wgate, const float* bgate, bf16_t* OIc, float* decp, int dry = 0) {
    float* BL = (float*)smem;
    bf16_t* Qs = (bf16_t*)(smem + 33792);
    bf16_t* Ks = Qs + 64 * 136;
    bf16_t* KTs = Ks + 64 * 136;
    bf16_t* VTs = KTs + 128 * 72;
    bf16_t* As = VTs + 256 * 72;
    float* ZRs = (float*)(As + 64 * 72);
    float* Seg = ZRs + 64 * 16;
    float* Pre = Seg + 512;
    float* Tot = Pre + 512;
    const int tid = ltid(), wid = tid >> 6, lane = tid & 63, r = lane & 31, hh = lane >> 5;
    const int gdk = tid & 127, gseg = tid >> 7;
    float wg[16];
#pragma unroll
    for (int j = 0; j < 16; ++j) wg[j] = wgate[j * 512 + hd * 128 + gdk];
    const float bg = bgate[hd * 128 + gdk];
    u32x4 gq[2], gk[2], gvv[4];
    { const int t = tid >> 3, d0 = (tid & 7) * 16;
#pragma unroll
      for (int h8 = 0; h8 < 2; ++h8) { gq[h8] = *(const u32x4*)(Zc + (size_t)t * NZ + ZC_Q + hd * 128 + d0 + h8 * 8); gk[h8] = *(const u32x4*)(Zc + (size_t)t * NZ + ZC_K + hd * 128 + d0 + h8 * 8); }
#pragma unroll
      for (int it = 0; it < 4; ++it) { const int p = tid + 512 * it; gvv[it] = *(const u32x4*)(Zc + (size_t)(p >> 5) * NZ + ZC_V + hd * 256 + (p & 31) * 8); } }
    for (int e = tid; e < 64 * 16; e += 512) { const int t = e >> 4, j = e & 15; ZRs[e] = bf2f(Zc[(size_t)t * NZ + ZC_ZR + j]); }
    __syncthreads();
    {
        float run = 0.f;
#pragma unroll 4
        for (int tt = 0; tt < 16; ++tt) {
            const int t = gseg * 16 + tt;
            float z = bg;
#pragma unroll
            for (int j4 = 0; j4 < 4; ++j4) { const f32x4 zz = *(const f32x4*)(ZRs + t * 16 + j4 * 4); z += zz[0] * wg[j4 * 4] + zz[1] * wg[j4 * 4 + 1] + zz[2] * wg[j4 * 4 + 2] + zz[3] * wg[j4 * 4 + 3]; }
            run += -fsoftplus(-z) * (1.0f / 16.0f); BL[t * 132 + gdk] = run;
        }
        Seg[gseg * 128 + gdk] = run;
    }
    __syncthreads();
    if (tid < 128) { const float s0 = Seg[tid], s1 = Seg[128 + tid], s2 = Seg[256 + tid], s3 = Seg[384 + tid];
        Pre[tid] = 0.f; Pre[128 + tid] = s0; Pre[256 + tid] = s0 + s1; Pre[384 + tid] = s0 + s1 + s2; Tot[tid] = s0 + s1 + s2 + s3; decp[tid] = fexp(s0 + s1 + s2 + s3); }
    __syncthreads();
    {
        const int t = tid >> 3, d0 = (tid & 7) * 16, sg = t >> 4;
#pragma unroll
        for (int half8 = 0; half8 < 2; ++half8) {
            const int dk = d0 + half8 * 8;
            const u32x4 qw = gq[half8], kw = gk[half8];
            float q[8] = {lo2f(qw.x), hi2f(qw.x), lo2f(qw.y), hi2f(qw.y), lo2f(qw.z), hi2f(qw.z), lo2f(qw.w), hi2f(qw.w)};
            float k[8] = {lo2f(kw.x), hi2f(kw.x), lo2f(kw.y), hi2f(kw.y), lo2f(kw.z), hi2f(kw.z), lo2f(kw.w), hi2f(kw.w)};
            float qt[8], kt[8];
            const f32x4 bl0 = *(const f32x4*)(BL + t * 132 + dk), bl1 = *(const f32x4*)(BL + t * 132 + dk + 4), pr0 = *(const f32x4*)(Pre + sg * 128 + dk), pr1 = *(const f32x4*)(Pre + sg * 128 + dk + 4);
            const f32x4 to0 = *(const f32x4*)(Tot + dk), to1 = *(const f32x4*)(Tot + dk + 4);
            const int kcol = (((t >> 3) ^ ((dk >> 3) & 7)) << 3) + (t & 7);
#pragma unroll
            for (int e = 0; e < 8; ++e) {
                const float b = (e < 4 ? bl0[e & 3] + pr0[e & 3] : bl1[e & 3] + pr1[e & 3]), tot = (e < 4 ? to0[e & 3] : to1[e & 3]);
                qt[e] = q[e] * fexp(b) * 0.08838834764831845f; kt[e] = k[e] * fexp(-b);
                KTs[(dk + e) * 72 + kcol] = f2bf(k[e] * fexp(tot - b));
            }
            u32x4 w; w.x = cvtpk(qt[0], qt[1]); w.y = cvtpk(qt[2], qt[3]); w.z = cvtpk(qt[4], qt[5]); w.w = cvtpk(qt[6], qt[7]);
            *(u32x4*)(Qs + t * 136 + dk) = w;
            w.x = cvtpk(kt[0], kt[1]); w.y = cvtpk(kt[2], kt[3]); w.z = cvtpk(kt[4], kt[5]); w.w = cvtpk(kt[6], kt[7]);
            *(u32x4*)(Ks + t * 136 + dk) = w;
        }
    }
#pragma unroll
    for (int it = 0; it < 4; ++it) {
        const int p = tid + 512 * it, t = p >> 5, dv = (p & 31) * 8;
        const u32x4 vw = gvv[it];
        const int vcol = (((t >> 3) ^ ((dv >> 3) & 7)) << 3) + (t & 7);
        VTs[(dv + 0) * 72 + vcol] = (bf16_t)(vw.x & 0xffff); VTs[(dv + 1) * 72 + vcol] = (bf16_t)(vw.x >> 16); VTs[(dv + 2) * 72 + vcol] = (bf16_t)(vw.y & 0xffff); VTs[(dv + 3) * 72 + vcol] = (bf16_t)(vw.y >> 16);
        VTs[(dv + 4) * 72 + vcol] = (bf16_t)(vw.z & 0xffff); VTs[(dv + 5) * 72 + vcol] = (bf16_t)(vw.z >> 16); VTs[(dv + 6) * 72 + vcol] = (bf16_t)(vw.w & 0xffff); VTs[(dv + 7) * 72 + vcol] = (bf16_t)(vw.w >> 16);
    }
    __syncthreads();
    if (wid < 4) {
        const int tbk = wid >> 1, sbk = wid & 1;
        f32x16 a = zero16();
        if (tbk >= sbk) {
#pragma unroll
            for (int ks = 0; ks < 8; ++ks) a = MFMA32(ld8(Qs + (tbk * 32 + r) * 136 + ks * 16 + hh * 8), ld8(Ks + (sbk * 32 + r) * 136 + ks * 16 + hh * 8), a);
        }
#pragma unroll
        for (int i = 0; i < 16; ++i) { const int t = tbk * 32 + crow(i, hh), s2 = sbk * 32 + r; As[t * 72 + s2] = f2bf(s2 <= t ? a[i] : 0.f); }
    }
    if (!dry) {
#pragma unroll
    for (int it = 0; it < 2; ++it) { const int p = tid + 512 * it;
        { const int t = p >> 4, pc = p & 15; *(u32x4*)(Zc + (size_t)t * NZ + ZC_Q + hd * 128 + pc * 8) = *(const u32x4*)(Qs + t * 136 + pc * 8); }
        { const int dk = p >> 3, tp = p & 7, idx = dk * 64 + tp * 8; *(u32x4*)(Zc + (size_t)(idx >> 7) * NZ + ZC_K + hd * 128 + (idx & 127)) = *(const u32x4*)(KTs + dk * 72 + ((tp ^ ((dk >> 3) & 7)) << 3)); } }
#pragma unroll
    for (int it = 0; it < 4; ++it) { const int p = tid + 512 * it, dv = p >> 3, tp = p & 7, idx = dv * 64 + tp * 8;
        *(u32x4*)(Zc + (size_t)(idx >> 8) * NZ + ZC_V + hd * 256 + (idx & 255)) = *(const u32x4*)(VTs + dv * 72 + ((tp ^ ((dv >> 3) & 7)) << 3)); }
    }
    __syncthreads();
    f32x16 o[2]; o[0] = zero16(); o[1] = zero16();
#pragma unroll
    for (int ks = 0; ks < 4; ++ks) {
        const int dvr = wid * 32 + r; const bf16x8 bv = ld8(VTs + dvr * 72 + (((ks * 2 + hh) ^ ((dvr >> 3) & 7)) << 3));
#pragma unroll
        for (int tbk = 0; tbk < 2; ++tbk) o[tbk] = MFMA32(ld8(As + (tbk * 32 + r) * 72 + ks * 16 + hh * 8), bv, o[tbk]);
    }
    {
        bf16_t* op = OIc + ((size_t)wid * 64 + lane) * 32;
#pragma unroll
        for (int tbk = 0; tbk < 2; ++tbk)
#pragma unroll
            for (int g = 0; g < 2; ++g) { u32x4 w; w.x = cvtpk(o[tbk][8 * g], o[tbk][8 * g + 1]); w.y = cvtpk(o[tbk][8 * g + 2], o[tbk][8 * g + 3]); w.z = cvtpk(o[tbk][8 * g + 4], o[tbk][8 * g + 5]); w.w = cvtpk(o[tbk][8 * g + 6], o[tbk][8 * g + 7]);
                if (!dry) *(u32x4*)(op + tbk * 16 + g * 8) = w; }
    }
    __syncthreads();
}

DI void gla_seq_unit(char* smem, const bf16_t* Zb, int hd, bf16_t* OIb  , const float* DECb, float* Sout, int dry = 0) {
    constexpr int SEQBUF = 64 * 136 + 128 * 72 + 256 * 72;
    bf16_t* Qt = (bf16_t*)smem;
    bf16_t* KTt = Qt + 64 * 136;
    bf16_t* VTt = KTt + 128 * 72;
    float* Dec = (float*)(Qt + 2 * SEQBUF);
    const int tid = ltid(), wid = tid >> 6, lane = tid & 63, r = lane & 31, hh = lane >> 5;
    f32x16 S[4];
#pragma unroll
    for (int d = 0; d < 4; ++d) S[d] = zero16();
    u32x4 pq[2], pk[2], pv[4]; float pd = 0.f;
    auto gload = [&](int ch) {
        const bf16_t* Zc = Zb + (size_t)ch * 64 * NZ;
#pragma unroll
        for (int it = 0; it < 2; ++it) { const int p = tid + 512 * it, row = p >> 4, col = (p & 15) * 8;
            pq[it] = *(const u32x4*)(Zc + (size_t)row * NZ + ZC_Q + hd * 128 + col); pk[it] = *(const u32x4*)(Zc + (size_t)row * NZ + ZC_K + hd * 128 + col); }
#pragma unroll
        for (int it = 0; it < 4; ++it) { const int p = tid + 512 * it, row = p >> 5, col = (p & 31) * 8; pv[it] = *(const u32x4*)(Zc + (size_t)row * NZ + ZC_V + hd * 256 + col); }
        if (tid < 128) pd = DECb[ch * 128 + tid];
    };
    auto lstore = [&](int bsel) {
        const int bo = bsel * SEQBUF;
#pragma unroll
        for (int it = 0; it < 2; ++it) { const int p = tid + 512 * it;
            *(u32x4*)(Qt + bo + (p >> 4) * 136 + (p & 15) * 8) = pq[it];
            *(u32x4*)(KTt + bo + (p >> 3) * 72 + (p & 7) * 8) = pk[it]; }
#pragma unroll
        for (int it = 0; it < 4; ++it) { const int p = tid + 512 * it; *(u32x4*)(VTt + bo + (p >> 3) * 72 + (p & 7) * 8) = pv[it]; }
        if (tid < 128) Dec[bsel * 128 + tid] = pd;
    };
    gload(0); lstore(0);
    if (SEQ / 64 > 1) gload(1);
    __syncthreads();
    for (int ch = 0; ch < SEQ / 64; ++ch) {
        const int bo = (ch & 1) * SEQBUF;
        bf16_t* op = OIb + (((size_t)ch * 8 + wid) * 64 + lane) * 32;
        u32x4 oi[4];
#pragma unroll
        for (int g = 0; g < 4; ++g) oi[g] = *(const u32x4*)(op + g * 8);
        f32x16 o[2], o2[2]; o[0] = zero16(); o[1] = zero16(); o2[0] = zero16(); o2[1] = zero16();
#pragma unroll
        for (int d = 0; d < 4; ++d)
#pragma unroll
            for (int s = 0; s < 2; ++s) {
                const bf16x8 bS = pack8(S[d], s);
#pragma unroll
                for (int tbk = 0; tbk < 2; ++tbk) { const bf16_t* qp = Qt + bo + (tbk * 32 + r) * 136 + d * 32 + 16 * s + 4 * hh;
                    if (d < 2) o[tbk] = MFMA32(cat44(qp, qp + 8), bS, o[tbk]); else o2[tbk] = MFMA32(cat44(qp, qp + 8), bS, o2[tbk]); }
            }
        o[0] = o[0] + o2[0]; o[1] = o[1] + o2[1];
#pragma unroll
        for (int d = 0; d < 4; ++d)
#pragma unroll
            for (int g = 0; g < 4; ++g) { const f32x4 dv4 = *(const f32x4*)(Dec + (ch & 1) * 128 + 32 * d + 8 * g + 4 * hh);
                S[d][4 * g] *= dv4[0]; S[d][4 * g + 1] *= dv4[1]; S[d][4 * g + 2] *= dv4[2]; S[d][4 * g + 3] *= dv4[3]; }
#pragma unroll
        for (int ks = 0; ks < 4; ++ks) {
            const bf16x8 bv = ld8(VTt + bo + (wid * 32 + r) * 72 + ks * 16 + hh * 8);
#pragma unroll
            for (int d = 0; d < 4; ++d) S[d] = MFMA32(ld8(KTt + bo + (d * 32 + r) * 72 + ks * 16 + hh * 8), bv, S[d]);
        }
#pragma unroll
        for (int g = 0; g < 4; ++g) { const int tbk = g >> 1, i0 = (g & 1) * 8; const unsigned ou[4] = {oi[g].x, oi[g].y, oi[g].z, oi[g].w}; u32x4 w;
            w.x = cvtpk(o[tbk][i0 + 0] + lo2f(ou[0]), o[tbk][i0 + 1] + hi2f(ou[0])); w.y = cvtpk(o[tbk][i0 + 2] + lo2f(ou[1]), o[tbk][i0 + 3] + hi2f(ou[1]));
            w.z = cvtpk(o[tbk][i0 + 4] + lo2f(ou[2]), o[tbk][i0 + 5] + hi2f(ou[2])); w.w = cvtpk(o[tbk][i0 + 6] + lo2f(ou[3]), o[tbk][i0 + 7] + hi2f(ou[3]));
            if (!dry) *(u32x4*)(op + g * 8) = w; }
        if (ch + 1 < SEQ / 64) lstore((ch + 1) & 1);
        if (ch + 2 < SEQ / 64) gload(ch + 2);
        __syncthreads();
    }
#pragma unroll
    for (int d = 0; d < 4; ++d)
#pragma unroll
        for (int i = 0; i < 16; ++i) Sout[(size_t)(32 * d + crow(i, hh)) * 256 + 32 * wid + r] = S[d][i];
}
DI void gla_post_unit(char* smem, bf16_t* Zc, int hd, const bf16_t* OIc, const float* gnorm, int dry = 0) {
    float* SSq = (float*)smem;
    float* RS = SSq + 512;
    const int tid = ltid(), wid = tid >> 6, lane = tid & 63, r = lane & 31, hh = lane >> 5;
    const float gn = gnorm[32 * wid + r];
    float o[32];
    const bf16_t* op = OIc + ((size_t)wid * 64 + lane) * 32;
#pragma unroll
    for (int g = 0; g < 4; ++g) { const u32x4 w = *(const u32x4*)(op + g * 8);
        o[g * 8 + 0] = lo2f(w.x); o[g * 8 + 1] = hi2f(w.x); o[g * 8 + 2] = lo2f(w.y); o[g * 8 + 3] = hi2f(w.y); o[g * 8 + 4] = lo2f(w.z); o[g * 8 + 5] = hi2f(w.z); o[g * 8 + 6] = lo2f(w.w); o[g * 8 + 7] = hi2f(w.w); }
    bf16_t gv[32];
#pragma unroll
    for (int e = 0; e < 32; ++e) gv[e] = Zc[(size_t)((e >> 4) * 32 + crow(e & 15, hh)) * NZ + ZC_GB + hd * 256 + 32 * wid + r];
    float v[32];
#pragma unroll
    for (int e = 0; e < 32; ++e) v[e] = o[e] * o[e];
#pragma unroll
    for (int k = 0; k < 16; ++k) { const bool up = (r & 16) != 0; const float keep = up ? v[16 + k] : v[k], send = up ? v[k] : v[16 + k]; v[k] = keep + __shfl_xor(send, 16, 64); }
#pragma unroll
    for (int k = 0; k < 8; ++k) { const bool up = (r & 8) != 0; const float keep = up ? v[8 + k] : v[k], send = up ? v[k] : v[8 + k]; v[k] = keep + __shfl_xor(send, 8, 64); }
#pragma unroll
    for (int k = 0; k < 4; ++k) { const bool up = (r & 4) != 0; const float keep = up ? v[4 + k] : v[k], send = up ? v[k] : v[4 + k]; v[k] = keep + __shfl_xor(send, 4, 64); }
#pragma unroll
    for (int k = 0; k < 2; ++k) { const bool up = (r & 2) != 0; const float keep = up ? v[2 + k] : v[k], send = up ? v[k] : v[2 + k]; v[k] = keep + __shfl_xor(send, 2, 64); }
    { const bool up = (r & 1) != 0; const float keep = up ? v[1] : v[0], send = up ? v[0] : v[1]; v[0] = keep + __shfl_xor(send, 1, 64); }
    SSq[wid * 64 + (r >> 4) * 32 + crow(r & 15, hh)] = v[0];
    __syncthreads();
    if (tid < 64) { float ss = 0.f;
#pragma unroll
        for (int w = 0; w < 8; ++w) ss += SSq[w * 64 + tid];
        RS[tid] = __builtin_amdgcn_rsqf(ss * (1.0f / 256.0f) + EPS); }
    __syncthreads();
#pragma unroll
    for (int e = 0; e < 32; ++e) {
        const int tl = (e >> 4) * 32 + crow(e & 15, hh);
        bf16_t* p = Zc + (size_t)tl * NZ + ZC_GB + hd * 256 + 32 * wid + r; const float v_ = o[e] * RS[tl] * gn * bf2f(gv[e]); if (!dry) *p = f2bf(v_);
    }
    __syncthreads();
}

DI void lru_pre_multi(char* smem, const bf16_t* Z, int idx0, int cnt, int n, int half, const float* convw, const float* convb, const bf16_t* WAT, const bf16_t* WXT,
                      const float* ba, const float* bx, const float* lam, bf16_t* HL, bf16_t* AC, float* TA, float* TU, float* conv_all) {
    bf16_t* Xc = (bf16_t*)smem;
    float* SumA = (float*)(smem + 128 * 136 * 2);
    float* SumU = SumA + 256;
    const int tid = ltid(), wid = tid >> 6, lane = tid & 63, r = lane & 31, hh = lane >> 5, tb = wid >> 1, cb = wid & 1;
    const int cl = half * 64 + cb * 32 + r, cg_ = n * 128 + cl;
    const float b_a = ba[cg_], b_x = bx[cg_], sp = fsoftplus(-lam[cg_]);
    bf16x8 wa[8], wx[8];
#pragma unroll
    for (int ks = 0; ks < 8; ++ks) { wa[ks] = ld8(WAT + ((size_t)n * 128 + cl) * 128 + ks * 16 + hh * 8); wx[ks] = ld8(WXT + ((size_t)n * 128 + cl) * 128 + ks * 16 + hh * 8); }
    const int sc = (tid & 15) * 8, st = (tid >> 4) * 4;
    float cw[4][8], cbias[8];
#pragma unroll
    for (int j = 0; j < 4; ++j) { const f32x4 w0 = *(const f32x4*)(convw + j * 1024 + n * 128 + sc), w1 = *(const f32x4*)(convw + j * 1024 + n * 128 + sc + 4);
#pragma unroll
        for (int e = 0; e < 4; ++e) { cw[j][e] = w0[e]; cw[j][4 + e] = w1[e]; } }
    { const f32x4 w0 = *(const f32x4*)(convb + n * 128 + sc), w1 = *(const f32x4*)(convb + n * 128 + sc + 4);
#pragma unroll
        for (int e = 0; e < 4; ++e) { cbias[e] = w0[e]; cbias[4 + e] = w1[e]; } }
    u32x4 xw[7];
    auto xload = [&](int idx_) { const int bb_ = idx_ >> 4, t0_ = (idx_ & 15) * 128; const bf16_t* Zb_ = Z + (size_t)bb_ * SEQ * NZ;
#pragma unroll
        for (int j = 0; j < 7; ++j) { const int t = t0_ + st - 3 + j; xw[j] = (u32x4){0u, 0u, 0u, 0u}; if (t >= 0) xw[j] = *(const u32x4*)(Zb_ + (size_t)t * NZ + ZC_XA + n * 128 + sc); } };
    xload(idx0);
    for (int kk = 0; kk < cnt; ++kk) {
    const int idx = idx0 + kk, bb = idx >> 4, step = idx & 15;
    const bf16_t* Zb = Z + (size_t)bb * SEQ * NZ; bf16_t* HLb = HL + (size_t)bb * SEQ * 1024; bf16_t* ACb = AC + (size_t)bb * SEQ * 1024;
    float* TAp = TA + (size_t)idx * 1024; float* TUp = TU + (size_t)idx * 1024; float* conv_out = step == 15 ? conv_all + (size_t)bb * 3 * 1024 : nullptr;
    const int t0 = step * 128;
    if (conv_out && tid < 192) { const int j = tid >> 6, c = n * 128 + half * 64 + (tid & 63); conv_out[j * 1024 + c] = bf2f(Zb[(size_t)(SEQ - 3 + j) * NZ + ZC_XA + c]); }
    {
        float xr[7][8];
#pragma unroll
        for (int j = 0; j < 7; ++j) { const u32x4 w = xw[j];
            xr[j][0] = lo2f(w.x); xr[j][1] = hi2f(w.x); xr[j][2] = lo2f(w.y); xr[j][3] = hi2f(w.y); xr[j][4] = lo2f(w.z); xr[j][5] = hi2f(w.z); xr[j][6] = lo2f(w.w); xr[j][7] = hi2f(w.w); }
#pragma unroll
        for (int q = 0; q < 4; ++q) {
            float o[8];
#pragma unroll
            for (int e = 0; e < 8; ++e) o[e] = cbias[e] + cw[0][e] * xr[q][e] + cw[1][e] * xr[q + 1][e] + cw[2][e] * xr[q + 2][e] + cw[3][e] * xr[q + 3][e];
            u32x4 w; w.x = cvtpk(o[0], o[1]); w.y = cvtpk(o[2], o[3]); w.z = cvtpk(o[4], o[5]); w.w = cvtpk(o[6], o[7]);
            *(u32x4*)(Xc + (st + q) * 136 + sc) = w;
        }
    }
    if (kk + 1 < cnt) xload(idx + 1);
    __syncthreads();
    f32x16 accr = zero16(), acci = zero16();
#pragma unroll
    for (int ks = 0; ks < 8; ++ks) {
        const bf16x8 a = ld8(Xc + (tb * 32 + r) * 136 + ks * 16 + hh * 8);
        accr = MFMA32(a, wa[ks], accr); acci = MFMA32(a, wx[ks], acci);
    }
    float av[16], uv[16];
#pragma unroll
    for (int i = 0; i < 16; ++i) {
        const int tl = tb * 32 + crow(i, hh);
        const float xf = bf2f(Xc[tl * 136 + cl]);
        const float rg = fsigmoid(accr[i] + b_a), ig = fsigmoid(acci[i] + b_x);
        const float la = -8.0f * rg * sp;
        av[i] = fexp(la); uv[i] = __builtin_sqrtf(neg_expm1(2.0f * la)) * (ig * xf);
    }
    float PA[4], PU[4];
#pragma unroll
    for (int g = 0; g < 4; ++g) {
        float A = av[4 * g], U = uv[4 * g];
#pragma unroll
        for (int k = 1; k < 4; ++k) { U = av[4 * g + k] * U + uv[4 * g + k]; A *= av[4 * g + k]; uv[4 * g + k] = U; av[4 * g + k] = A; }
        PA[g] = A; PU[g] = U;
    }
    float QA[4], QU[4];
#pragma unroll
    for (int g = 0; g < 4; ++g) { QA[g] = __shfl_xor(PA[g], 32, 64); QU[g] = __shfl_xor(PU[g], 32, 64); }
    float gA[4], gU[4]; float CA = 1.f, CU = 0.f;
#pragma unroll
    for (int g = 0; g < 4; ++g) {
        if (hh == 0) { gA[g] = CA; gU[g] = CU; CU = PA[g] * CU + PU[g]; CA = PA[g] * CA; CU = QA[g] * CU + QU[g]; CA = QA[g] * CA; }
        else { CU = QA[g] * CU + QU[g]; CA = QA[g] * CA; gA[g] = CA; gU[g] = CU; CU = PA[g] * CU + PU[g]; CA = PA[g] * CA; }
    }
    if (hh == 0) { SumA[tb * 64 + cb * 32 + r] = CA; SumU[tb * 64 + cb * 32 + r] = CU; }
    __syncthreads();
    float pA = 1.f, pU = 0.f;
    for (int j = 0; j < tb; ++j) { const float sa = SumA[j * 64 + cb * 32 + r], su = SumU[j * 64 + cb * 32 + r]; pU = sa * pU + su; pA = sa * pA; }
#pragma unroll
    for (int g = 0; g < 4; ++g)
#pragma unroll
        for (int k = 0; k < 4; ++k) {
            const int i = 4 * g + k, t = t0 + tb * 32 + crow(i, hh);
            HLb[(size_t)t * 1024 + cg_] = f2bf(uv[i] + av[i] * (gA[g] * pU + gU[g]));
            ACb[(size_t)t * 1024 + cg_] = f2bf(av[i] * gA[g] * pA);
        }
    if (tb == 3 && hh == 0) { TAp[cg_] = CA * pA; TUp[cg_] = CA * pU + CU; }
    __syncthreads();
    }
}
DI void lru_fix_seq(bf16_t* Zb, int n, int q4, const bf16_t* HLb, const bf16_t* ACb, const float* TAb  , const float* TUb, float* h_out, int dry = 0) {
    const int tid = ltid(), c0 = n * 128 + q4 * 32 + (tid & 3) * 8, tl = tid >> 2;
    float carry[8];
#pragma unroll
    for (int e = 0; e < 8; ++e) carry[e] = 0.f;
    for (int s0 = 0; s0 < 16; s0 += 4) {
        u32x4 hw[4], aw[4], gw[4]; f32x4 ta0[4], ta1[4], tu0[4], tu1[4];
#pragma unroll
        for (int k = 0; k < 4; ++k) { const int stp = s0 + k, t = stp * 128 + tl;
            hw[k] = *(const u32x4*)(HLb + (size_t)t * 1024 + c0); aw[k] = *(const u32x4*)(ACb + (size_t)t * 1024 + c0); gw[k] = *(const u32x4*)(Zb + (size_t)t * NZ + ZC_GA + c0);
            ta0[k] = *(const f32x4*)(TAb + stp * 1024 + c0); ta1[k] = *(const f32x4*)(TAb + stp * 1024 + c0 + 4); tu0[k] = *(const f32x4*)(TUb + stp * 1024 + c0); tu1[k] = *(const f32x4*)(TUb + stp * 1024 + c0 + 4); }
#pragma unroll
        for (int k = 0; k < 4; ++k) {
            const int t = (s0 + k) * 128 + tl;
            const unsigned hu[4] = {hw[k].x, hw[k].y, hw[k].z, hw[k].w}, au[4] = {aw[k].x, aw[k].y, aw[k].z, aw[k].w}, gu[4] = {gw[k].x, gw[k].y, gw[k].z, gw[k].w};
            float h[8]; unsigned ou[4];
#pragma unroll
            for (int e = 0; e < 4; ++e) {
                h[2 * e] = lo2f(hu[e]) + lo2f(au[e]) * carry[2 * e]; h[2 * e + 1] = hi2f(hu[e]) + hi2f(au[e]) * carry[2 * e + 1];
                ou[e] = cvtpk(h[2 * e] * lo2f(gu[e]), h[2 * e + 1] * hi2f(gu[e]));
            }
            if (!dry) *(u32x4*)(Zb + (size_t)t * NZ + ZC_GA + c0) = (u32x4){ou[0], ou[1], ou[2], ou[3]};
            if (t == SEQ - 1) {
#pragma unroll
                for (int e = 0; e < 8; ++e) h_out[c0 + e] = h[e];
            }
#pragma unroll
            for (int e = 0; e < 4; ++e) { carry[e] = ta0[k][e] * carry[e] + tu0[k][e]; carry[4 + e] = ta1[k][e] * carry[4 + e] + tu1[k][e]; }
        }
    }
}

template <int NKS, class QF>
DI void qk_tile(const bf16_t* Kt, int kstr, const QF& qf, f32x16& s0, f32x16& s1, int r, int hh) {
    s0 = zero16(); s1 = zero16();
#pragma unroll
    for (int s = 0; s < NKS; ++s) {
        const bf16x8 q = qf(s);
        s0 = MFMA32(ld8(Kt + r * kstr + s * 16 + hh * 8), q, s0);
        s1 = MFMA32(ld8(Kt + (32 + r) * kstr + s * 16 + hh * 8), q, s1);
    }
}
template <int NKS, int NBATCH>
DI void qk_tile_stream(const bf16_t* Kt, int kstr, const bf16_t* qrow, f32x16& s0, f32x16& s1, int r, int hh) {
    s0 = zero16(); s1 = zero16();
#pragma unroll
    for (int b0 = 0; b0 < NKS; b0 += NBATCH) {
        bf16x8 q[NBATCH];
#pragma unroll
        for (int k = 0; k < NBATCH; ++k) q[k] = ld8(qrow + (b0 + k) * 16 + hh * 8);
#pragma unroll
        for (int k = 0; k < NBATCH; ++k) { const int s = b0 + k;
            s0 = MFMA32(ld8(Kt + r * kstr + s * 16 + hh * 8), q[k], s0);
            s1 = MFMA32(ld8(Kt + (32 + r) * kstr + s * 16 + hh * 8), q[k], s1); }
    }
}
template <int NDB>
DI void softmax_pv_tile(f32x16 s0, f32x16 s1, const bf16_t* Vt, int vstr, f32x16 (&o)[NDB], float& m, float& l, int nvalid, int r, int hh) {
    if (nvalid < 64) {
#pragma unroll
        for (int i = 0; i < 16; ++i) { if (crow(i, hh) >= nvalid) s0[i] = -INFINITY; if (32 + crow(i, hh) >= nvalid) s1[i] = -INFINITY; }
    }
    float mx = s0[0];
#pragma unroll
    for (int i = 1; i < 16; ++i) mx = fmaxf(mx, s0[i]);
#pragma unroll
    for (int i = 0; i < 16; ++i) mx = fmaxf(mx, s1[i]);
    mx = fmaxf(mx, __shfl_xor(mx, 32, 64));
    const float mn = fmaxf(m, mx), alpha = __builtin_amdgcn_exp2f(m - mn);
    float rs = 0.f;
#pragma unroll
    for (int i = 0; i < 16; ++i) { s0[i] = __builtin_amdgcn_exp2f(s0[i] - mn); s1[i] = __builtin_amdgcn_exp2f(s1[i] - mn); rs += s0[i] + s1[i]; }
    rs += __shfl_xor(rs, 32, 64);
    l = l * alpha + rs; m = mn;
#pragma unroll
    for (int d = 0; d < NDB; ++d)
#pragma unroll
        for (int i = 0; i < 16; ++i) o[d][i] *= alpha;
    const bf16x8 p00 = pack8(s0, 0), p01 = pack8(s0, 1), p10 = pack8(s1, 0), p11 = pack8(s1, 1);
#pragma unroll
    for (int d = 0; d < NDB; ++d) {
        const bf16_t* vp = Vt + (d * 32 + r) * vstr + 4 * hh;
        o[d] = MFMA32(cat44(vp, vp + 8), p00, o[d]);
        o[d] = MFMA32(cat44(vp + 16, vp + 24), p01, o[d]);
        o[d] = MFMA32(cat44(vp + 32, vp + 40), p10, o[d]);
        o[d] = MFMA32(cat44(vp + 48, vp + 56), p11, o[d]);
    }
}
template <int NKS, int NDB, class QF>
DI void flash_tile(const bf16_t* Kt, int kstr, const bf16_t* Vt, int vstr, const QF& qf, f32x16 (&o)[NDB], float& m, float& l, int nvalid, int r, int hh) {
    f32x16 s0, s1;
    qk_tile<NKS>(Kt, kstr, qf, s0, s1, r, hh);
    softmax_pv_tile<NDB>(s0, s1, Vt, vstr, o, m, l, nvalid, r, hh);
}

DI void attn_prompt_unit(char* smem, int b, int hd, int qb, bf16_t* QN, const bf16_t* KN, const bf16_t* KPE, const bf16_t* VT, int dry = 0) {
    constexpr int KSTR = 104, VSTR = 72, KB = 64 * KSTR, VB = 64 * VSTR;
    bf16_t* Kb = (bf16_t*)smem;
    bf16_t* Vb = Kb + 3 * KB;
    const int tid = ltid(), wid = tid >> 6, lane = tid & 63, r = lane & 31, hh = lane >> 5;
    const size_t tok0 = (size_t)b * SEQ;
    const int qrow = qb * 256 + wid * 32 + r;
    bf16x8 qf[6];
#pragma unroll
    for (int s = 0; s < 4; ++s) qf[s] = ld8(QN + (tok0 + qrow) * NQ + hd * 64 + s * 16 + hh * 8);
#pragma unroll
    for (int s = 0; s < 2; ++s) qf[4 + s] = ld8(QN + (tok0 + qrow) * NQ + 1024 + hd * 32 + s * 16 + hh * 8);
    f32x16 o[2]; o[0] = zero16(); o[1] = zero16();
    float m = -INFINITY, l = 0.f;
    const int ntiles = 4 * qb + 4, myl = 4 * qb + (wid >> 1);
    const int sr = tid >> 3, sp = tid & 7;
    u32x4 kreg, vreg, preg = (u32x4){0, 0, 0, 0};
    auto gloadK = [&](int kt) { const size_t key = tok0 + (size_t)kt * 64;
        kreg = *(const u32x4*)(KN + (key + sr) * 1024 + hd * 64 + sp * 8);
        if (tid < 256) preg = *(const u32x4*)(KPE + (key + (tid >> 2)) * 32 + (tid & 3) * 8); };
    auto gloadV = [&](int kt) { const size_t key = tok0 + (size_t)kt * 64; vreg = *(const u32x4*)(VT + (size_t)(hd * 64 + sr) * MP + key + sp * 8); };
    auto lstoreK = [&](int bi) { *(u32x4*)(Kb + bi * KB + sr * KSTR + sp * 8) = kreg; if (tid < 256) *(u32x4*)(Kb + bi * KB + (tid >> 2) * KSTR + 64 + (tid & 3) * 8) = preg; };
    auto lstoreV = [&](int bi) { *(u32x4*)(Vb + bi * VB + sr * VSTR + sp * 8) = vreg; };
    {
        gloadK(0); gloadV(0);
        const u32x4 k0 = kreg, p0 = preg;
        gloadK(1);
        const u32x4 k1 = kreg, p1 = preg;
        kreg = k0; preg = p0; lstoreK(0); lstoreV(0);
        kreg = k1; preg = p1; lstoreK(1);
    }
    __syncthreads();
    f32x16 c0 = zero16(), c1 = zero16(), n0 = zero16(), n1 = zero16();
    qk_tile<6>(Kb, KSTR, [&](int s) { return qf[s]; }, c0, c1, r, hh);
    for (int kt = 0; kt < ntiles; ++kt) {
        if (kt + 2 < ntiles) gloadK(kt + 2);
        if (kt + 1 < ntiles) gloadV(kt + 1);
        if (kt + 1 < ntiles && kt + 1 <= myl) qk_tile<6>(Kb + ((kt + 1) % 3) * KB, KSTR, [&](int s) { return qf[s]; }, n0, n1, r, hh);
        if (kt <= myl) softmax_pv_tile<2>(c0, c1, Vb + (kt & 1) * VB, VSTR, o, m, l, 64, r, hh);
        if (kt + 2 < ntiles) lstoreK((kt + 2) % 3);
        if (kt + 1 < ntiles) lstoreV((kt + 1) & 1);
        __syncthreads();
        c0 = n0; c1 = n1;
    }
    const float inv = frcp(l);
#pragma unroll
    for (int d = 0; d < 2; ++d)
#pragma unroll
        for (int g = 0; g < 4; ++g) {
            u32x2 w; w.x = cvtpk(o[d][4 * g] * inv, o[d][4 * g + 1] * inv); w.y = cvtpk(o[d][4 * g + 2] * inv, o[d][4 * g + 3] * inv);
            if (!dry) *(u32x2*)(QN + (tok0 + qrow) * NQ + hd * 64 + d * 32 + 8 * g + 4 * hh) = w;
        }
    __syncthreads();
}

DI void attn_sample_unit(char* smem, int b, int sp, const bf16_t* QLAT, const bf16_t* CC, const bf16_t* CCT, bf16_t* OP, float* ML) {
    constexpr int KSTR = 296, VSTR = 72;
    bf16_t* Kt = (bf16_t*)smem;
    bf16_t* Vt = (bf16_t*)(smem + 64 * KSTR * 2);
    const int tid = ltid(), wid = tid >> 6, lane = tid & 63, r = lane & 31, hh = lane >> 5;
    const bf16_t* qrow = QLAT + ((size_t)b * 256 + wid * 32 + r) * DLAT;
    f32x16 o[8];
#pragma unroll
    for (int d = 0; d < 8; ++d) o[d] = zero16();
    float m = -INFINITY, l = 0.f;
    for (int kt = (NKT * sp) / NSPLIT; kt < (NKT * (sp + 1)) / NSPLIT; ++kt) {
        const int key0 = kt * 64;
        {
            u32x4 kk[5], vv[4];
#pragma unroll
            for (int it = 0; it < 5; ++it) { const int p = tid + 512 * it; kk[it] = (u32x4){0u, 0u, 0u, 0u}; if (p < 64 * 36) { const int row = p / 36, pc = p % 36; kk[it] = *(const u32x4*)(CC + ((size_t)b * KEYP + key0 + row) * DLAT + pc * 8); } }
#pragma unroll
            for (int it = 0; it < 4; ++it) { const int p = tid + 512 * it, row = p >> 3, pc = p & 7; vv[it] = *(const u32x4*)(CCT + ((size_t)b * 256 + row) * KEYP + key0 + pc * 8); }
#pragma unroll
            for (int it = 0; it < 5; ++it) { const int p = tid + 512 * it; if (p < 64 * 36) { const int row = p / 36, pc = p % 36; *(u32x4*)(Kt + row * KSTR + pc * 8) = kk[it]; } }
#pragma unroll
            for (int it = 0; it < 4; ++it) { const int p = tid + 512 * it, row = p >> 3, pc = p & 7; *(u32x4*)(Vt + row * VSTR + pc * 8) = vv[it]; }
        }
        __syncthreads();
        const int nvalid = (KEYS - key0) < 64 ? (KEYS - key0) : 64;
        { f32x16 s0, s1; qk_tile_stream<18, 9>(Kt, KSTR, qrow, s0, s1, r, hh); softmax_pv_tile<8>(s0, s1, Vt, VSTR, o, m, l, nvalid, r, hh); }
        __syncthreads();
    }
    bf16_t* op = OP + (((size_t)b * NSPLIT + sp) * 256 + wid * 32 + r) * 256;
#pragma unroll
    for (int d = 0; d < 8; ++d)
#pragma unroll
        for (int g = 0; g < 4; ++g) { u32x2 w; w.x = cvtpk(o[d][4 * g], o[d][4 * g + 1]); w.y = cvtpk(o[d][4 * g + 2], o[d][4 * g + 3]); *(u32x2*)(op + d * 32 + 8 * g + 4 * hh) = w; }
    if (hh == 0) { float* ml = ML + (((size_t)b * NSPLIT + sp) * 256 + wid * 32 + r) * 2; ml[0] = m; ml[1] = l; }
}


#define XB_TMO      128
#define XB_XCNT(j)  (256  + 64 * (j))
#define XB_XSUB(j)  (1280 + 64 * (j))
#define XB_XGEN(j)  (2304 + 64 * (j))
#define XB_TOP      3328
#define XB_TOPGEN   3392
#define XCD_BAR_WORDS 3456
#define XB_SPIN_CAP (1u << 18)
DI unsigned xb_ld(unsigned* p)              { return __hip_atomic_load(p, __ATOMIC_RELAXED, __HIP_MEMORY_SCOPE_AGENT); }
DI unsigned xb_add(unsigned* p, unsigned v) { return __hip_atomic_fetch_add(p, v, __ATOMIC_RELAXED, __HIP_MEMORY_SCOPE_AGENT); }
DI unsigned xb_xcc_id() { return (unsigned)__builtin_amdgcn_s_getreg((3 << 11) | 20) & 0xFu; }
#define XB_SPIN(cond, bar) do { unsigned _sp = 0; while (cond) { __builtin_amdgcn_s_sleep(1); \
    if ((++_sp & 255u) == 0u) { if (xb_ld(&(bar)[XB_TMO])) break; if (_sp > XB_SPIN_CAP) { atomicAdd(&(bar)[XB_TMO], 1u); break; } } } } while (0)
struct XcdBarrier { unsigned* bar; unsigned x; volatile LAS unsigned* st; };
DI XcdBarrier xcd_barrier_post(unsigned* bar, volatile LAS unsigned* st) {
    XcdBarrier b; b.bar = bar; b.x = xb_xcc_id(); b.st = st;
    if (threadIdx.x == 0) (void)xb_add(&bar[XB_XCNT(b.x)], 1u);
    return b;
}
DI void xcd_barrier_complete(unsigned* bar, unsigned x, unsigned& nloc, unsigned& nx) {
    const unsigned G = gridDim.x * gridDim.y * gridDim.z;
    unsigned sum, cnt, mine, sp = 0u;
    for (;;) {
        sum = 0u; cnt = 0u; mine = 0u;
#pragma unroll
        for (unsigned j = 0; j < 16; ++j) { const unsigned c = xb_ld(&bar[XB_XCNT(j)]); sum += c; cnt += (c > 0u) ? 1u : 0u; mine = (j == x) ? c : mine; }
        if (sum == G) break;
        __builtin_amdgcn_s_sleep(1);
        if ((++sp & 255u) == 0u) { if (xb_ld(&bar[XB_TMO])) break; if (sp > XB_SPIN_CAP) { atomicAdd(&bar[XB_TMO], 1u); break; } }
    }
    nloc = mine > 0u ? mine : 1u; nx = cnt > 0u ? cnt : 1u;
}
DI void xcd_barrier(const XcdBarrier& b) {
    asm volatile("s_waitcnt vmcnt(0)" ::: "memory");
    __syncthreads();
    if (threadIdx.x == 0) {
        unsigned* bar = b.bar;
        __builtin_amdgcn_s_waitcnt(0);
        unsigned nloc = b.st[0], nx = b.st[1];
        if (nloc == 0u) { xcd_barrier_complete(bar, b.x, nloc, nx); b.st[0] = nloc; b.st[1] = nx; }
        const unsigned old = xb_add(&bar[XB_XSUB(b.x)], 1u);
        const unsigned gen = old / nloc;
        if (old + 1u == (gen + 1u) * nloc) {
            __builtin_amdgcn_fence(__ATOMIC_RELEASE, "agent");
            asm volatile("s_waitcnt vmcnt(0)" ::: "memory");
            const unsigned og = xb_add(&bar[XB_TOP], 1u);
            const unsigned tg = og / nx;
            if (og + 1u == (tg + 1u) * nx) xb_add(&bar[XB_TOPGEN], 1u);
            else XB_SPIN(xb_ld(&bar[XB_TOPGEN]) == tg, bar);
            __builtin_amdgcn_fence(__ATOMIC_ACQUIRE, "agent");
            xb_add(&bar[XB_XGEN(b.x)], 1u);
            asm volatile("s_waitcnt vmcnt(0)" ::: "memory");
        } else {
            XB_SPIN(xb_ld(&bar[XB_XGEN(b.x)]) == gen, bar);
            __builtin_amdgcn_fence(__ATOMIC_ACQUIRE, "agent");
            asm volatile("s_waitcnt vmcnt(0)" ::: "memory");
        }
    }
    __syncthreads();
}
struct Args { const float* in[33]; float* out; char* ws; int ph_lo, ph_hi; };
enum { I_XP = 0, I_XS, I_SCONV, I_SLRU, I_SGLA, I_CCKV, I_CKPE, I_NMPRE, I_NMPOST, I_NFPRE, I_NFPOST, I_WINAB, I_CONVW, I_CONVB, I_LWA, I_LBA, I_LWX, I_LBX, I_LAM,
       I_GWG, I_GBG, I_GNORM, I_WOUTAB, I_WINC, I_QNORM, I_WUQ, I_KVNORM, I_WUK, I_WUV, I_WOUTC, I_FG, I_FU, I_FD };
constexpr int NPHASE = 21;
__device__ const int PH_ORDER_unused = 0;
#ifndef PH_MASK
#define PH_MASK 0x3FFFFF
#endif
#define PHM(n) ((PH_MASK >> (n)) & 1)
#ifndef PROBE_DUP
#define PROBE_DUP 0
#endif

extern __shared__ __attribute__((aligned(16))) unsigned char dyn_lds[];

__global__ void __launch_bounds__(512, 2) mk_fwd(Args a) {
    char* smem = (char*)dyn_lds;
    char* ws = a.ws; float* out = a.out;
    const int G = gridDim.x, bid = blockIdx.x;
    bf16_t* WIN = (bf16_t*)(ws + WS_WIN); bf16_t* WOUT = (bf16_t*)(ws + WS_WOUT); bf16_t* WGU0 = (bf16_t*)(ws + WS_WGU0); bf16_t* WDN0 = (bf16_t*)(ws + WS_WDN0);
    bf16_t* WAT = (bf16_t*)(ws + WS_WAT); bf16_t* WXT = WAT + 8 * 128 * 128; float* ROPE = (float*)(ws + WS_ROPE);
    bf16_t* Us = (bf16_t*)(ws + WS_US); bf16_t* Zs = (bf16_t*)(ws + WS_ZS); bf16_t* Gs = (bf16_t*)(ws + WS_GS); float* CQs = (float*)(ws + WS_CQS);
    bf16_t* CQNs = (bf16_t*)(ws + WS_CQNS); bf16_t* QNs = (bf16_t*)(ws + WS_QNS); bf16_t* QLAT = (bf16_t*)(ws + WS_QLAT); float* ML = (float*)(ws + WS_ML);
    bf16_t* OLAT = (bf16_t*)(ws + WS_OLAT); bf16_t* Os = (bf16_t*)(ws + WS_OS);
    bf16_t* U = (bf16_t*)(ws + WS_U); bf16_t* Z = (bf16_t*)(ws + WS_Z);
    bf16_t* WGU1 = (bf16_t*)(ws + ZR_WGU1); bf16_t* WDN1 = (bf16_t*)(ws + ZR_WDN1); bf16_t* WINC = (bf16_t*)(ws + WS_WINC); bf16_t* WUQ = (bf16_t*)(ws + WS_WUQ);
    bf16_t* WUKT = (bf16_t*)(ws + WS_WUKT); bf16_t* WUVT = (bf16_t*)(ws + WS_WUVT); bf16_t* WOC = (bf16_t*)(ws + WS_WOC); bf16_t* WUK = (bf16_t*)(ws + WS_WUKP);
    bf16_t* CC = (bf16_t*)(ws + ZR_CC); bf16_t* CCT = (bf16_t*)(ws + ZR_CCT); bf16_t* Gp = (bf16_t*)(ws + ZR_G);
    float* CQ = (float*)(ws + ZR_QN); bf16_t* QN = (bf16_t*)(ws + ZR_QN); bf16_t* VT = (bf16_t*)(ws + ZR_VT); bf16_t* OP = (bf16_t*)(ws + WS_WIN);
    bf16_t* CQN = (bf16_t*)(ws + ZR_CQN); bf16_t* CKVN = (bf16_t*)(ws + ZR_CKVN); bf16_t* KPE = (bf16_t*)(ws + ZR_KPE);
    bf16_t* U0 = (bf16_t*)(out + O_YP);
    float* Hp = out + O_YP; float* Hs = out + O_YS;
    bf16_t* Hb = (bf16_t*)(out + O_YP);
    bf16_t* Hb2 = (bf16_t*)(ws + ZR_CC);

    volatile LAS unsigned* bst = (volatile LAS unsigned*)(dyn_lds + LDS_BYTES - 16);
    if (threadIdx.x == 0) { bst[0] = 0u; bst[1] = 0u; }
    __syncthreads();
    XcdBarrier xb = xcd_barrier_post((unsigned*)(ws + WS_CTL), bst);
    if (a.ph_hi > NPHASE) cg::this_grid().sync();
    for (int ph = a.ph_lo; ph < a.ph_hi; ++ph) {
        if (ph > a.ph_lo) xcd_barrier(xb);
        const int phc = ph < 2 ? ph : (ph == 2 ? 20 : (ph == 3 ? 2 : (ph == 4 ? 21 : ph - 2)));
        for (int rep_ = 0; rep_ < (((PROBE_DUP >> phc) & 1) ? 2 : 1); ++rep_) {
        if (rep_) __syncthreads();
        const int dry_ = (((PROBE_DUP >> phc) & 1) && rep_ == 0) ? 1 : 0;
        int r9lo = 0, r9hi = 0;
        switch (phc) {
        case 0: if (PHM(0)) {
            const int tid = ltid(), wid = tid >> 6, lane = tid & 63; (void)wid; (void)lane;
            int tb = 0;
            transpose_job(smem, 1024, NZ, WIN, 1024, SrcWin{a.in[I_WINAB]}, tb);
            transpose_job(smem, 2048, 1024, WOUT, 2048, SrcPlain{a.in[I_WOUTAB], 1024}, tb);
            for (int e = bid * 512 + tid; e < 2 * 8 * 128 * 16; e += G * 512) {
                const int which = e >> 14, idx = e & 16383, n = idx >> 11, cg8 = (idx >> 7) & 15, d = idx & 127;
                const float* wsrc = a.in[which ? I_LWX : I_LWA] + ((size_t)(n * 128 + cg8 * 8)) * 128 + d;
                float v[8];
#pragma unroll
                for (int k = 0; k < 8; ++k) v[k] = wsrc[k * 128];
                u32x4 w; w.x = cvtpk(v[0], v[1]); w.y = cvtpk(v[2], v[3]); w.z = cvtpk(v[4], v[5]); w.w = cvtpk(v[6], v[7]);
                *(u32x4*)(WAT + (size_t)which * 131072 + ((size_t)(n * 128 + d)) * 128 + cg8 * 8) = w;
            }
            for (int e = bid * 512 + tid; e < 2064 * 16; e += G * 512) {
                const int pi = e >> 4, i = e & 15; const int pos = pi < 2048 ? pi : PAST + (pi - 2048);
                const float inv = __builtin_amdgcn_exp2f(-(float)i * 0.830482023721841f);
                const float ang = (float)pos * inv;
                const double rev = (double)ang * 0.15915494309189535; const float fr = (float)(rev - floor(rev));
                ROPE[pi * 32 + i] = __builtin_amdgcn_cosf(fr); ROPE[pi * 32 + 16 + i] = __builtin_amdgcn_sinf(fr);
            }
            rms_rows_to_bf16(a.in[I_XP], a.in[I_NMPRE], U0, MP);
            rms_rows_to_bf16(a.in[I_XS], a.in[I_NMPRE], Us, MS);
        } break;
        case 1: if (PHM(1)) {
            big_gemm(smem, U0, 1024, WIN, MP, 5120, 1024, 0, FZ{Z});
            for (int u = (bid + G - 64 % G) % G; u < MP / 128; u += G) small_gemm_unit(smem, U0 + (size_t)u * 128 * 1024, 1024, WIN, 1024, 1024, ZC_ZR, FZ{Z + (size_t)u * 128 * NZ});
            small_gemm(smem, Us, 1024, WIN, 1024, 1024, IN_AB, 192, FZ{Zs});
        } break;
        case 20: if (PHM(20)) {
            bf16_t* HL = (bf16_t*)(out + O_YP); bf16_t* AC = HL + (size_t)MP * 1024; float* DEC = (float*)(ws + WS_DEC); float* TA = (float*)(ws + WS_TA); float* TU = (float*)(ws + WS_TU);
            for (int u = bid; u < 1024; u += G) { const int b = u >> 7, hd = (u >> 5) & 3, ch = u & 31;
                gla_pre_unit(smem, Z + ((size_t)b * SEQ + ch * 64) * NZ, hd, a.in[I_GWG], a.in[I_GBG], U + ((size_t)(b * 4 + hd) * 32 + ch) * 16384, DEC + ((size_t)(b * 4 + hd) * 32 + ch) * 128, dry_); }
        } break;
        case 2: if (PHM(2)) {
            bf16_t* HL = (bf16_t*)(out + O_YP); bf16_t* AC = HL + (size_t)MP * 1024; float* DEC = (float*)(ws + WS_DEC); float* TA = (float*)(ws + WS_TA); float* TU = (float*)(ws + WS_TU);
            if (bid < 32) { const int b = bid >> 2, hd = bid & 3;
                gla_seq_unit(smem, Z + (size_t)b * SEQ * NZ, hd, U + (size_t)(b * 4 + hd) * 32 * 16384, DEC + (size_t)(b * 4 + hd) * 32 * 128, out + O_PS + ((size_t)b * 4 + hd) * 128 * 256, dry_);
            }
            const int nb2 = G > 64 ? G - 32 : G, me2 = G > 64 ? (int)bid - 32 : (int)bid;
            if (me2 >= 0) for (int u = me2; u < 32 + 128; u += nb2) {
                if (u < 32) { const int b = u >> 2, hd = u & 3;
                    gla_unit(smem, Zs + (size_t)b * DSEQ * NZ, DSEQ, hd, a.in[I_GWG], a.in[I_GBG], a.in[I_GNORM], a.in[I_SGLA] + ((size_t)b * 4 + hd) * 128 * 256, out + O_SS + ((size_t)b * 4 + hd) * 128 * 256, dry_);
                } else { const int w = u - 32, b = w >> 4, n = (w >> 1) & 7, half = w & 1;
                    lru_unit(smem, Zs + (size_t)b * DSEQ * NZ, DSEQ, n, half, a.in[I_CONVW], a.in[I_CONVB], WAT, WXT, a.in[I_LBA], a.in[I_LBX], a.in[I_LAM],
                             a.in[I_SCONV] + (size_t)b * 3 * 1024, a.in[I_SLRU] + (size_t)b * 1024, out + O_SCONV + (size_t)b * 3 * 1024, out + O_SH + (size_t)b * 1024, dry_);
                }
                __syncthreads();
            }
            const int sk2 = nb2 >= 96 ? 32 : 0;
            if (me2 >= sk2) { const int m3 = me2 - sk2, n3 = nb2 - sk2; const int nh = m3 & 15, grp = m3 >> 4, ngrp = (n3 + 15 - nh) / 16;
              if (ngrp > 0) { const int per = (128 + ngrp - 1) / ngrp, i0 = grp * per, i1 = (i0 + per < 128) ? i0 + per : 128;
                if (i0 < i1) lru_pre_multi(smem, Z, i0, i1 - i0, nh >> 1, nh & 1, a.in[I_CONVW], a.in[I_CONVB], WAT, WXT, a.in[I_LBA], a.in[I_LBX], a.in[I_LAM], HL, AC, TA, TU, out + O_PCONV); } }
            { int tb2 = 0;
              transpose_job(smem, 1024, NGU, WGU0, 1024, SrcGU{a.in[I_FG], a.in[I_FU]}, tb2, nb2, G > 64 ? me2 : (int)bid);
              transpose_job(smem, DFF, 1024, WDN0, DFF, SrcPlain{a.in[I_FD], 1024}, tb2, nb2, G > 64 ? me2 : (int)bid);
              const int mw = G > 64 ? me2 : (int)bid;
              transpose_job(smem, 1024, NINC, WINC, 1024, SrcInc{a.in[I_WINC]}, tb2, nb2, mw);
              transpose_job(smem, 384, NQ, WUQ, 384, SrcUq{a.in[I_WUQ]}, tb2, nb2, mw);
              transpose_job(smem, 256, 1024, WUKT, 256, SrcPlain{a.in[I_WUK], 1024}, tb2, nb2, mw);
              transpose_job(smem, 256, 1024, WUVT, 256, SrcPlain{a.in[I_WUV], 1024}, tb2, nb2, mw);
              transpose_job(smem, 1024, 1024, WOC, 1024, SrcPlain{a.in[I_WOUTC], 1024}, tb2, nb2, mw);
              if (mw >= 0) { const int tid = ltid(); for (int e = mw * 512 + tid; e < 256 * 1024 / 4; e += nb2 * 512) { const f32x4 v = *(const f32x4*)(a.in[I_WUK] + (size_t)e * 4); u32x2 w; w.x = cvtpk(v[0], v[1]); w.y = cvtpk(v[2], v[3]); *(u32x2*)(WUK + (size_t)e * 4) = w; } } }
        } break;
        case 21: if (PHM(21)) {
            for (int u = bid; u < 1024; u += G) { const int b = u >> 7, hd = (u >> 5) & 3, ch = u & 31;
                gla_post_unit(smem, Z + ((size_t)b * SEQ + ch * 64) * NZ, hd, U + ((size_t)(b * 4 + hd) * 32 + ch) * 16384, a.in[I_GNORM], dry_); }
            { bf16_t* HL = (bf16_t*)(out + O_YP); bf16_t* AC = HL + (size_t)MP * 1024; float* TA = (float*)(ws + WS_TA); float* TU = (float*)(ws + WS_TU);
              for (int v = bid; v < 256; v += G) { const int b = v >> 5, n = (v >> 2) & 7, q4 = v & 3;
                lru_fix_seq(Z + (size_t)b * SEQ * NZ, n, q4, HL + (size_t)b * SEQ * 1024, AC + (size_t)b * SEQ * 1024, TA + (size_t)b * 16 * 1024, TU + (size_t)b * 16 * 1024, out + O_PH + (size_t)b * 1024, dry_); } }
            small_gemm_h(smem, Zs + ZC_GA, NZ, WOUT, 2048, 2048, 1024, 0, FB{Us, 1024});
        } break;
        case 3: if (PHM(3)) {
            big_gemm(smem, Z + ZC_GA, NZ, WOUT, MP, 1024, 2048, 0, FB{U, 1024});
            norm_rows<0, 0>(Us, a.in[I_XS], Hs, a.in[I_NMPOST], a.in[I_NFPRE], Us, MS, dry_);
        } break;
        case 4: if (PHM(4)) {
            const int tid = ltid(), wid = tid >> 6, lane = tid & 63; (void)wid; (void)lane;
            norm_rows<0, 1>(U, a.in[I_XP], Hb, a.in[I_NMPOST], a.in[I_NFPRE], U, MP, dry_);
            { int tb = 0; for (int b = 0; b < NB; ++b) transpose_job(smem, PAST, 256, CCT + (size_t)b * 256 * KEYP, KEYP, SrcPlain{a.in[I_CCKV] + (size_t)b * PAST * 256, 256}, tb); }
            for (int e0 = bid * 512 + tid; e0 < NB * PAST * 64; e0 += 4 * G * 512) {
                f32x4 v[4];
#pragma unroll
                for (int k = 0; k < 4; ++k) { const int e = e0 + k * G * 512; v[k] = (f32x4){0.f, 0.f, 0.f, 0.f}; if (e < NB * PAST * 64) v[k] = *(const f32x4*)(a.in[I_CCKV] + (size_t)(e >> 6) * 256 + (e & 63) * 4); }
#pragma unroll
                for (int k = 0; k < 4; ++k) { const int e = e0 + k * G * 512; if (e < NB * PAST * 64) { const int row = e >> 6, c4 = (e & 63) * 4; const int b = row >> 12, key = row & 4095;
                    u32x2 w; w.x = cvtpk(v[k][0], v[k][1]); w.y = cvtpk(v[k][2], v[k][3]); *(u32x2*)(CC + ((size_t)b * KEYP + key) * DLAT + c4) = w; } }
            }
            {
                float x1[4], x2[4];
#pragma unroll
                for (int k = 0; k < 4; ++k) { const int e = bid * 512 + tid + k * G * 512; x1[k] = 0.f; x2[k] = 0.f;
                    if (e < NB * PAST * 16) { const int row = e >> 4, i = e & 15; x1[k] = a.in[I_CKPE][(size_t)row * 32 + i]; x2[k] = a.in[I_CKPE][(size_t)row * 32 + 16 + i]; } }
#pragma unroll
                for (int k = 0; k < 4; ++k) { const int e = bid * 512 + tid + k * G * 512;
                    if (e < NB * PAST * 16) { const int row = e >> 4, i = e & 15; const int b = row >> 12, key = row & 4095; *(unsigned*)(CC + ((size_t)b * KEYP + key) * DLAT + 256 + 2 * i) = cvtpk(x1[k], x2[k]); } }
                for (int e = bid * 512 + tid + 4 * G * 512; e < NB * PAST * 16; e += G * 512) { const int row = e >> 4, i = e & 15; const int b = row >> 12, key = row & 4095;
                    *(unsigned*)(CC + ((size_t)b * KEYP + key) * DLAT + 256 + 2 * i) = cvtpk(a.in[I_CKPE][(size_t)row * 32 + i], a.in[I_CKPE][(size_t)row * 32 + 16 + i]); }
            }
            small_gemm2(smem, Us, 1024, WGU0, 1024, 1024, NGU, 0, FSw{Gs});
        } break;
        case 5: if (PHM(5)) {
            big_gemm(smem, U, 1024, WGU0, MP, NGU, 1024, 0, FSw{Gp});
            { int tb5 = 0; const int nw5 = G > 128 ? G - 128 : G, me5 = G > 128 ? (int)bid - 128 : (int)bid;
              transpose_job(smem, 1024, NGU, WGU1, 1024, SrcGU{a.in[I_FG] + (size_t)1024 * DFF, a.in[I_FU] + (size_t)1024 * DFF}, tb5, nw5, me5);
              transpose_job(smem, DFF, 1024, WDN1, DFF, SrcPlain{a.in[I_FD] + (size_t)DFF * 1024, 1024}, tb5, nw5, me5); }
            small_gemm(smem, Gs, DFF, WDN0, DFF, DFF, 1024, 128, FB{Us, 1024});
        } break;
        case 6: if (PHM(6)) {
            big_gemm(smem, Gp, DFF, WDN0, MP, 1024, DFF, 0, FB{U, 1024});
            norm_rows<0, 0>(Us, Hs, Hs, a.in[I_NFPOST], a.in[I_NMPRE] + 1024, Us, MS, dry_);
        } break;
        case 7: if (PHM(7)) {
            norm_rows<1, 1>(U, Hb, Hb, a.in[I_NFPOST], a.in[I_NMPRE] + 1024, U, MP, dry_);
            small_gemm_h(smem, Us, 1024, WINC, 1024, 1024, INC, 0, FF32{CQs, NINC});
        } break;
        case 8: if (PHM(8)) {
            big_gemm(smem, U, 1024, WINC, MP, NINC, 1024, 0, FF32{CQ, NINC});
            r9lo = MP; r9hi = MP + MS;
        } break;
        case 9: if (PHM(9)) {
            r9lo = 0; r9hi = MP;
            small_gemm_h(smem, CQNs, 384, WUQ, 384, 384, NQ, 0, FQ{ROPE, 1, QNs, QLAT});
        } break;
        case 10: if (PHM(10)) {
            big_gemm(smem, CQN, 384, WUQ, MP, NQ, 384, 0, FQ{ROPE, 0, QN, nullptr});
            big_gemm(smem, CKVN, 256, WUKT, MP, 1024, 256, 128, FB{U, 1024});
            big_gemm(smem, WUVT, 256, CKVN, 1024, MP, 256, 128, FB{VT, MP});
            for (int u = bid; u < 256; u += G) { const int hd = u >> 4, nt = u & 15; small_gemm_unit(smem, QNs + hd * 64, 1024, WUK + hd * 64, 1024, 64, nt * 16, FQL{QLAT, hd}); }
        } break;
        case 11: if (PHM(11)) {
            { const int bh = bid >> 1, set = bid & 1, b = bh >> 4, hd = bh & 15;
              if (bid < 256) for (int i = 0; i < 4; ++i) { const int qb = set ? (i & 1 ? 2 + (i >> 1) : 5 - (i >> 1)) : (i & 1 ? (i >> 1) : 7 - (i >> 1)); attn_prompt_unit(smem, b, hd, qb, QN, U, KPE, VT, dry_); }
              if (G < 256) {   for (int u = G + bid; u < 256; u += G) { const int bh2 = u >> 1, s2 = u & 1; for (int i = 0; i < 4; ++i) { const int qb = s2 ? (i & 1 ? 2 + (i >> 1) : 5 - (i >> 1)) : (i & 1 ? (i >> 1) : 7 - (i >> 1)); attn_prompt_unit(smem, bh2 >> 4, bh2 & 15, qb, QN, U, KPE, VT, dry_); } } } }
            for (int u = bid; u < NB * NSPLIT; u += G) attn_sample_unit(smem, u / NSPLIT, u % NSPLIT, QLAT, CC, CCT, OP, ML);
        } break;
        case 12: if (PHM(12)) {
            big_gemm(smem, QN, NQ, WOC, MP, 1024, 1024, 0, FB{U, 1024});
            { const int tid = ltid(), wid = tid >> 6, lane = tid & 63; (void)lane;
            const int gw = bid * 8 + wid, GW = G * 8;
            for (int rr = gw; rr < 2048; rr += GW) { const int b = rr >> 8, qr = rr & 255;
                float mm[NSPLIT], ll[NSPLIT]; float M = -INFINITY;
#pragma unroll
                for (int j = 0; j < NSPLIT; ++j) { const float* ml = ML + (((size_t)b * NSPLIT + j) * 256 + qr) * 2; mm[j] = ml[0]; ll[j] = ml[1]; M = fmaxf(M, mm[j]); }
                float Lt = 0.f; f32x4 acc = (f32x4){0.f, 0.f, 0.f, 0.f};
#pragma unroll
                for (int j = 0; j < NSPLIT; ++j) { const float w = __builtin_amdgcn_exp2f(mm[j] - M); Lt += w * ll[j];
                    const u32x2 pv = *(const u32x2*)(OP + (((size_t)b * NSPLIT + j) * 256 + qr) * 256 + lane * 4); acc += (f32x4){lo2f(pv.x), hi2f(pv.x), lo2f(pv.y), hi2f(pv.y)} * w; }
                const float inv = frcp(Lt); u32x2 w; w.x = cvtpk(acc[0] * inv, acc[1] * inv); w.y = cvtpk(acc[2] * inv, acc[3] * inv);
                *(u32x2*)(OLAT + (size_t)rr * 256 + lane * 4) = w; }
            }
        } break;
        case 13: if (PHM(13)) {
            const int tid = ltid(), wid = tid >> 6, lane = tid & 63; (void)wid; (void)lane;
            norm_rows<1, 1>(U, Hb, Hb2, a.in[I_NMPOST] + 1024, a.in[I_NFPRE] + 1024, U, MP, dry_);
            for (int u = bid; u < 128; u += G) { const int hd = u >> 3, nt = (u >> 1) & 3, hf = u & 1; small_gemm_unit_h(smem, OLAT + hd * 256, 4096, WUVT + (size_t)hd * 64 * 256, 256, 256, nt * 16, hf * 64, FOS{Os, hd}); }
        } break;
        case 14: if (PHM(14)) {
            big_gemm(smem, U, 1024, WGU1, MP, NGU, 1024, 0, FSw{Gp});
            small_gemm(smem, Os, 1024, WOC, 1024, 1024, 1024, 128, FB{Us, 1024});
        } break;
        case 15: if (PHM(15)) {
            big_gemm(smem, Gp, DFF, WDN1, MP, 1024, DFF, 0, FB{U, 1024});
            norm_rows<0, 0>(Us, Hs, Hs, a.in[I_NMPOST] + 1024, a.in[I_NFPRE] + 1024, Us, MS, dry_);
        } break;
        case 16: if (PHM(16)) {
            norm_rows<1, 0>(U, Hb2, Hp, a.in[I_NFPOST] + 1024, nullptr, nullptr, MP, dry_);
            small_gemm2(smem, Us, 1024, WGU1, 1024, 1024, NGU, 0, FSw{Gs});
        } break;
        case 17: if (PHM(17)) small_gemm_h(smem, Gs, DFF, WDN1, DFF, DFF, 1024, 0, FB{Us, 1024}); break;
        case 18: if (PHM(18)) norm_rows<0, 0>(Us, Hs, Hs, a.in[I_NFPOST] + 1024, nullptr, nullptr, MS, dry_); break;
        default: break;
        }
        if (r9hi > r9lo) {
            const int tid = ltid(), wid = tid >> 6, lane = tid & 63; (void)wid; (void)lane;
            const int gw = bid * 8 + wid, GW = G * 8;
            float nq[6]; f32x4 nkv = (f32x4){0.f, 0.f, 0.f, 0.f}; float nx1 = 0.f, nx2 = 0.f;
            auto p9load = [&](int rr_) { const bool smp_ = rr_ >= MP; const float* cq_ = (smp_ ? CQs + (size_t)(rr_ - MP) * NINC : CQ + (size_t)rr_ * NINC);
#pragma unroll
                for (int i = 0; i < 6; ++i) nq[i] = cq_[i * 64 + lane];
                nkv = *(const f32x4*)(cq_ + 384 + lane * 4); nx1 = cq_[640 + (lane & 15)]; nx2 = cq_[656 + (lane & 15)]; };
            float gqn[6];
#pragma unroll
            for (int i = 0; i < 6; ++i) gqn[i] = a.in[I_QNORM][i * 64 + lane];
            const f32x4 gkn = *(const f32x4*)(a.in[I_KVNORM] + lane * 4);
            if (r9lo + gw < r9hi) p9load(r9lo + gw);
            for (int rr = r9lo + gw; rr < r9hi; rr += GW) {
                const bool smp = rr >= MP; const int row = smp ? rr - MP : rr;
                const float* cq = (smp ? CQs : CQ) + (size_t)row * NINC;
                float q[6]; float ss = 0.f;
#pragma unroll
                for (int i = 0; i < 6; ++i) { q[i] = nq[i]; ss += q[i] * q[i]; }
                const f32x4 kv = nkv; const float x1 = nx1, x2 = nx2;
                if (rr + GW < r9hi) p9load(rr + GW);
                ss = wave_sum(ss); const float rq = __builtin_amdgcn_rsqf(ss * (1.0f / 384.0f) + EPS);
                bf16_t* cqn = (smp ? CQNs : CQN) + (size_t)row * 384;
#pragma unroll
                for (int i = 0; i < 6; ++i) cqn[i * 64 + lane] = f2bf(q[i] * rq * gqn[i]);
                float s2 = kv[0] * kv[0] + kv[1] * kv[1] + kv[2] * kv[2] + kv[3] * kv[3]; s2 = wave_sum(s2); const float rk = __builtin_amdgcn_rsqf(s2 * (1.0f / 256.0f) + EPS);
                const f32x4 gk = gkn;
                const f32x4 kn = (f32x4){kv[0] * rk * gk[0], kv[1] * rk * gk[1], kv[2] * rk * gk[2], kv[3] * rk * gk[3]};
                *(f32x4*)(out + (smp ? O_SCKV : O_PCKV) + (size_t)row * 256 + lane * 4) = kn;
                u32x2 w; w.x = cvtpk(kn[0], kn[1]); w.y = cvtpk(kn[2], kn[3]);
                const int b = row >> 4, t = row & 15;
                if (!smp) *(u32x2*)(CKVN + (size_t)row * 256 + lane * 4) = w;
                else { *(u32x2*)(CC + ((size_t)b * KEYP + PAST + t) * DLAT + lane * 4) = w;
#pragma unroll
                    for (int j = 0; j < 4; ++j) CCT[((size_t)b * 256 + lane * 4 + j) * KEYP + PAST + t] = f2bf(kn[j]); }
                if (lane < 16) {
                    const int pidx = smp ? 2048 + t : (row & 2047);
                    const float c = ROPE[pidx * 32 + lane], s = ROPE[pidx * 32 + 16 + lane];
                    const float o1 = x1 * c - x2 * s, o2 = x1 * s + x2 * c;
                    float* ko = out + (smp ? O_SKPE : O_PKPE) + (size_t)row * 32; ko[lane] = o1; ko[16 + lane] = o2;
                    if (!smp) *(unsigned*)(KPE + (size_t)row * 32 + 2 * lane) = cvtpk(o1, o2);
                    else *(unsigned*)(CC + ((size_t)b * KEYP + PAST + t) * DLAT + 256 + 2 * lane) = cvtpk(o1, o2);
                }
            }
            }
        }
    }
}

#ifndef MK_COOP
#define MK_COOP 1
#endif
extern "C" void kernel_launch(void* const* d_in, const int* in_sizes, int n_in, void* d_out, int out_size, void* d_ws, size_t ws_size, hipStream_t stream) {
    static int grid = 0;
    if (grid == 0) {
        if (n_in != 33 || ws_size < WS_END) { fprintf(stderr, "kernel_launch: unexpected n_in %d / ws %zu\n", n_in, ws_size); grid = -1; return; }
        int dev = 0, cus = 0, per_cu = 0;
        hipGetDevice(&dev); hipDeviceGetAttribute(&cus, hipDeviceAttributeMultiprocessorCount, dev);
        if (hipFuncSetAttribute((const void*)mk_fwd, hipFuncAttributeMaxDynamicSharedMemorySize, LDS_BYTES) != hipSuccess) { fprintf(stderr, "hipFuncSetAttribute failed\n"); grid = -1; return; }
        hipOccupancyMaxActiveBlocksPerMultiprocessor(&per_cu, (const void*)mk_fwd, 512, LDS_BYTES);
        (void)hipGetLastError();
        if (per_cu < 1) per_cu = 1;
        grid = cus;
    }
    if (grid < 0) return;
    if (hipMemsetAsync((char*)d_ws + WS_CTL, 0, CTL_BYTES, stream) != hipSuccess) { fprintf(stderr, "memset failed\n"); return; }
    Args a{};
    for (int i = 0; i < 33; ++i) a.in[i] = (const float*)d_in[i];
    a.out = (float*)d_out; a.ws = (char*)d_ws;
#if MK_COOP
    a.ph_lo = 0; a.ph_hi = NPHASE;
    void* args[] = {&a};
    hipError_t e = hipLaunchCooperativeKernel((const void*)mk_fwd, dim3(grid), dim3(512), args, LDS_BYTES, stream);
    if (e != hipSuccess) fprintf(stderr, "cooperative launch failed: %s (grid %d)\n", hipGetErrorString(e), grid);
#else
    for (int ph = 0; ph < NPHASE; ++ph) { a.ph_lo = ph; a.ph_hi = ph + 1; hipLaunchKernelGGL(mk_fwd, dim3(grid), dim3(512), LDS_BYTES, stream, a); }
#endif
}
```

```cpp
#include <hip/hip_runtime.h>
#include <hip/hip_cooperative_groups.h>
#include <cstdio>
#include <cstdint>
namespace cg = cooperative_groups;

#define DI __device__ __forceinline__
#define LAS __attribute__((address_space(3)))
typedef unsigned short bf16_t;
typedef short bf16x8 __attribute__((ext_vector_type(8)));
typedef short s16x4 __attribute__((ext_vector_type(4)));
typedef float f32x2 __attribute__((ext_vector_type(2)));
typedef float f32x4 __attribute__((ext_vector_type(4)));
typedef float f32x16 __attribute__((ext_vector_type(16)));
typedef unsigned u32x2 __attribute__((ext_vector_type(2)));
typedef unsigned u32x4 __attribute__((ext_vector_type(4)));
typedef __bf16 bf16x2_t __attribute__((ext_vector_type(2)));

constexpr int DM = 1024, MP = 16384, MS = 128, SEQ = 2048, NB = 8, DSEQ = 16, PAST = 4096;
constexpr int NZ = 5376;
constexpr int ZC_XA = 0, ZC_GA = 1024, ZC_GB = 2048, ZC_Q = 3072, ZC_K = 3584, ZC_V = 4096, ZC_ZR = 5120;
constexpr int IN_AB = 5136, DFF = 2816, NGU = 5632, INC = 672, NINC = 768, NQ = 1536;
constexpr int KEYS = 4112, KEYP = 4160, DLAT = 288;
constexpr int NSPLIT = 30, NKT = 65;
constexpr float EPS = 1e-6f;
constexpr int LDS_BYTES = 147456;

constexpr size_t O_YP = 0, O_YS = 16777216, O_PCONV = 16908288, O_PH = 16932864, O_PS = 16941056, O_PCKV = 17989632, O_PKPE = 22183936,
                 O_SCONV = 22708224, O_SH = 22732800, O_SS = 22740992, O_SCKV = 23789568, O_SKPE = 23822336;

constexpr size_t al(size_t x) { return (x + 255) & ~(size_t)255; }
constexpr size_t WS_WIN = 0;
constexpr size_t WS_WOUT = WS_WIN + (size_t)NZ * 1024 * 2;
constexpr size_t WS_WGU0 = WS_WOUT + (size_t)1024 * 2048 * 2;
constexpr size_t WS_WDN0 = WS_WGU0 + (size_t)NGU * 1024 * 2;
constexpr size_t WS_WAT = WS_WDN0 + (size_t)1024 * DFF * 2;
constexpr size_t WS_ROPE = WS_WAT + (size_t)2 * 8 * 128 * 128 * 2;
constexpr size_t WS_US = al(WS_ROPE + (size_t)2064 * 32 * 4);
constexpr size_t WS_ZS = WS_US + (size_t)MS * 1024 * 2;
constexpr size_t WS_GS = WS_ZS + (size_t)MS * NZ * 2;
constexpr size_t WS_CQS = WS_GS + (size_t)MS * DFF * 2;
constexpr size_t WS_CQNS = WS_CQS + (size_t)MS * NINC * 4;
constexpr size_t WS_QNS = WS_CQNS + (size_t)MS * 384 * 2;
constexpr size_t WS_QLAT = WS_QNS + (size_t)MS * 1024 * 2;
constexpr size_t WS_ML = WS_QLAT + (size_t)2048 * DLAT * 2;
constexpr size_t WS_OLAT = al(WS_ML + (size_t)8 * NSPLIT * 256 * 2 * 4);
constexpr size_t WS_OS = WS_OLAT + (size_t)2048 * 256 * 2;
constexpr size_t WS_U = al(WS_OS + (size_t)MS * 1024 * 2);
constexpr size_t WS_Z = WS_U + (size_t)MP * 1024 * 2;
constexpr size_t Z_BYTES = (size_t)MP * NZ * 2;
constexpr size_t WS_CTL = WS_Z + Z_BYTES;
constexpr size_t CTL_BYTES = 16384;
constexpr size_t WS_DEC = WS_CTL + CTL_BYTES;
constexpr size_t WS_TA = WS_DEC + (size_t)1024 * 128 * 4;
constexpr size_t WS_TU = WS_TA + (size_t)128 * 1024 * 4;
constexpr size_t WS_WINC = WS_TU + (size_t)128 * 1024 * 4;
constexpr size_t WS_WUQ = WS_WINC + (size_t)NINC * 1024 * 2;
constexpr size_t WS_WUKT = WS_WUQ + (size_t)NQ * 384 * 2;
constexpr size_t WS_WUVT = WS_WUKT + (size_t)1024 * 256 * 2;
constexpr size_t WS_WOC = WS_WUVT + (size_t)1024 * 256 * 2;
constexpr size_t WS_WUKP = WS_WOC + (size_t)1024 * 1024 * 2;
constexpr size_t WS_END = WS_WUKP + (size_t)256 * 1024 * 2;
constexpr size_t ZR_WGU1 = WS_Z;
constexpr size_t ZR_WDN1 = ZR_WGU1 + (size_t)NGU * 1024 * 2;
constexpr size_t ZR_WUK = ZR_WDN1 + (size_t)1024 * DFF * 2;
constexpr size_t ZR_CC = ZR_WUK;
constexpr size_t ZR_CCT = ZR_CC + (size_t)NB * KEYP * DLAT * 2;
constexpr size_t ZR_G = al(ZR_CCT + (size_t)NB * 256 * KEYP * 2);
constexpr size_t ZR_QN = ZR_G;
constexpr size_t ZR_VT = ZR_QN + (size_t)MP * NQ * 2;
constexpr size_t ZR_CQN = ZR_VT + (size_t)MP * 1024 * 2;
constexpr size_t ZR_CKVN = ZR_CQN + (size_t)MP * 384 * 2;
constexpr size_t ZR_KPE = ZR_CKVN + (size_t)MP * 256 * 2;
constexpr size_t ZR_END = ZR_KPE + (size_t)MP * 32 * 2;
static_assert(ZR_END <= WS_CTL && ZR_G + (size_t)MP * DFF * 2 <= WS_CTL && WS_END <= 268435456, "ws map");
static_assert((size_t)NB * NSPLIT * 256 * 256 * 2 <= WS_WAT, "OP fits the layer-0 weight area");
static_assert((size_t)MP * NINC * 4 <= (size_t)MP * NQ * 2, "CQ fits QN");
static_assert(ZR_CC + (size_t)MP * 1024 * 2 <= ZR_G, "Hb2 fits the latent cache image");

DI unsigned cvtpk(float lo, float hi) { f32x2 v = {lo, hi}; bf16x2_t b = __builtin_convertvector(v, bf16x2_t); return __builtin_bit_cast(unsigned, b); }
DI float bf2f(bf16_t b) { return __uint_as_float(((unsigned)b) << 16); }
DI bf16_t f2bf(float f) { return (bf16_t)(cvtpk(f, 0.f) & 0xffffu); }
DI float lo2f(unsigned u) { return __uint_as_float(u << 16); }
DI float hi2f(unsigned u) { return __uint_as_float(u & 0xffff0000u); }
DI float fexp(float x) { return __builtin_amdgcn_exp2f(x * 1.44269504089f); }
DI float frcp(float x) { return __builtin_amdgcn_rcpf(x); }
DI float fsigmoid(float x) { return frcp(1.0f + fexp(-x)); }
DI float fsilu(float x) { return x * fsigmoid(x); }
DI float fgelu(float x) { const float u = 0.7978845608f * (x + 0.044715f * x * x * x); const float t = 1.0f - 2.0f * frcp(1.0f + fexp(2.0f * u)); return 0.5f * x * (1.0f + t); }
DI float flog(float x) { return __builtin_amdgcn_logf(x) * 0.69314718056f; }
DI float flog1p_small(float e) { return e < 0.03f ? e * (1.0f - e * (0.5f - e * (0.33333333f - 0.25f * e))) : flog(1.0f + e); }
DI float fsoftplus(float x) { return fmaxf(x, 0.f) + flog1p_small(fexp(-fabsf(x))); }
DI float neg_expm1(float y) {
    return (y > -0.1f) ? -y * (1.0f + y * 0.5f * (1.0f + y * 0.33333333f * (1.0f + y * 0.25f * (1.0f + y * 0.2f)))) : 1.0f - fexp(y); }
DI float wave_sum(float v) {
#pragma unroll
    for (int o = 32; o >= 1; o >>= 1) v += __shfl_xor(v, o, 64);
    return v; }
DI int ltid() { int t = threadIdx.x; asm volatile("" : "+v"(t)); return t; }
DI int crow(int i, int h) { return (i & 3) + 8 * (i >> 2) + 4 * h; }
DI bf16x8 pack8(const f32x16& x, int s) {
    u32x4 p; p.x = cvtpk(x[8 * s], x[8 * s + 1]); p.y = cvtpk(x[8 * s + 2], x[8 * s + 3]); p.z = cvtpk(x[8 * s + 4], x[8 * s + 5]); p.w = cvtpk(x[8 * s + 6], x[8 * s + 7]);
    return __builtin_bit_cast(bf16x8, p); }
DI bf16x8 ld8(const void* p) { return *(const bf16x8*)p; }
DI bf16x8 cat44(const void* lo, const void* hi) { const s16x4 a = *(const s16x4*)lo, b = *(const s16x4*)hi; return __builtin_shufflevector(a, b, 0, 1, 2, 3, 4, 5, 6, 7); }
#define MFMA32(a, b, c) __builtin_amdgcn_mfma_f32_32x32x16_bf16((a), (b), (c), 0, 0, 0)
#define MFMA16(a, b, c) __builtin_amdgcn_mfma_f32_16x16x32_bf16((a), (b), (c), 0, 0, 0)
DI f32x16 zero16() { f32x16 z; for (int i = 0; i < 16; ++i) z[i] = 0.f; return z; }

namespace pg8 {
constexpr int BM = 256, BK = 64, HALF = 128, HTB = HALF * BK * 2, STAGE_BYTES = 8 * HTB, NXCD = 8, WGM = 8;
DI int lds_byte(int r, int c) { const int st = (r >> 4) * 2 + (c >> 5), rr = r & 15, cc = c & 31, ob = rr * 64 + cc * 2; return st * 1024 + (ob ^ (((ob >> 9) & 1) << 5)); }
DI void stage_rc(int b, int& R, int& C) { const int st = b / 1024, sb = b % 1024, swz = sb ^ (((sb >> 9) & 1) << 5); R = (st >> 1) * 16 + swz / 64; C = (st & 1) * 32 + (swz % 64) / 2; }
DI int perm32(int rho) { const int n = rho >> 4, i = rho & 15; return 8 * (i >> 2) + 4 * n + (i & 3); }
struct Unit { int pm, pn; };
struct Gemm { const bf16_t* A; const bf16_t* Bt; int M, N, K, lda; };
struct StaticOrder {
    int nM, nN, nwg, G, c;
    DI void init(int M, int N, int G_, int c_) { nM = M / BM; nN = N / BM; nwg = nM * nN; G = G_; c = c_; }
    DI bool next(int i, Unit& u) const {
        const long L = (long)i * G + c; if (L >= nwg) return false;
        int wgid = (int)L; { const int q = nwg / NXCD, r = nwg % NXCD, xcd = wgid % NXCD, off = wgid / NXCD; wgid = (xcd < r ? xcd * (q + 1) : r * (q + 1) + (xcd - r) * q) + off; }
        const int nig = WGM * nN, gid = wgid / nig, fm = gid * WGM, gsz = (nM - fm) < WGM ? (nM - fm) : WGM;
        u.pm = fm + ((wgid % nig) % gsz); u.pn = (wgid % nig) / gsz; return true;
    }
};
template <class F> struct Epi {
    F f;
    DI void operator()(const f32x4 (&acc)[2][2][4][2], const Unit& u, int wr, int wc, int fr, int fq) const {
        int frl = fr, fql = fq; asm volatile("" : "+v"(frl), "+v"(fql));
        const int row0 = u.pm * BM + wr * 64 + frl, col0 = u.pn * BM + wc * 32 + 8 * fql;
#pragma unroll
        for (int ai = 0; ai < 2; ++ai)
#pragma unroll
            for (int m = 0; m < 4; ++m)
#pragma unroll
                for (int bj = 0; bj < 2; ++bj) f(row0 + ai * HALF + m * 16, col0 + bj * HALF, acc[ai][bj][m][0], acc[ai][bj][m][1]);
    }
};
template <class EpiT>
DI void gemm_phase(LAS unsigned char* lds, const Gemm g, const StaticOrder& S, const EpiT& E) {
    const int tid = ltid(), wid = __builtin_amdgcn_readfirstlane(tid >> 6), lane = tid & 63, wr = wid >> 2, wc = wid & 3, fr = lane & 15, fq = lane >> 4;
    int K_ = g.K, lda_ = g.lda; asm volatile("" : "+s"(K_), "+s"(lda_));
    const int K = K_, nt = K / BK, lda = lda_;
    unsigned voffA[2], voffB[2];
#pragma unroll
    for (int i = 0; i < 2; ++i) { int R, C; stage_rc(tid * 16 + i * 8192, R, C); const int Rb = (R & ~31) + perm32(R & 31);
        voffA[i] = (unsigned)(R * lda + C) * 2u; voffB[i] = (unsigned)(Rb * K + C) * 2u; }
    const size_t kstep = (size_t)(BK * 2);
    const size_t hstepA = (size_t)HALF * lda * 2, hstepB = (size_t)HALF * K * 2;
    const size_t tstepA = 2 * hstepA, tstepB = 2 * hstepB;
    const unsigned ldsw = (unsigned)wid * 1024u;
    const int aoff = lds_byte(wr * 64 + fr, fq * 8), boff = lds_byte(wc * 32 + fr, fq * 8);
#define PG8_SA(b, h) (((b) * 2 + (h)) * HTB)
#define PG8_SB(b, h) ((4 + (b) * 2 + (h)) * HTB)
#define PG8_STAGE(bufoff, gbase, voff) do { _Pragma("unroll") for (int _i = 0; _i < 2; ++_i) \
        __builtin_amdgcn_global_load_lds((const unsigned*)((const char*)(gbase) + (voff)[_i]), (LAS unsigned*)(lds + (bufoff) + ldsw + _i * 8192), 16, 0, 0); } while (0)
#define PG8_LDA(dst, b, h) do { _Pragma("unroll") for (int m = 0; m < 4; ++m) _Pragma("unroll") for (int k = 0; k < 2; ++k) dst[m][k] = *(const LAS bf16x8*)(lds + PG8_SA(b, h) + aoff + m * 2048 + k * 1024); } while (0)
#define PG8_LDB(dst, b, h) do { _Pragma("unroll") for (int n = 0; n < 2; ++n) _Pragma("unroll") for (int k = 0; k < 2; ++k) dst[n][k] = *(const LAS bf16x8*)(lds + PG8_SB(b, h) + boff + n * 2048 + k * 1024); } while (0)
#define PG8_MMA(ai, bj, At, Bt) do { __builtin_amdgcn_s_setprio(1); _Pragma("unroll") for (int m = 0; m < 4; ++m) _Pragma("unroll") for (int n = 0; n < 2; ++n) _Pragma("unroll") for (int k = 0; k < 2; ++k) \
        acc[ai][bj][m][n] = __builtin_amdgcn_mfma_f32_16x16x32_bf16(Bt[n][k], At[m][k], acc[ai][bj][m][n], 0, 0, 0); __builtin_amdgcn_s_setprio(0); } while (0)
#define PG8_WAIT_V(n) asm volatile("s_waitcnt vmcnt(" #n ")" ::: "memory")
#define PG8_WAIT_L(n) asm volatile("s_waitcnt lgkmcnt(" #n ")" ::: "memory")
#define PG8_BAR __builtin_amdgcn_s_barrier()
#define PG8_SCHED __builtin_amdgcn_sched_barrier(0)
    Unit cur, nxt; int ui = 0;
    if (!S.next(0, cur)) return;
    f32x4 acc[2][2][4][2];
#pragma unroll
    for (int a = 0; a < 2; ++a)
#pragma unroll
        for (int b = 0; b < 2; ++b)
#pragma unroll
            for (int m = 0; m < 4; ++m)
#pragma unroll
                for (int n = 0; n < 2; ++n) acc[a][b][m][n] = (f32x4){0.f, 0.f, 0.f, 0.f};
    bf16x8 At[4][2], B0[2][2], B1[2][2];
    const char* cA = (const char*)g.A + (size_t)cur.pm * tstepA; const char* cB = (const char*)g.Bt + (size_t)cur.pn * tstepB;
    PG8_STAGE(PG8_SB(0, 0), cB, voffB); PG8_STAGE(PG8_SA(0, 0), cA, voffA); PG8_STAGE(PG8_SB(0, 1), cB + hstepB, voffB); PG8_STAGE(PG8_SA(0, 1), cA + hstepA, voffA);
    if (wr == 1) PG8_BAR;
    PG8_WAIT_V(4); PG8_BAR;
    PG8_STAGE(PG8_SB(1, 0), cB + kstep, voffB); PG8_STAGE(PG8_SA(1, 0), cA + kstep, voffA); PG8_STAGE(PG8_SB(1, 1), cB + hstepB + kstep, voffB);
    PG8_WAIT_V(6); PG8_BAR;
    for (;;) {
        const bool has_next = S.next(ui + 1, nxt);
        const char* nA = has_next ? (const char*)g.A + (size_t)nxt.pm * tstepA : cA; const char* nB = has_next ? (const char*)g.Bt + (size_t)nxt.pn * tstepB : cB;
        for (int t = 0; t < nt; t += 2) {
            const bool last = (t == nt - 2);
            const char* a1 = cA + (size_t)(t + 1) * kstep;
            const char* a2 = last ? nA : cA + (size_t)(t + 2) * kstep; const char* b2 = last ? nB : cB + (size_t)(t + 2) * kstep;
            const char* a3 = a2 + kstep; const char* b3 = b2 + kstep;
            PG8_LDB(B0, 0, 0); PG8_SCHED; PG8_LDA(At, 0, 0); PG8_STAGE(PG8_SA(1, 1), a1 + hstepA, voffA);
            PG8_WAIT_L(8); PG8_BAR; PG8_WAIT_L(0); PG8_MMA(0, 0, At, B0); PG8_BAR; PG8_SCHED;
            PG8_LDB(B1, 0, 1); PG8_STAGE(PG8_SB(0, 0), b2, voffB);
            PG8_BAR; PG8_WAIT_L(0); PG8_MMA(0, 1, At, B1); PG8_BAR;
            PG8_LDA(At, 0, 1); PG8_STAGE(PG8_SA(0, 0), a2, voffA);
            PG8_BAR; PG8_WAIT_L(0); PG8_MMA(1, 0, At, B0); PG8_BAR; PG8_SCHED;
            PG8_STAGE(PG8_SB(0, 1), b2 + hstepB, voffB);
            PG8_WAIT_V(6); PG8_BAR; PG8_MMA(1, 1, At, B1); PG8_BAR;
            PG8_LDB(B0, 1, 0); PG8_SCHED; PG8_LDA(At, 1, 0); PG8_STAGE(PG8_SA(0, 1), a2 + hstepA, voffA);
            PG8_WAIT_L(8); PG8_BAR; PG8_WAIT_L(0); PG8_MMA(0, 0, At, B0); PG8_BAR; PG8_SCHED;
            PG8_LDB(B1, 1, 1); PG8_STAGE(PG8_SB(1, 0), b3, voffB);
            PG8_BAR; PG8_WAIT_L(0); PG8_MMA(0, 1, At, B1); PG8_BAR;
            PG8_LDA(At, 1, 1); PG8_STAGE(PG8_SA(1, 0), a3, voffA);
            PG8_BAR; PG8_WAIT_L(0); PG8_MMA(1, 0, At, B0); PG8_BAR; PG8_SCHED;
            PG8_STAGE(PG8_SB(1, 1), b3 + hstepB, voffB);
            PG8_WAIT_V(6); PG8_BAR; PG8_MMA(1, 1, At, B1); PG8_BAR;
        }
        E(acc, cur, wr, wc, fr, fq);
        if (!has_next) break;
#pragma unroll
        for (int a = 0; a < 2; ++a)
#pragma unroll
            for (int b = 0; b < 2; ++b)
#pragma unroll
                for (int m = 0; m < 4; ++m)
#pragma unroll
                    for (int n = 0; n < 2; ++n) acc[a][b][m][n] = (f32x4){0.f, 0.f, 0.f, 0.f};
        cur = nxt; cA = nA; cB = nB; ++ui;
    }
    PG8_WAIT_V(0);
    if (wr == 0) PG8_BAR;
    PG8_BAR;
#undef PG8_SA
#undef PG8_SB
#undef PG8_STAGE
#undef PG8_LDA
#undef PG8_LDB
#undef PG8_MMA
#undef PG8_WAIT_V
#undef PG8_WAIT_L
#undef PG8_BAR
#undef PG8_SCHED
}
}

template <class F>
DI void big_gemm(char* smem, const bf16_t* A, int lda, const bf16_t* Bt, int M, int N, int K, int crot, const F& f) {
    pg8::Gemm g{A, Bt, M, N, K, lda};
    pg8::StaticOrder S; S.init(M, N, (int)gridDim.x, (int)((blockIdx.x + crot) % gridDim.x));
    pg8::Epi<F> E{f};
    pg8::gemm_phase(( LAS unsigned char*)smem, g, S, E);
}

template <class F>
DI void small_gemm_unit(char* smem, const bf16_t* A, int lda, const bf16_t* Wt, int ldw, int K, int n0, const F& f) {
    const int tid = ltid(), wid = tid >> 6, lane = tid & 63, r16 = lane & 15, quad = lane >> 4;
    f32x4 acc[8];
#pragma unroll
    for (int i = 0; i < 8; ++i) acc[i] = (f32x4){0.f, 0.f, 0.f, 0.f};
    {
        const int nks = K / 32;
        bf16x8 bcur, acur[8];
        if (wid < nks) { const int k0 = wid * 32 + quad * 8; bcur = ld8(Wt + (size_t)(n0 + r16) * ldw + k0);
#pragma unroll
            for (int rb = 0; rb < 8; ++rb) acur[rb] = ld8(A + (size_t)(rb * 16 + r16) * lda + k0); }
        for (int ks = wid; ks < nks; ks += 8) {
            bf16x8 bnx = bcur, anx[8];
#pragma unroll
            for (int rb = 0; rb < 8; ++rb) anx[rb] = acur[rb];
            if (ks + 8 < nks) { const int k1 = (ks + 8) * 32 + quad * 8; bnx = ld8(Wt + (size_t)(n0 + r16) * ldw + k1);
#pragma unroll
                for (int rb = 0; rb < 8; ++rb) anx[rb] = ld8(A + (size_t)(rb * 16 + r16) * lda + k1); }
#pragma unroll
            for (int rb = 0; rb < 8; ++rb) acc[rb] = MFMA16(acur[rb], bcur, acc[rb]);
            bcur = bnx;
#pragma unroll
            for (int rb = 0; rb < 8; ++rb) acur[rb] = anx[rb];
        }
    }
    float* P = (float*)smem;
#pragma unroll
    for (int rb = 0; rb < 8; ++rb)
#pragma unroll
        for (int j = 0; j < 4; ++j) P[(wid * 128 + rb * 16 + quad * 4 + j) * 16 + r16] = acc[rb][j];
    __syncthreads();
    if (tid < 256) {
        const int row = tid >> 1, c8 = (tid & 1) * 8;
        f32x4 s0 = (f32x4){0.f, 0.f, 0.f, 0.f}, s1 = s0;
#pragma unroll
        for (int w = 0; w < 8; ++w) { s0 += *(const f32x4*)&P[(w * 128 + row) * 16 + c8]; s1 += *(const f32x4*)&P[(w * 128 + row) * 16 + c8 + 4]; }
        f(row, n0 + c8, s0, s1);
    }
    __syncthreads();
}
template <class F>
DI void small_gemm_unit_h(char* smem, const bf16_t* A, int lda, const bf16_t* Wt, int ldw, int K, int n0, int row0, const F& f) {
    const int tid = ltid(), wid = tid >> 6, lane = tid & 63, r16 = lane & 15, quad = lane >> 4;
    f32x4 acc[4];
#pragma unroll
    for (int i = 0; i < 4; ++i) acc[i] = (f32x4){0.f, 0.f, 0.f, 0.f};
    {
        const int nks = K / 32;
        bf16x8 bcur, acur[4];
        if (wid < nks) { const int k0 = wid * 32 + quad * 8; bcur = ld8(Wt + (size_t)(n0 + r16) * ldw + k0);
#pragma unroll
            for (int rb = 0; rb < 4; ++rb) acur[rb] = ld8(A + (size_t)(row0 + rb * 16 + r16) * lda + k0); }
        for (int ks = wid; ks < nks; ks += 8) {
            bf16x8 bnx = bcur, anx[4];
#pragma unroll
            for (int rb = 0; rb < 4; ++rb) anx[rb] = acur[rb];
            if (ks + 8 < nks) { const int k1 = (ks + 8) * 32 + quad * 8; bnx = ld8(Wt + (size_t)(n0 + r16) * ldw + k1);
#pragma unroll
                for (int rb = 0; rb < 4; ++rb) anx[rb] = ld8(A + (size_t)(row0 + rb * 16 + r16) * lda + k1); }
#pragma unroll
            for (int rb = 0; rb < 4; ++rb) acc[rb] = MFMA16(acur[rb], bcur, acc[rb]);
            bcur = bnx;
#pragma unroll
            for (int rb = 0; rb < 4; ++rb) acur[rb] = anx[rb];
        }
    }
    float* P = (float*)smem;
#pragma unroll
    for (int rb = 0; rb < 4; ++rb)
#pragma unroll
        for (int j = 0; j < 4; ++j) P[(wid * 64 + rb * 16 + quad * 4 + j) * 16 + r16] = acc[rb][j];
    __syncthreads();
    if (tid < 128) {
        const int row = tid >> 1, c8 = (tid & 1) * 8;
        f32x4 s0 = (f32x4){0.f, 0.f, 0.f, 0.f}, s1 = s0;
#pragma unroll
        for (int w = 0; w < 8; ++w) { s0 += *(const f32x4*)&P[(w * 64 + row) * 16 + c8]; s1 += *(const f32x4*)&P[(w * 64 + row) * 16 + c8 + 4]; }
        f(row0 + row, n0 + c8, s0, s1);
    }
    __syncthreads();
}
template <class F>
DI void small_gemm_h(char* smem, const bf16_t* A, int lda, const bf16_t* Wt, int ldw, int K, int N, int bstart, const F& f) {
    const int G = gridDim.x; const int me = ((int)blockIdx.x - bstart % G + G) % G;
    for (int u = me; u < 2 * (N / 16); u += G) small_gemm_unit_h(smem, A, lda, Wt, ldw, K, (u >> 1) * 16, (u & 1) * 64, f);
}
template <class F>
DI void small_gemm_unit2(char* smem, const bf16_t* A, int lda, const bf16_t* Wt, int ldw, int K, int n0, const F& f) {
    const int tid = ltid(), wid = tid >> 6, lane = tid & 63, r16 = lane & 15, quad = lane >> 4;
    f32x4 acc[2][8];
#pragma unroll
    for (int c = 0; c < 2; ++c)
#pragma unroll
        for (int i = 0; i < 8; ++i) acc[c][i] = (f32x4){0.f, 0.f, 0.f, 0.f};
    {
        const int nks = K / 32;
        bf16x8 b0c, b1c, acur[8];
        if (wid < nks) { const int k0 = wid * 32 + quad * 8; b0c = ld8(Wt + (size_t)(n0 + r16) * ldw + k0); b1c = ld8(Wt + (size_t)(n0 + 16 + r16) * ldw + k0);
#pragma unroll
            for (int rb = 0; rb < 8; ++rb) acur[rb] = ld8(A + (size_t)(rb * 16 + r16) * lda + k0); }
        for (int ks = wid; ks < nks; ks += 8) {
            bf16x8 b0n = b0c, b1n = b1c, anx[8];
#pragma unroll
            for (int rb = 0; rb < 8; ++rb) anx[rb] = acur[rb];
            if (ks + 8 < nks) { const int k1 = (ks + 8) * 32 + quad * 8; b0n = ld8(Wt + (size_t)(n0 + r16) * ldw + k1); b1n = ld8(Wt + (size_t)(n0 + 16 + r16) * ldw + k1);
#pragma unroll
                for (int rb = 0; rb < 8; ++rb) anx[rb] = ld8(A + (size_t)(rb * 16 + r16) * lda + k1); }
#pragma unroll
            for (int rb = 0; rb < 8; ++rb) { acc[0][rb] = MFMA16(acur[rb], b0c, acc[0][rb]); acc[1][rb] = MFMA16(acur[rb], b1c, acc[1][rb]); }
            b0c = b0n; b1c = b1n;
#pragma unroll
            for (int rb = 0; rb < 8; ++rb) acur[rb] = anx[rb];
        }
    }
    float* P = (float*)smem;
#pragma unroll
    for (int c = 0; c < 2; ++c)
#pragma unroll
        for (int rb = 0; rb < 8; ++rb)
#pragma unroll
            for (int j = 0; j < 4; ++j) P[(wid * 128 + rb * 16 + quad * 4 + j) * 32 + c * 16 + r16] = acc[c][rb][j];
    __syncthreads();
    {
        const int row = tid >> 2, c8 = (tid & 3) * 8;
        f32x4 s0 = (f32x4){0.f, 0.f, 0.f, 0.f}, s1 = s0;
#pragma unroll
        for (int w = 0; w < 8; ++w) { s0 += *(const f32x4*)&P[(w * 128 + row) * 32 + c8]; s1 += *(const f32x4*)&P[(w * 128 + row) * 32 + c8 + 4]; }
        f(row, n0 + c8, s0, s1);
    }
    __syncthreads();
}
template <class F>
DI void small_gemm2(char* smem, const bf16_t* A, int lda, const bf16_t* Wt, int ldw, int K, int N, int bstart, const F& f) {
    const int G = gridDim.x; const int me = ((int)blockIdx.x - bstart % G + G) % G;
    for (int u = me; u < N / 32; u += G) small_gemm_unit2(smem, A, lda, Wt, ldw, K, u * 32, f);
}
template <class F>
DI void small_gemm(char* smem, const bf16_t* A, int lda, const bf16_t* Wt, int ldw, int K, int N, int bstart, const F& f) {
    const int G = gridDim.x; const int me = ((int)blockIdx.x - bstart % G + G) % G;
    for (int u = me; u < N / 16; u += G) small_gemm_unit(smem, A, lda, Wt, ldw, K, u * 16, f);
}

struct FZ {
    bf16_t* Z;
    DI void operator()(int row, int col, f32x4 v0, f32x4 v1) const {
        if (col >= ZC_GA && col < ZC_GB) { for (int j = 0; j < 4; ++j) { v0[j] = fgelu(v0[j]); v1[j] = fgelu(v1[j]); } }
        else if (col >= ZC_GB && col < ZC_Q) { for (int j = 0; j < 4; ++j) { v0[j] = fsilu(v0[j]); v1[j] = fsilu(v1[j]); } }
        u32x4 w; w.x = cvtpk(v0[0], v0[1]); w.y = cvtpk(v0[2], v0[3]); w.z = cvtpk(v1[0], v1[1]); w.w = cvtpk(v1[2], v1[3]);
        *(u32x4*)(Z + (size_t)row * NZ + col) = w;
    }
};
struct FB {
    bf16_t* O; int ldc;
    DI void operator()(int row, int col, f32x4 v0, f32x4 v1) const {
        u32x4 w; w.x = cvtpk(v0[0], v0[1]); w.y = cvtpk(v0[2], v0[3]); w.z = cvtpk(v1[0], v1[1]); w.w = cvtpk(v1[2], v1[3]);
        *(u32x4*)(O + (size_t)row * ldc + col) = w;
    }
};
struct FSw {
    bf16_t* G;
    DI void operator()(int row, int col, f32x4 v0, f32x4 v1) const {
        u32x2 w; w.x = cvtpk(fsilu(v0[0]) * v1[0], fsilu(v0[1]) * v1[1]); w.y = cvtpk(fsilu(v0[2]) * v1[2], fsilu(v0[3]) * v1[3]);
        *(u32x2*)(G + (size_t)row * DFF + (col >> 1)) = w;
    }
};
struct FF32 {
    float* C; int ldc;
    DI void operator()(int row, int col, f32x4 v0, f32x4 v1) const { *(f32x4*)(C + (size_t)row * ldc + col) = v0; *(f32x4*)(C + (size_t)row * ldc + col + 4) = v1; }
};
constexpr float QSCALE = 0.10206207261596575f * 1.4426950408889634f;
struct FQ {
    const float* rope; int sample; bf16_t* QN; bf16_t* QLAT;
    DI void operator()(int row, int col, f32x4 v0, f32x4 v1) const {
        if (col >= 1024) {
            const int m = col - 1024, i0 = (m & 31) >> 1;
            const int pidx = sample ? (2048 + (row & 15)) : (row & 2047);
            const f32x4 c = *(const f32x4*)(rope + pidx * 32 + i0), s = *(const f32x4*)(rope + pidx * 32 + 16 + i0);
            f32x4 a, b;
            a[0] = v0[0] * c[0] - v0[1] * s[0]; a[1] = v0[0] * s[0] + v0[1] * c[0]; a[2] = v0[2] * c[1] - v0[3] * s[1]; a[3] = v0[2] * s[1] + v0[3] * c[1];
            b[0] = v1[0] * c[2] - v1[1] * s[2]; b[1] = v1[0] * s[2] + v1[1] * c[2]; b[2] = v1[2] * c[3] - v1[3] * s[3]; b[3] = v1[2] * s[3] + v1[3] * c[3];
            v0 = a; v1 = b;
        }
        u32x4 w; w.x = cvtpk(v0[0] * QSCALE, v0[1] * QSCALE); w.y = cvtpk(v0[2] * QSCALE, v0[3] * QSCALE); w.z = cvtpk(v1[0] * QSCALE, v1[1] * QSCALE); w.w = cvtpk(v1[2] * QSCALE, v1[3] * QSCALE);
        if (!sample) *(u32x4*)(QN + (size_t)row * NQ + col) = w;
        else if (col < 1024) *(u32x4*)(QN + (size_t)row * 1024 + col) = w;
        else { const int m = col - 1024, h = m >> 5; *(u32x4*)(QLAT + ((size_t)row * 16 + h) * DLAT + 256 + (m & 31)) = w; }
    }
};
struct FQL {
    bf16_t* QLAT; int h;
    DI void operator()(int row, int col, f32x4 v0, f32x4 v1) const {
        u32x4 w; w.x = cvtpk(v0[0], v0[1]); w.y = cvtpk(v0[2], v0[3]); w.z = cvtpk(v1[0], v1[1]); w.w = cvtpk(v1[2], v1[3]);
        *(u32x4*)(QLAT + ((size_t)row * 16 + h) * DLAT + col) = w;
    }
};
struct FOS {
    bf16_t* O; int h;
    DI void operator()(int row, int col, f32x4 v0, f32x4 v1) const {
        u32x4 w; w.x = cvtpk(v0[0], v0[1]); w.y = cvtpk(v0[2], v0[3]); w.z = cvtpk(v1[0], v1[1]); w.w = cvtpk(v1[2], v1[3]);
        *(u32x4*)(O + (size_t)row * 1024 + h * 64 + col) = w;
    }
};

template <class SrcF>
DI void transpose_job(char* smem, int K, int Nout, bf16_t* WT, int ldwt, const SrcF& src, int& tile_base, int nw = -1, int me = 0) {
    float* T = (float*)smem;
    const int nkt = K / 64, ntiles = nkt * (Nout / 256), G = nw > 0 ? nw : (int)gridDim.x, tid = ltid();
    const int first = nw > 0 ? (me < 0 ? ntiles : (me - tile_base % G + G) % G) : ((int)blockIdx.x - tile_base % G + G) % G;
    float v[32];
    auto tload = [&](int t) { const int kt = t % nkt, nt = t / nkt; const int n = nt * 256 + (tid & 255), kb = kt * 64 + (tid >> 8);
#pragma unroll
        for (int j = 0; j < 32; ++j) v[j] = src(n, kb + 2 * j); };
    if (first < ntiles) tload(first);
    for (int t = first; t < ntiles; t += G) {
        const int kt = t % nkt, nt = t / nkt;
#pragma unroll
        for (int j = 0; j < 32; ++j) T[((tid >> 8) + 2 * j) * 257 + (tid & 255)] = v[j];
        if (t + G < ntiles) tload(t + G);
        __syncthreads();
#pragma unroll
        for (int i = 0; i < 4; ++i) {
            const int p = tid + 512 * i, nn = p >> 3, kp = (p & 7) * 8;
            u32x4 w;
            w.x = cvtpk(T[(kp + 0) * 257 + nn], T[(kp + 1) * 257 + nn]); w.y = cvtpk(T[(kp + 2) * 257 + nn], T[(kp + 3) * 257 + nn]);
            w.z = cvtpk(T[(kp + 4) * 257 + nn], T[(kp + 5) * 257 + nn]); w.w = cvtpk(T[(kp + 6) * 257 + nn], T[(kp + 7) * 257 + nn]);
            *(u32x4*)(WT + (size_t)(nt * 256 + nn) * ldwt + kt * 64 + kp) = w;
        }
        __syncthreads();
    }
    tile_base += ntiles;
}
struct SrcPlain { const float* W; int N; DI float operator()(int n, int k) const { return W[(size_t)k * N + n]; } };
struct SrcWin { const float* W; DI float operator()(int n, int k) const {
    int oc;
    if (n < 2048) oc = n; else if (n < 3072) oc = n - 2048 + 4096; else if (n < 3584) oc = n - 3072 + 2048; else if (n < 4096) oc = n - 3584 + 2560;
    else if (n < 5120) oc = n - 4096 + 3072; else if (n < IN_AB) oc = n; else oc = -1;
    return oc < 0 ? 0.f : W[(size_t)k * IN_AB + oc]; } };
struct SrcGU { const float* Wg; const float* Wu; DI float operator()(int n, int k) const { const int i = n >> 3, j = n & 7; return j < 4 ? Wg[(size_t)k * DFF + 4 * i + j] : Wu[(size_t)k * DFF + 4 * i + j - 4]; } };
struct SrcInc { const float* W; DI float operator()(int n, int k) const { return n < INC ? W[(size_t)k * INC + n] : 0.f; } };
struct SrcUq { const float* W; DI float operator()(int n, int k) const {
    int oc; if (n < 1024) { oc = (n >> 6) * 96 + (n & 63); } else { const int m = n - 1024, h = m >> 5, i = (m & 31) >> 1, p = m & 1; oc = h * 96 + 64 + p * 16 + i; }
    return W[(size_t)k * NQ + oc]; } };

DI void rms_rows_to_bf16(const float* X, const float* g, bf16_t* U, int nrows) {
    const int tid_ = ltid(); const int lane = tid_ & 63, gw = blockIdx.x * 8 + (tid_ >> 6), GW = gridDim.x * 8;
    f32x4 nx[4], gg4[4];
#pragma unroll
    for (int i = 0; i < 4; ++i) gg4[i] = *(const f32x4*)(g + i * 256 + lane * 4);
    if (gw < nrows) {
#pragma unroll
        for (int i = 0; i < 4; ++i) nx[i] = *(const f32x4*)(X + (size_t)gw * DM + i * 256 + lane * 4); }
    for (int r = gw; r < nrows; r += GW) {
        f32x4 a[4]; float ss = 0.f;
#pragma unroll
        for (int i = 0; i < 4; ++i) { a[i] = nx[i]; ss += a[i][0] * a[i][0] + a[i][1] * a[i][1] + a[i][2] * a[i][2] + a[i][3] * a[i][3]; }
        if (r + GW < nrows) {
#pragma unroll
            for (int i = 0; i < 4; ++i) nx[i] = *(const f32x4*)(X + (size_t)(r + GW) * DM + i * 256 + lane * 4); }
        ss = wave_sum(ss); const float rs = __builtin_amdgcn_rsqf(ss * (1.0f / DM) + EPS);
#pragma unroll
        for (int i = 0; i < 4; ++i) { const f32x4 gg = gg4[i];
            u32x2 w; w.x = cvtpk(a[i][0] * rs * gg[0], a[i][1] * rs * gg[1]); w.y = cvtpk(a[i][2] * rs * gg[2], a[i][3] * rs * gg[3]);
            *(u32x2*)(U + (size_t)r * DM + i * 256 + lane * 4) = w; }
    }
}
template <int HI, int HO>
DI void norm_rows(const bf16_t* Y, const void* Hin_, void* Hout_, const float* gpost, const float* gpre, bf16_t* U, int nrows, int dry = 0) {
    const int tid_ = ltid(); const int lane = tid_ & 63, gw = blockIdx.x * 8 + (tid_ >> 6), GW = gridDim.x * 8;
    u32x4 ry[2], rh[4];
    auto rload = [&](int r) {
#pragma unroll
        for (int i = 0; i < 2; ++i) { const int c = i * 512 + lane * 8;
            ry[i] = *(const u32x4*)(Y + (size_t)r * DM + c);
            if (HI == 0) { rh[2 * i] = *(const u32x4*)((const float*)Hin_ + (size_t)r * DM + c); rh[2 * i + 1] = *(const u32x4*)((const float*)Hin_ + (size_t)r * DM + c + 4); }
            else rh[2 * i] = *(const u32x4*)((const bf16_t*)Hin_ + (size_t)r * DM + c); }
    };
    f32x4 gp[4], gq[4];
#pragma unroll
    for (int i = 0; i < 2; ++i) { const int c = i * 512 + lane * 8; gp[2 * i] = *(const f32x4*)(gpost + c); gp[2 * i + 1] = *(const f32x4*)(gpost + c + 4);
        gq[2 * i] = gpre ? *(const f32x4*)(gpre + c) : (f32x4){0.f, 0.f, 0.f, 0.f}; gq[2 * i + 1] = gpre ? *(const f32x4*)(gpre + c + 4) : (f32x4){0.f, 0.f, 0.f, 0.f}; }
    if (gw < nrows) rload(gw);
    for (int r = gw; r < nrows; r += GW) {
        float y[16], hin[16]; float ss = 0.f;
#pragma unroll
        for (int i = 0; i < 2; ++i) { const u32x4 w = ry[i];
            y[i * 8 + 0] = lo2f(w.x); y[i * 8 + 1] = hi2f(w.x); y[i * 8 + 2] = lo2f(w.y); y[i * 8 + 3] = hi2f(w.y); y[i * 8 + 4] = lo2f(w.z); y[i * 8 + 5] = hi2f(w.z); y[i * 8 + 6] = lo2f(w.w); y[i * 8 + 7] = hi2f(w.w);
            if (HI == 0) { const f32x4 a0 = __builtin_bit_cast(f32x4, rh[2 * i]), a1 = __builtin_bit_cast(f32x4, rh[2 * i + 1]);
#pragma unroll
                for (int j = 0; j < 4; ++j) { hin[i * 8 + j] = a0[j]; hin[i * 8 + 4 + j] = a1[j]; } }
            else { const u32x4 v = rh[2 * i];
                hin[i * 8 + 0] = lo2f(v.x); hin[i * 8 + 1] = hi2f(v.x); hin[i * 8 + 2] = lo2f(v.y); hin[i * 8 + 3] = hi2f(v.y); hin[i * 8 + 4] = lo2f(v.z); hin[i * 8 + 5] = hi2f(v.z); hin[i * 8 + 6] = lo2f(v.w); hin[i * 8 + 7] = hi2f(v.w); }
        }
        if (r + GW < nrows) rload(r + GW);
#pragma unroll
        for (int i = 0; i < 16; ++i) ss += y[i] * y[i];
        ss = wave_sum(ss); const float rs = __builtin_amdgcn_rsqf(ss * (1.0f / DM) + EPS);
        float h[16]; float s2 = 0.f;
#pragma unroll
        for (int i = 0; i < 2; ++i) {
            const int c = i * 512 + lane * 8; const f32x4 g0 = gp[2 * i], g1 = gp[2 * i + 1];
#pragma unroll
            for (int j = 0; j < 4; ++j) { h[i * 8 + j] = hin[i * 8 + j] + y[i * 8 + j] * rs * g0[j]; h[i * 8 + 4 + j] = hin[i * 8 + 4 + j] + y[i * 8 + 4 + j] * rs * g1[j]; }
            if (HO == 1) {
                u32x4 w; w.x = cvtpk(h[i * 8 + 0], h[i * 8 + 1]); w.y = cvtpk(h[i * 8 + 2], h[i * 8 + 3]); w.z = cvtpk(h[i * 8 + 4], h[i * 8 + 5]); w.w = cvtpk(h[i * 8 + 6], h[i * 8 + 7]);
                if (!dry) *(u32x4*)((bf16_t*)Hout_ + (size_t)r * DM + c) = w;
                h[i * 8 + 0] = lo2f(w.x); h[i * 8 + 1] = hi2f(w.x); h[i * 8 + 2] = lo2f(w.y); h[i * 8 + 3] = hi2f(w.y); h[i * 8 + 4] = lo2f(w.z); h[i * 8 + 5] = hi2f(w.z); h[i * 8 + 6] = lo2f(w.w); h[i * 8 + 7] = hi2f(w.w);
            } else if (!dry) {
                *(f32x4*)((float*)Hout_ + (size_t)r * DM + c) = (f32x4){h[i * 8 + 0], h[i * 8 + 1], h[i * 8 + 2], h[i * 8 + 3]};
                *(f32x4*)((float*)Hout_ + (size_t)r * DM + c + 4) = (f32x4){h[i * 8 + 4], h[i * 8 + 5], h[i * 8 + 6], h[i * 8 + 7]};
            }
        }
        if (gpre) {
#pragma unroll
            for (int i = 0; i < 16; ++i) s2 += h[i] * h[i];
            s2 = wave_sum(s2); const float r2 = __builtin_amdgcn_rsqf(s2 * (1.0f / DM) + EPS);
#pragma unroll
            for (int i = 0; i < 2; ++i) { const int c = i * 512 + lane * 8; const f32x4 g0 = gq[2 * i], g1 = gq[2 * i + 1];
                u32x4 w; w.x = cvtpk(h[i * 8 + 0] * r2 * g0[0], h[i * 8 + 1] * r2 * g0[1]); w.y = cvtpk(h[i * 8 + 2] * r2 * g0[2], h[i * 8 + 3] * r2 * g0[3]);
                w.z = cvtpk(h[i * 8 + 4] * r2 * g1[0], h[i * 8 + 5] * r2 * g1[1]); w.w = cvtpk(h[i * 8 + 6] * r2 * g1[2], h[i * 8 + 7] * r2 * g1[3]);
                if (!dry) *(u32x4*)(U + (size_t)r * DM + c) = w; }
        }
    }
}

DI void lru_unit(char* smem, bf16_t* Zb, int L, int n, int half, const float* convw, const float* convb, const bf16_t* WAT, const bf16_t* WXT,
                 const float* ba, const float* bx, const float* lam, const float* conv0  , const float* h0  ,
                 float* conv_out  , float* h_out  , int dry = 0) {
    bf16_t* Xc = (bf16_t*)smem;
    float* SumA = (float*)(smem + 128 * 136 * 2);
    float* SumU = SumA + 256;
    float* Carry = SumU + 256;
    const int tid = ltid(), wid = tid >> 6, lane = tid & 63, r = lane & 31, hh = lane >> 5, tb = wid >> 1, cb = wid & 1;
    const int cl = half * 64 + cb * 32 + r;
    const int cg_ = n * 128 + cl;
    const float b_a = ba[cg_], b_x = bx[cg_], sp = fsoftplus(-lam[cg_]);
    if (tid < 64) Carry[tid] = h0 ? h0[n * 128 + half * 64 + tid] : 0.f;
    if (tid < 192 && !dry) { const int j = tid >> 6, c = n * 128 + half * 64 + (tid & 63); conv_out[j * 1024 + c] = bf2f(Zb[(size_t)(L - 3 + j) * NZ + ZC_XA + c]); }
    const int sc = (tid & 15) * 8, st = (tid >> 4) * 4;
    float cw[4][8], cbias[8];
#pragma unroll
    for (int j = 0; j < 4; ++j)
#pragma unroll
        for (int e = 0; e < 8; ++e) cw[j][e] = convw[j * 1024 + n * 128 + sc + e];
#pragma unroll
    for (int e = 0; e < 8; ++e) cbias[e] = convb[n * 128 + sc + e];
    const int nsteps = (L + 127) / 128;
    for (int step = 0; step < nsteps; ++step) {
        const int t0 = step * 128;
        {
            float xr[7][8];
#pragma unroll
            for (int j = 0; j < 7; ++j) {
                const int t = t0 + st - 3 + j;
                if (t >= 0 && t < L) { const u32x4 w = *(const u32x4*)(Zb + (size_t)t * NZ + ZC_XA + n * 128 + sc);
                    xr[j][0] = lo2f(w.x); xr[j][1] = hi2f(w.x); xr[j][2] = lo2f(w.y); xr[j][3] = hi2f(w.y); xr[j][4] = lo2f(w.z); xr[j][5] = hi2f(w.z); xr[j][6] = lo2f(w.w); xr[j][7] = hi2f(w.w); }
                else if (t < 0 && conv0) {
#pragma unroll
                    for (int e = 0; e < 8; ++e) xr[j][e] = conv0[(3 + t) * 1024 + n * 128 + sc + e]; }
                else {
#pragma unroll
                    for (int e = 0; e < 8; ++e) xr[j][e] = 0.f; }
            }
#pragma unroll
            for (int q = 0; q < 4; ++q) {
                float o[8];
#pragma unroll
                for (int e = 0; e < 8; ++e) o[e] = cbias[e] + cw[0][e] * xr[q][e] + cw[1][e] * xr[q + 1][e] + cw[2][e] * xr[q + 2][e] + cw[3][e] * xr[q + 3][e];
                u32x4 w; w.x = cvtpk(o[0], o[1]); w.y = cvtpk(o[2], o[3]); w.z = cvtpk(o[4], o[5]); w.w = cvtpk(o[6], o[7]);
                *(u32x4*)(Xc + (st + q) * 136 + sc) = w;
            }
        }
        __syncthreads();
        f32x16 accr = zero16(), acci = zero16();
#pragma unroll
        for (int ks = 0; ks < 8; ++ks) {
            const bf16x8 a = ld8(Xc + (tb * 32 + r) * 136 + ks * 16 + hh * 8);
            const bf16x8 wa = ld8(WAT + ((size_t)n * 128 + cl) * 128 + ks * 16 + hh * 8), wx = ld8(WXT + ((size_t)n * 128 + cl) * 128 + ks * 16 + hh * 8);
            accr = MFMA32(a, wa, accr); acci = MFMA32(a, wx, acci);
        }
        float av[16], uv[16];
#pragma unroll
        for (int i = 0; i < 16; ++i) {
            const int tl = tb * 32 + crow(i, hh);
            const float xf = bf2f(Xc[tl * 136 + cl]);
            const float rg = fsigmoid(accr[i] + b_a), ig = fsigmoid(acci[i] + b_x);
            const float la = -8.0f * rg * sp;
            float a = fexp(la), u = __builtin_sqrtf(neg_expm1(2.0f * la)) * (ig * xf);
            if (t0 + tl >= L) { a = 1.f; u = 0.f; }
            av[i] = a; uv[i] = u;
        }
        float PA[4], PU[4];
#pragma unroll
        for (int g = 0; g < 4; ++g) {
            float A = av[4 * g], U = uv[4 * g];
#pragma unroll
            for (int k = 1; k < 4; ++k) { U = av[4 * g + k] * U + uv[4 * g + k]; A *= av[4 * g + k]; uv[4 * g + k] = U; av[4 * g + k] = A; }
            PA[g] = A; PU[g] = U;
        }
        float QA[4], QU[4];
#pragma unroll
        for (int g = 0; g < 4; ++g) { QA[g] = __shfl_xor(PA[g], 32, 64); QU[g] = __shfl_xor(PU[g], 32, 64); }
        float CA = 1.f, CU = 0.f;
#pragma unroll
        for (int g = 0; g < 4; ++g) {
            const float A0 = hh == 0 ? PA[g] : QA[g], U0 = hh == 0 ? PU[g] : QU[g], A1 = hh == 0 ? QA[g] : PA[g], U1 = hh == 0 ? QU[g] : PU[g];
            CU = A0 * CU + U0; CA = A0 * CA;
            CU = A1 * CU + U1; CA = A1 * CA;
        }
        if (hh == 0) { SumA[tb * 64 + cb * 32 + r] = CA; SumU[tb * 64 + cb * 32 + r] = CU; }
        __syncthreads();
        float carry = Carry[(step & 1) * 64 + cb * 32 + r];
        for (int j = 0; j < tb; ++j) carry = SumA[j * 64 + cb * 32 + r] * carry + SumU[j * 64 + cb * 32 + r];
        float hcur = carry;
#pragma unroll
        for (int g = 0; g < 4; ++g) {
            float my_in;
            if (hh == 0) { my_in = hcur; hcur = PA[g] * hcur + PU[g]; hcur = QA[g] * hcur + QU[g]; }
            else { hcur = QA[g] * hcur + QU[g]; my_in = hcur; hcur = PA[g] * hcur + PU[g]; }
#pragma unroll
            for (int k = 0; k < 4; ++k) {
                const int i = 4 * g + k, tl = tb * 32 + crow(i, hh), t = t0 + tl;
                const float hv = uv[i] + av[i] * my_in;
                if (t < L && !dry) { bf16_t* p = Zb + (size_t)t * NZ + ZC_GA + cg_; *p = f2bf(hv * bf2f(*p)); }
            }
        }
        if (tb == 3 && hh == 0) { Carry[((step + 1) & 1) * 64 + cb * 32 + r] = hcur; if (step == nsteps - 1 && !dry) h_out[cg_] = hcur; }
        __syncthreads();
    }
}

DI void gla_unit(char* smem, bf16_t* Zb, int L, int hd, const float* wgate  , const float* bgate  , const float* gnorm  ,
                 const float* S0  , float* Sout  , int dry = 0) {
    float* BL = (float*)smem;
    bf16_t* Qs = (bf16_t*)(smem + 32768);
    bf16_t* Ks = Qs + 64 * 136;
    bf16_t* KTs = Ks + 64 * 136;
    bf16_t* VTs = KTs + 128 * 72;
    bf16_t* As = VTs + 256 * 72;
    float* ZRs = (float*)(As + 64 * 72);
    float* Seg = ZRs + 64 * 16;
    float* Dec = Seg + 512;
    float* SSq = Dec + 128;
    const int tid = ltid(), wid = tid >> 6, lane = tid & 63, r = lane & 31, hh = lane >> 5;
    f32x16 S[4];
#pragma unroll
    for (int d = 0; d < 4; ++d)
#pragma unroll
        for (int i = 0; i < 16; ++i) S[d][i] = S0 ? S0[(size_t)(32 * d + crow(i, hh)) * 256 + 32 * wid + r] : 0.f;
    const int gdk = tid & 127, gseg = tid >> 7;
    const float gn = gnorm[32 * wid + r];
    const int nch = (L + 63) / 64;
    for (int ch = 0; ch < nch; ++ch) {
        const int t0 = ch * 64;
        for (int e = tid; e < 64 * 16; e += 512) { const int t = e >> 4, j = e & 15; ZRs[e] = (t0 + t < L) ? bf2f(Zb[(size_t)(t0 + t) * NZ + ZC_ZR + j]) : 0.f; }
        __syncthreads();
        {
            float wg[16];
#pragma unroll
            for (int j = 0; j < 16; ++j) wg[j] = wgate[j * 512 + hd * 128 + gdk];
            const float bg = bgate[hd * 128 + gdk];
            float run = 0.f;
#pragma unroll 4
            for (int tt = 0; tt < 16; ++tt) {
                const int t = gseg * 16 + tt;
                float z = bg;
#pragma unroll
                for (int j = 0; j < 16; ++j) z += ZRs[t * 16 + j] * wg[j];
                const float lg = (t0 + t < L) ? -fsoftplus(-z) * (1.0f / 16.0f) : 0.f;
                run += lg; BL[t * 128 + gdk] = run;
            }
            Seg[gseg * 128 + gdk] = run;
        }
        __syncthreads();
        if (tid < 128) { const float s0 = Seg[tid], s1 = Seg[128 + tid], s2 = Seg[256 + tid], s3 = Seg[384 + tid]; Dec[tid] = fexp(s0 + s1 + s2 + s3); }
        {
            const int t = tid >> 3, d0 = (tid & 7) * 16, sg = t >> 4;
            const bool valid = (t0 + t) < L;
#pragma unroll 1
            for (int half8 = 0; half8 < 2; ++half8) {
                const int dk = d0 + half8 * 8;
                u32x4 qw = (u32x4){0, 0, 0, 0}, kw = qw;
                if (valid) { qw = *(const u32x4*)(Zb + (size_t)(t0 + t) * NZ + ZC_Q + hd * 128 + dk); kw = *(const u32x4*)(Zb + (size_t)(t0 + t) * NZ + ZC_K + hd * 128 + dk); }
                float q[8] = {lo2f(qw.x), hi2f(qw.x), lo2f(qw.y), hi2f(qw.y), lo2f(qw.z), hi2f(qw.z), lo2f(qw.w), hi2f(qw.w)};
                float k[8] = {lo2f(kw.x), hi2f(kw.x), lo2f(kw.y), hi2f(kw.y), lo2f(kw.z), hi2f(kw.z), lo2f(kw.w), hi2f(kw.w)};
                float qt[8], kt[8];
#pragma unroll
                for (int e = 0; e < 8; ++e) {
                    float off = 0.f, tot = 0.f;
#pragma unroll
                    for (int s = 0; s < 4; ++s) { const float sv = Seg[s * 128 + dk + e]; tot += sv; if (s < sg) off += sv; }
                    const float b = BL[t * 128 + dk + e] + off;
                    qt[e] = q[e] * fexp(b) * 0.08838834764831845f; kt[e] = k[e] * fexp(-b);
                    KTs[(dk + e) * 72 + t] = f2bf(k[e] * fexp(tot - b));
                }
                u32x4 w; w.x = cvtpk(qt[0], qt[1]); w.y = cvtpk(qt[2], qt[3]); w.z = cvtpk(qt[4], qt[5]); w.w = cvtpk(qt[6], qt[7]);
                *(u32x4*)(Qs + t * 136 + dk) = w;
                w.x = cvtpk(kt[0], kt[1]); w.y = cvtpk(kt[2], kt[3]); w.z = cvtpk(kt[4], kt[5]); w.w = cvtpk(kt[6], kt[7]);
                *(u32x4*)(Ks + t * 136 + dk) = w;
            }
        }
#pragma unroll 1
        for (int it = 0; it < 4; ++it) {
            const int p = tid + 512 * it, t = p >> 5, dv = (p & 31) * 8;
            u32x4 vw = (u32x4){0, 0, 0, 0};
            if (t0 + t < L) vw = *(const u32x4*)(Zb + (size_t)(t0 + t) * NZ + ZC_V + hd * 256 + dv);
            VTs[(dv + 0) * 72 + t] = (bf16_t)(vw.x & 0xffff); VTs[(dv + 1) * 72 + t] = (bf16_t)(vw.x >> 16); VTs[(dv + 2) * 72 + t] = (bf16_t)(vw.y & 0xffff); VTs[(dv + 3) * 72 + t] = (bf16_t)(vw.y >> 16);
            VTs[(dv + 4) * 72 + t] = (bf16_t)(vw.z & 0xffff); VTs[(dv + 5) * 72 + t] = (bf16_t)(vw.z >> 16); VTs[(dv + 6) * 72 + t] = (bf16_t)(vw.w & 0xffff); VTs[(dv + 7) * 72 + t] = (bf16_t)(vw.w >> 16);
        }
        __syncthreads();
        if (wid < 4) {
            const int tbk = wid >> 1, sbk = wid & 1;
            f32x16 a = zero16();
            if (tbk >= sbk) {
#pragma unroll
                for (int ks = 0; ks < 8; ++ks) a = MFMA32(ld8(Qs + (tbk * 32 + r) * 136 + ks * 16 + hh * 8), ld8(Ks + (sbk * 32 + r) * 136 + ks * 16 + hh * 8), a);
            }
#pragma unroll
            for (int i = 0; i < 16; ++i) { const int t = tbk * 32 + crow(i, hh), s = sbk * 32 + r; As[t * 72 + s] = f2bf(s <= t ? a[i] : 0.f); }
        }
        f32x16 o[2]; o[0] = zero16(); o[1] = zero16();
#pragma unroll
        for (int d = 0; d < 4; ++d)
#pragma unroll
            for (int s = 0; s < 2; ++s) {
                const bf16x8 bS = pack8(S[d], s);
#pragma unroll
                for (int tbk = 0; tbk < 2; ++tbk) {
                    const bf16_t* qp = Qs + (tbk * 32 + r) * 136 + d * 32 + 16 * s + 4 * hh;
                    o[tbk] = MFMA32(cat44(qp, qp + 8), bS, o[tbk]);
                }
            }
        __syncthreads();
#pragma unroll
        for (int ks = 0; ks < 4; ++ks) {
            const bf16x8 bv = ld8(VTs + (wid * 32 + r) * 72 + ks * 16 + hh * 8);
#pragma unroll
            for (int tbk = 0; tbk < 2; ++tbk) o[tbk] = MFMA32(ld8(As + (tbk * 32 + r) * 72 + ks * 16 + hh * 8), bv, o[tbk]);
        }
#pragma unroll
        for (int d = 0; d < 4; ++d)
#pragma unroll
            for (int i = 0; i < 16; ++i) S[d][i] *= Dec[32 * d + crow(i, hh)];
#pragma unroll
        for (int ks = 0; ks < 4; ++ks) {
            const bf16x8 bv = ld8(VTs + (wid * 32 + r) * 72 + ks * 16 + hh * 8);
#pragma unroll
            for (int d = 0; d < 4; ++d) S[d] = MFMA32(ld8(KTs + (d * 32 + r) * 72 + ks * 16 + hh * 8), bv, S[d]);
        }
#pragma unroll
        for (int tbk = 0; tbk < 2; ++tbk)
#pragma unroll
            for (int i = 0; i < 16; ++i) {
                float v = o[tbk][i] * o[tbk][i];
                v += __shfl_xor(v, 1, 64); v += __shfl_xor(v, 2, 64); v += __shfl_xor(v, 4, 64); v += __shfl_xor(v, 8, 64); v += __shfl_xor(v, 16, 64);
                if (r == 0) SSq[wid * 64 + tbk * 32 + crow(i, hh)] = v;
            }
        __syncthreads();
#pragma unroll
        for (int tbk = 0; tbk < 2; ++tbk)
#pragma unroll
            for (int i = 0; i < 16; ++i) {
                const int tl = tbk * 32 + crow(i, hh), t = t0 + tl;
                float ss = 0.f;
#pragma unroll
                for (int w = 0; w < 8; ++w) ss += SSq[w * 64 + tl];
                const float rs = __builtin_amdgcn_rsqf(ss * (1.0f / 256.0f) + EPS);
                if (t < L && !dry) { bf16_t* p = Zb + (size_t)t * NZ + ZC_GB + hd * 256 + 32 * wid + r; *p = f2bf(o[tbk][i] * rs * gn * bf2f(*p)); }
            }
        __syncthreads();
    }
#pragma unroll
    for (int d = 0; d < 4; ++d)
#pragma unroll
        for (int i = 0; i < 16; ++i) if (!dry) Sout[(size_t)(32 * d + crow(i, hh)) * 256 + 32 * wid + r] = S[d][i];
}


DI void gla_pre_unit(char* smem, bf16_t* Zc, int hd, const float* wgate, const float* bgate, bf16_t* OIc, float* decp, int dry = 0) {
    float* BL = (float*)smem;
    bf16_t* Qs = (bf16_t*)(smem + 33792);
    bf16_t* Ks = Qs + 64 * 136;
    bf16_t* KTs = Ks + 64 * 136;
    bf16_t* VTs = KTs + 128 * 72;
    bf16_t* As = VTs + 256 * 72;
    float* ZRs = (float*)(As + 64 * 72);
    float* Seg = ZRs + 64 * 16;
    float* Pre = Seg + 512;
    float* Tot = Pre + 512;
    const int tid = ltid(), wid = tid >> 6, lane = tid & 63, r = lane & 31, hh = lane >> 5;
    const int gdk = tid & 127, gseg = tid >> 7;
    float wg[16];
#pragma unroll
    for (int j = 0; j < 16; ++j) wg[j] = wgate[j * 512 + hd * 128 + gdk];
    const float bg = bgate[hd * 128 + gdk];
    u32x4 gq[2], gk[2], gvv[4];
    { const int t = tid >> 3, d0 = (tid & 7) * 16;
#pragma unroll
      for (int h8 = 0; h8 < 2; ++h8) { gq[h8] = *(const u32x4*)(Zc + (size_t)t * NZ + ZC_Q + hd * 128 + d0 + h8 * 8); gk[h8] = *(const u32x4*)(Zc + (size_t)t * NZ + ZC_K + hd * 128 + d0 + h8 * 8); }
#pragma unroll
      for (int it = 0; it < 4; ++it) { const int p = tid + 512 * it; gvv[it] = *(const u32x4*)(Zc + (size_t)(p >> 5) * NZ + ZC_V + hd * 256 + (p & 31) * 8); } }
    for (int e = tid; e < 64 * 16; e += 512) { const int t = e >> 4, j = e & 15; ZRs[e] = bf2f(Zc[(size_t)t * NZ + ZC_ZR + j]); }
    __syncthreads();
    {
        float run = 0.f;
#pragma unroll 4
        for (int tt = 0; tt < 16; ++tt) {
            const int t = gseg * 16 + tt;
            float z = bg;
#pragma unroll
            for (int j4 = 0; j4 < 4; ++j4) { const f32x4 zz = *(const f32x4*)(ZRs + t * 16 + j4 * 4); z += zz[0] * wg[j4 * 4] + zz[1] * wg[j4 * 4 + 1] + zz[2] * wg[j4 * 4 + 2] + zz[3] * wg[j4 * 4 + 3]; }
            run += -fsoftplus(-z) * (1.0f / 16.0f); BL[t * 132 + gdk] = run;
        }
        Seg[gseg * 128 + gdk] = run;
    }
    __syncthreads();
    if (tid < 128) { const float s0 = Seg[tid], s1 = Seg[128 + tid], s2 = Seg[256 + tid], s3 = Seg[384 + tid];
        Pre[tid] = 0.f; Pre[128 + tid] = s0; Pre[256 + tid] = s0 + s1; Pre[384 + tid] = s0 + s1 + s2; Tot[tid] = s0 + s1 + s2 + s3; decp[tid] = fexp(s0 + s1 + s2 + s3); }
    __syncthreads();
    {
        const int t = tid >> 3, d0 = (tid & 7) * 16, sg = t >> 4;
#pragma unroll
        for (int half8 = 0; half8 < 2; ++half8) {
            const int dk = d0 + half8 * 8;
            const u32x4 qw = gq[half8], kw = gk[half8];
            float q[8] = {lo2f(qw.x), hi2f(qw.x), lo2f(qw.y), hi2f(qw.y), lo2f(qw.z), hi2f(qw.z), lo2f(qw.w), hi2f(qw.w)};
            float k[8] = {lo2f(kw.x), hi2f(kw.x), lo2f(kw.y), hi2f(kw.y), lo2f(kw.z), hi2f(kw.z), lo2f(kw.w), hi2f(kw.w)};
            float qt[8], kt[8];
            const f32x4 bl0 = *(const f32x4*)(BL + t * 132 + dk), bl1 = *(const f32x4*)(BL + t * 132 + dk + 4), pr0 = *(const f32x4*)(Pre + sg * 128 + dk), pr1 = *(const f32x4*)(Pre + sg * 128 + dk + 4);
            const f32x4 to0 = *(const f32x4*)(Tot + dk), to1 = *(const f32x4*)(Tot + dk + 4);
            const int kcol = (((t >> 3) ^ ((dk >> 3) & 7)) << 3) + (t & 7);
#pragma unroll
            for (int e = 0; e < 8; ++e) {
                const float b = (e < 4 ? bl0[e & 3] + pr0[e & 3] : bl1[e & 3] + pr1[e & 3]), tot = (e < 4 ? to0[e & 3] : to1[e & 3]);
                qt[e] = q[e] * fexp(b) * 0.08838834764831845f; kt[e] = k[e] * fexp(-b);
                KTs[(dk + e) * 72 + kcol] = f2bf(k[e] * fexp(tot - b));
            }
            u32x4 w; w.x = cvtpk(qt[0], qt[1]); w.y = cvtpk(qt[2], qt[3]); w.z = cvtpk(qt[4], qt[5]); w.w = cvtpk(qt[6], qt[7]);
            *(u32x4*)(Qs + t * 136 + dk) = w;
            w.x = cvtpk(kt[0], kt[1]); w.y = cvtpk(kt[2], kt[3]); w.z = cvtpk(kt[4], kt[5]); w.w = cvtpk(kt[6], kt[7]);
            *(u32x4*)(Ks + t * 136 + dk) = w;
        }
    }
#pragma unroll
    for (int it = 0; it < 4; ++it) {
        const int p = tid + 512 * it, t = p >> 5, dv = (p & 31) * 8;
        const u32x4 vw = gvv[it];
        const int vcol = (((t >> 3) ^ ((dv >> 3) & 7)) << 3) + (t & 7);
        VTs[(dv + 0) * 72 + vcol] = (bf16_t)(vw.x & 0xffff); VTs[(dv + 1) * 72 + vcol] = (bf16_t)(vw.x >> 16); VTs[(dv + 2) * 72 + vcol] = (bf16_t)(vw.y & 0xffff); VTs[(dv + 3) * 72 + vcol] = (bf16_t)(vw.y >> 16);
        VTs[(dv + 4) * 72 + vcol] = (bf16_t)(vw.z & 0xffff); VTs[(dv + 5) * 72 + vcol] = (bf16_t)(vw.z >> 16); VTs[(dv + 6) * 72 + vcol] = (bf16_t)(vw.w & 0xffff); VTs[(dv + 7) * 72 + vcol] = (bf16_t)(vw.w >> 16);
    }
    __syncthreads();
    if (wid < 4) {
        const int tbk = wid >> 1, sbk = wid & 1;
        f32x16 a = zero16();
        if (tbk >= sbk) {
#pragma unroll
            for (int ks = 0; ks < 8; ++ks) a = MFMA32(ld8(Qs + (tbk * 32 + r) * 136 + ks * 16 + hh * 8), ld8(Ks + (sbk * 32 + r) * 136 + ks * 16 + hh * 8), a);
        }
#pragma unroll
        for (int i = 0; i < 16; ++i) { const int t = tbk * 32 + crow(i, hh), s2 = sbk * 32 + r; As[t * 72 + s2] = f2bf(s2 <= t ? a[i] : 0.f); }
    }
    if (!dry) {
#pragma unroll
    for (int it = 0; it < 2; ++it) { const int p = tid + 512 * it;
        { const int t = p >> 4, pc = p & 15; *(u32x4*)(Zc + (size_t)t * NZ + ZC_Q + hd * 128 + pc * 8) = *(const u32x4*)(Qs + t * 136 + pc * 8); }
        { const int dk = p >> 3, tp = p & 7, idx = dk * 64 + tp * 8; *(u32x4*)(Zc + (size_t)(idx >> 7) * NZ + ZC_K + hd * 128 + (idx & 127)) = *(const u32x4*)(KTs + dk * 72 + ((tp ^ ((dk >> 3) & 7)) << 3)); } }
#pragma unroll
    for (int it = 0; it < 4; ++it) { const int p = tid + 512 * it, dv = p >> 3, tp = p & 7, idx = dv * 64 + tp * 8;
        *(u32x4*)(Zc + (size_t)(idx >> 8) * NZ + ZC_V + hd * 256 + (idx & 255)) = *(const u32x4*)(VTs + dv * 72 + ((tp ^ ((dv >> 3) & 7)) << 3)); }
    }
    __syncthreads();
    f32x16 o[2]; o[0] = zero16(); o[1] = zero16();
#pragma unroll
    for (int ks = 0; ks < 4; ++ks) {
        const int dvr = wid * 32 + r; const bf16x8 bv = ld8(VTs + dvr * 72 + (((ks * 2 + hh) ^ ((dvr >> 3) & 7)) << 3));
#pragma unroll
        for (int tbk = 0; tbk < 2; ++tbk) o[tbk] = MFMA32(ld8(As + (tbk * 32 + r) * 72 + ks * 16 + hh * 8), bv, o[tbk]);
    }
    {
        bf16_t* op = OIc + ((size_t)wid * 64 + lane) * 32;
#pragma unroll
        for (int tbk = 0; tbk < 2; ++tbk)
#pragma unroll
            for (int g = 0; g < 2; ++g) { u32x4 w; w.x = cvtpk(o[tbk][8 * g], o[tbk][8 * g + 1]); w.y = cvtpk(o[tbk][8 * g + 2], o[tbk][8 * g + 3]); w.z = cvtpk(o[tbk][8 * g + 4], o[tbk][8 * g + 5]); w.w = cvtpk(o[tbk][8 * g + 6], o[tbk][8 * g + 7]);
                if (!dry) *(u32x4*)(op + tbk * 16 + g * 8) = w; }
    }
    __syncthreads();
}

DI void gla_seq_unit(char* smem, const bf16_t* Zb, int hd, bf16_t* OIb  , const float* DECb, float* Sout, int dry = 0) {
    constexpr int SEQBUF = 64 * 136 + 128 * 72 + 256 * 72;
    bf16_t* Qt = (bf16_t*)smem;
    bf16_t* KTt = Qt + 64 * 136;
    bf16_t* VTt = KTt + 128 * 72;
    float* Dec = (float*)(Qt + 2 * SEQBUF);
    const int tid = ltid(), wid = tid >> 6, lane = tid & 63, r = lane & 31, hh = lane >> 5;
    f32x16 S[4];
#pragma unroll
    for (int d = 0; d < 4; ++d) S[d] = zero16();
    u32x4 pq[2], pk[2], pv[4]; float pd = 0.f;
    auto gload = [&](int ch) {
        const bf16_t* Zc = Zb + (size_t)ch * 64 * NZ;
#pragma unroll
        for (int it = 0; it < 2; ++it) { const int p = tid + 512 * it, row = p >> 4, col = (p & 15) * 8;
            pq[it] = *(const u32x4*)(Zc + (size_t)row * NZ + ZC_Q + hd * 128 + col); pk[it] = *(const u32x4*)(Zc + (size_t)row * NZ + ZC_K + hd * 128 + col); }
#pragma unroll
        for (int it = 0; it < 4; ++it) { const int p = tid + 512 * it, row = p >> 5, col = (p & 31) * 8; pv[it] = *(const u32x4*)(Zc + (size_t)row * NZ + ZC_V + hd * 256 + col); }
        if (tid < 128) pd = DECb[ch * 128 + tid];
    };
    auto lstore = [&](int bsel) {
        const int bo = bsel * SEQBUF;
#pragma unroll
        for (int it = 0; it < 2; ++it) { const int p = tid + 512 * it;
            *(u32x4*)(Qt + bo + (p >> 4) * 136 + (p & 15) * 8) = pq[it];
            *(u32x4*)(KTt + bo + (p >> 3) * 72 + (p & 7) * 8) = pk[it]; }
#pragma unroll
        for (int it = 0; it < 4; ++it) { const int p = tid + 512 * it; *(u32x4*)(VTt + bo + (p >> 3) * 72 + (p & 7) * 8) = pv[it]; }
        if (tid < 128) Dec[bsel * 128 + tid] = pd;
    };
    gload(0); lstore(0);
    if (SEQ / 64 > 1) gload(1);
    __syncthreads();
    for (int ch = 0; ch < SEQ / 64; ++ch) {
        const int bo = (ch & 1) * SEQBUF;
        bf16_t* op = OIb + (((size_t)ch * 8 + wid) * 64 + lane) * 32;
        u32x4 oi[4];
#pragma unroll
        for (int g = 0; g < 4; ++g) oi[g] = *(const u32x4*)(op + g * 8);
        f32x16 o[2], o2[2]; o[0] = zero16(); o[1] = zero16(); o2[0] = zero16(); o2[1] = zero16();
#pragma unroll
        for (int d = 0; d < 4; ++d)
#pragma unroll
            for (int s = 0; s < 2; ++s) {
                const bf16x8 bS = pack8(S[d], s);
#pragma unroll
                for (int tbk = 0; tbk < 2; ++tbk) { const bf16_t* qp = Qt + bo + (tbk * 32 + r) * 136 + d * 32 + 16 * s + 4 * hh;
                    if (d < 2) o[tbk] = MFMA32(cat44(qp, qp + 8), bS, o[tbk]); else o2[tbk] = MFMA32(cat44(qp, qp + 8), bS, o2[tbk]); }
            }
        o[0] = o[0] + o2[0]; o[1] = o[1] + o2[1];
#pragma unroll
        for (int d = 0; d < 4; ++d)
#pragma unroll
            for (int g = 0; g < 4; ++g) { const f32x4 dv4 = *(const f32x4*)(Dec + (ch & 1) * 128 + 32 * d + 8 * g + 4 * hh);
                S[d][4 * g] *= dv4[0]; S[d][4 * g + 1] *= dv4[1]; S[d][4 * g + 2] *= dv4[2]; S[d][4 * g + 3] *= dv4[3]; }
#pragma unroll
        for (int ks = 0; ks < 4; ++ks) {
            const bf16x8 bv = ld8(VTt + bo + (wid * 32 + r) * 72 + ks * 16 + hh * 8);
#pragma unroll
            for (int d = 0; d < 4; ++d) S[d] = MFMA32(ld8(KTt + bo + (d * 32 + r) * 72 + ks * 16 + hh * 8), bv, S[d]);
        }
#pragma unroll
        for (int g = 0; g < 4; ++g) { const int tbk = g >> 1, i0 = (g & 1) * 8; const unsigned ou[4] = {oi[g].x, oi[g].y, oi[g].z, oi[g].w}; u32x4 w;
            w.x = cvtpk(o[tbk][i0 + 0] + lo2f(ou[0]), o[tbk][i0 + 1] + hi2f(ou[0])); w.y = cvtpk(o[tbk][i0 + 2] + lo2f(ou[1]), o[tbk][i0 + 3] + hi2f(ou[1]));
            w.z = cvtpk(o[tbk][i0 + 4] + lo2f(ou[2]), o[tbk][i0 + 5] + hi2f(ou[2])); w.w = cvtpk(o[tbk][i0 + 6] + lo2f(ou[3]), o[tbk][i0 + 7] + hi2f(ou[3]));
            if (!dry) *(u32x4*)(op + g * 8) = w; }
        if (ch + 1 < SEQ / 64) lstore((ch + 1) & 1);
        if (ch + 2 < SEQ / 64) gload(ch + 2);
        __syncthreads();
    }
#pragma unroll
    for (int d = 0; d < 4; ++d)
#pragma unroll
        for (int i = 0; i < 16; ++i) Sout[(size_t)(32 * d + crow(i, hh)) * 256 + 32 * wid + r] = S[d][i];
}
DI void gla_post_unit(char* smem, bf16_t* Zc, int hd, const bf16_t* OIc, const float* gnorm, int dry = 0) {
    float* SSq = (float*)smem;
    float* RS = SSq + 512;
    const int tid = ltid(), wid = tid >> 6, lane = tid & 63, r = lane & 31, hh = lane >> 5;
    const float gn = gnorm[32 * wid + r];
    float o[32];
    const bf16_t* op = OIc + ((size_t)wid * 64 + lane) * 32;
#pragma unroll
    for (int g = 0; g < 4; ++g) { const u32x4 w = *(const u32x4*)(op + g * 8);
        o[g * 8 + 0] = lo2f(w.x); o[g * 8 + 1] = hi2f(w.x); o[g * 8 + 2] = lo2f(w.y); o[g * 8 + 3] = hi2f(w.y); o[g * 8 + 4] = lo2f(w.z); o[g * 8 + 5] = hi2f(w.z); o[g * 8 + 6] = lo2f(w.w); o[g * 8 + 7] = hi2f(w.w); }
    bf16_t gv[32];
#pragma unroll
    for (int e = 0; e < 32; ++e) gv[e] = Zc[(size_t)((e >> 4) * 32 + crow(e & 15, hh)) * NZ + ZC_GB + hd * 256 + 32 * wid + r];
    float v[32];
#pragma unroll
    for (int e = 0; e < 32; ++e) v[e] = o[e] * o[e];
#pragma unroll
    for (int k = 0; k < 16; ++k) { const bool up = (r & 16) != 0; const float keep = up ? v[16 + k] : v[k], send = up ? v[k] : v[16 + k]; v[k] = keep + __shfl_xor(send, 16, 64); }
#pragma unroll
    for (int k = 0; k < 8; ++k) { const bool up = (r & 8) != 0; const float keep = up ? v[8 + k] : v[k], send = up ? v[k] : v[8 + k]; v[k] = keep + __shfl_xor(send, 8, 64); }
#pragma unroll
    for (int k = 0; k < 4; ++k) { const bool up = (r & 4) != 0; const float keep = up ? v[4 + k] : v[k], send = up ? v[k] : v[4 + k]; v[k] = keep + __shfl_xor(send, 4, 64); }
#pragma unroll
    for (int k = 0; k < 2; ++k) { const bool up = (r & 2) != 0; const float keep = up ? v[2 + k] : v[k], send = up ? v[k] : v[2 + k]; v[k] = keep + __shfl_xor(send, 2, 64); }
    { const bool up = (r & 1) != 0; const float keep = up ? v[1] : v[0], send = up ? v[0] : v[1]; v[0] = keep + __shfl_xor(send, 1, 64); }
    SSq[wid * 64 + (r >> 4) * 32 + crow(r & 15, hh)] = v[0];
    __syncthreads();
    if (tid < 64) { float ss = 0.f;
#pragma unroll
        for (int w = 0; w < 8; ++w) ss += SSq[w * 64 + tid];
        RS[tid] = __builtin_amdgcn_rsqf(ss * (1.0f / 256.0f) + EPS); }
    __syncthreads();
#pragma unroll
    for (int e = 0; e < 32; ++e) {
        const int tl = (e >> 4) * 32 + crow(e & 15, hh);
        bf16_t* p = Zc + (size_t)tl * NZ + ZC_GB + hd * 256 + 32 * wid + r; const float v_ = o[e] * RS[tl] * gn * bf2f(gv[e]); if (!dry) *p = f2bf(v_);
    }
    __syncthreads();
}

DI void lru_pre_multi(char* smem, const bf16_t* Z, int idx0, int cnt, int n, int half, const float* convw, const float* convb, const bf16_t* WAT, const bf16_t* WXT,
                      const float* ba, const float* bx, const float* lam, bf16_t* HL, bf16_t* AC, float* TA, float* TU, float* conv_all) {
    bf16_t* Xc = (bf16_t*)smem;
    float* SumA = (float*)(smem + 128 * 136 * 2);
    float* SumU = SumA + 256;
    const int tid = ltid(), wid = tid >> 6, lane = tid & 63, r = lane & 31, hh = lane >> 5, tb = wid >> 1, cb = wid & 1;
    const int cl = half * 64 + cb * 32 + r, cg_ = n * 128 + cl;
    const float b_a = ba[cg_], b_x = bx[cg_], sp = fsoftplus(-lam[cg_]);
    bf16x8 wa[8], wx[8];
#pragma unroll
    for (int ks = 0; ks < 8; ++ks) { wa[ks] = ld8(WAT + ((size_t)n * 128 + cl) * 128 + ks * 16 + hh * 8); wx[ks] = ld8(WXT + ((size_t)n * 128 + cl) * 128 + ks * 16 + hh * 8); }
    const int sc = (tid & 15) * 8, st = (tid >> 4) * 4;
    float cw[4][8], cbias[8];
#pragma unroll
    for (int j = 0; j < 4; ++j) { const f32x4 w0 = *(const f32x4*)(convw + j * 1024 + n * 128 + sc), w1 = *(const f32x4*)(convw + j * 1024 + n * 128 + sc + 4);
#pragma unroll
        for (int e = 0; e < 4; ++e) { cw[j][e] = w0[e]; cw[j][4 + e] = w1[e]; } }
    { const f32x4 w0 = *(const f32x4*)(convb + n * 128 + sc), w1 = *(const f32x4*)(convb + n * 128 + sc + 4);
#pragma unroll
        for (int e = 0; e < 4; ++e) { cbias[e] = w0[e]; cbias[4 + e] = w1[e]; } }
    u32x4 xw[7];
    auto xload = [&](int idx_) { const int bb_ = idx_ >> 4, t0_ = (idx_ & 15) * 128; const bf16_t* Zb_ = Z + (size_t)bb_ * SEQ * NZ;
#pragma unroll
        for (int j = 0; j < 7; ++j) { const int t = t0_ + st - 3 + j; xw[j] = (u32x4){0u, 0u, 0u, 0u}; if (t >= 0) xw[j] = *(const u32x4*)(Zb_ + (size_t)t * NZ + ZC_XA + n * 128 + sc); } };
    xload(idx0);
    for (int kk = 0; kk < cnt; ++kk) {
    const int idx = idx0 + kk, bb = idx >> 4, step = idx & 15;
    const bf16_t* Zb = Z + (size_t)bb * SEQ * NZ; bf16_t* HLb = HL + (size_t)bb * SEQ * 1024; bf16_t* ACb = AC + (size_t)bb * SEQ * 1024;
    float* TAp = TA + (size_t)idx * 1024; float* TUp = TU + (size_t)idx * 1024; float* conv_out = step == 15 ? conv_all + (size_t)bb * 3 * 1024 : nullptr;
    const int t0 = step * 128;
    if (conv_out && tid < 192) { const int j = tid >> 6, c = n * 128 + half * 64 + (tid & 63); conv_out[j * 1024 + c] = bf2f(Zb[(size_t)(SEQ - 3 + j) * NZ + ZC_XA + c]); }
    {
        float xr[7][8];
#pragma unroll
        for (int j = 0; j < 7; ++j) { const u32x4 w = xw[j];
            xr[j][0] = lo2f(w.x); xr[j][1] = hi2f(w.x); xr[j][2] = lo2f(w.y); xr[j][3] = hi2f(w.y); xr[j][4] = lo2f(w.z); xr[j][5] = hi2f(w.z); xr[j][6] = lo2f(w.w); xr[j][7] = hi2f(w.w); }
#pragma unroll
        for (int q = 0; q < 4; ++q) {
            float o[8];
#pragma unroll
            for (int e = 0; e < 8; ++e) o[e] = cbias[e] + cw[0][e] * xr[q][e] + cw[1][e] * xr[q + 1][e] + cw[2][e] * xr[q + 2][e] + cw[3][e] * xr[q + 3][e];
            u32x4 w; w.x = cvtpk(o[0], o[1]); w.y = cvtpk(o[2], o[3]); w.z = cvtpk(o[4], o[5]); w.w = cvtpk(o[6], o[7]);
            *(u32x4*)(Xc + (st + q) * 136 + sc) = w;
        }
    }
    if (kk + 1 < cnt) xload(idx + 1);
    __syncthreads();
    f32x16 accr = zero16(), acci = zero16();
#pragma unroll
    for (int ks = 0; ks < 8; ++ks) {
        const bf16x8 a = ld8(Xc + (tb * 32 + r) * 136 + ks * 16 + hh * 8);
        accr = MFMA32(a, wa[ks], accr); acci = MFMA32(a, wx[ks], acci);
    }
    float av[16], uv[16];
#pragma unroll
    for (int i = 0; i < 16; ++i) {
        const int tl = tb * 32 + crow(i, hh);
        const float xf = bf2f(Xc[tl * 136 + cl]);
        const float rg = fsigmoid(accr[i] + b_a), ig = fsigmoid(acci[i] + b_x);
        const float la = -8.0f * rg * sp;
        av[i] = fexp(la); uv[i] = __builtin_sqrtf(neg_expm1(2.0f * la)) * (ig * xf);
    }
    float PA[4], PU[4];
#pragma unroll
    for (int g = 0; g < 4; ++g) {
        float A = av[4 * g], U = uv[4 * g];
#pragma unroll
        for (int k = 1; k < 4; ++k) { U = av[4 * g + k] * U + uv[4 * g + k]; A *= av[4 * g + k]; uv[4 * g + k] = U; av[4 * g + k] = A; }
        PA[g] = A; PU[g] = U;
    }
    float QA[4], QU[4];
#pragma unroll
    for (int g = 0; g < 4; ++g) { QA[g] = __shfl_xor(PA[g], 32, 64); QU[g] = __shfl_xor(PU[g], 32, 64); }
    float gA[4], gU[4]; float CA = 1.f, CU = 0.f;
#pragma unroll
    for (int g = 0; g < 4; ++g) {
        if (hh == 0) { gA[g] = CA; gU[g] = CU; CU = PA[g] * CU + PU[g]; CA = PA[g] * CA; CU = QA[g] * CU + QU[g]; CA = QA[g] * CA; }
        else { CU = QA[g] * CU + QU[g]; CA = QA[g] * CA; gA[g] = CA; gU[g] = CU; CU = PA[g] * CU + PU[g]; CA = PA[g] * CA; }
    }
    if (hh == 0) { SumA[tb * 64 + cb * 32 + r] = CA; SumU[tb * 64 + cb * 32 + r] = CU; }
    __syncthreads();
    float pA = 1.f, pU = 0.f;
    for (int j = 0; j < tb; ++j) { const float sa = SumA[j * 64 + cb * 32 + r], su = SumU[j * 64 + cb * 32 + r]; pU = sa * pU + su; pA = sa * pA; }
#pragma unroll
    for (int g = 0; g < 4; ++g)
#pragma unroll
        for (int k = 0; k < 4; ++k) {
            const int i = 4 * g + k, t = t0 + tb * 32 + crow(i, hh);
            HLb[(size_t)t * 1024 + cg_] = f2bf(uv[i] + av[i] * (gA[g] * pU + gU[g]));
            ACb[(size_t)t * 1024 + cg_] = f2bf(av[i] * gA[g] * pA);
        }
    if (tb == 3 && hh == 0) { TAp[cg_] = CA * pA; TUp[cg_] = CA * pU + CU; }
    __syncthreads();
    }
}
DI void lru_fix_seq(bf16_t* Zb, int n, int q4, const bf16_t* HLb, const bf16_t* ACb, const float* TAb  , const float* TUb, float* h_out, int dry = 0) {
    const int tid = ltid(), c0 = n * 128 + q4 * 32 + (tid & 3) * 8, tl = tid >> 2;
    float carry[8];
#pragma unroll
    for (int e = 0; e < 8; ++e) carry[e] = 0.f;
    for (int s0 = 0; s0 < 16; s0 += 4) {
        u32x4 hw[4], aw[4], gw[4]; f32x4 ta0[4], ta1[4], tu0[4], tu1[4];
#pragma unroll
        for (int k = 0; k < 4; ++k) { const int stp = s0 + k, t = stp * 128 + tl;
            hw[k] = *(const u32x4*)(HLb + (size_t)t * 1024 + c0); aw[k] = *(const u32x4*)(ACb + (size_t)t * 1024 + c0); gw[k] = *(const u32x4*)(Zb + (size_t)t * NZ + ZC_GA + c0);
            ta0[k] = *(const f32x4*)(TAb + stp * 1024 + c0); ta1[k] = *(const f32x4*)(TAb + stp * 1024 + c0 + 4); tu0[k] = *(const f32x4*)(TUb + stp * 1024 + c0); tu1[k] = *(const f32x4*)(TUb + stp * 1024 + c0 + 4); }
#pragma unroll
        for (int k = 0; k < 4; ++k) {
            const int t = (s0 + k) * 128 + tl;
            const unsigned hu[4] = {hw[k].x, hw[k].y, hw[k].z, hw[k].w}, au[4] = {aw[k].x, aw[k].y, aw[k].z, aw[k].w}, gu[4] = {gw[k].x, gw[k].y, gw[k].z, gw[k].w};
            float h[8]; unsigned ou[4];
#pragma unroll
            for (int e = 0; e < 4; ++e) {
                h[2 * e] = lo2f(hu[e]) + lo2f(au[e]) * carry[2 * e]; h[2 * e + 1] = hi2f(hu[e]) + hi2f(au[e]) * carry[2 * e + 1];
                ou[e] = cvtpk(h[2 * e] * lo2f(gu[e]), h[2 * e + 1] * hi2f(gu[e]));
            }
            if (!dry) *(u32x4*)(Zb + (size_t)t * NZ + ZC_GA + c0) = (u32x4){ou[0], ou[1], ou[2], ou[3]};
            if (t == SEQ - 1) {
#pragma unroll
                for (int e = 0; e < 8; ++e) h_out[c0 + e] = h[e];
            }
#pragma unroll
            for (int e = 0; e < 4; ++e) { carry[e] = ta0[k][e] * carry[e] + tu0[k][e]; carry[4 + e] = ta1[k][e] * carry[4 + e] + tu1[k][e]; }
        }
    }
}

template <int NKS, class QF>
DI void qk_tile(const bf16_t* Kt, int kstr, const QF& qf, f32x16& s0, f32x16& s1, int r, int hh) {
    s0 = zero16(); s1 = zero16();
#pragma unroll
    for (int s = 0; s < NKS; ++s) {
        const bf16x8 q = qf(s);
        s0 = MFMA32(ld8(Kt + r * kstr + s * 16 + hh * 8), q, s0);
        s1 = MFMA32(ld8(Kt + (32 + r) * kstr + s * 16 + hh * 8), q, s1);
    }
}
template <int NKS, int NBATCH>
DI void qk_tile_stream(const bf16_t* Kt, int kstr, const bf16_t* qrow, f32x16& s0, f32x16& s1, int r, int hh) {
    s0 = zero16(); s1 = zero16();
#pragma unroll
    for (int b0 = 0; b0 < NKS; b0 += NBATCH) {
        bf16x8 q[NBATCH];
#pragma unroll
        for (int k = 0; k < NBATCH; ++k) q[k] = ld8(qrow + (b0 + k) * 16 + hh * 8);
#pragma unroll
        for (int k = 0; k < NBATCH; ++k) { const int s = b0 + k;
            s0 = MFMA32(ld8(Kt + r * kstr + s * 16 + hh * 8), q[k], s0);
            s1 = MFMA32(ld8(Kt + (32 + r) * kstr + s * 16 + hh * 8), q[k], s1); }
    }
}
template <int NDB>
DI void softmax_pv_tile(f32x16 s0, f32x16 s1, const bf16_t* Vt, int vstr, f32x16 (&o)[NDB], float& m, float& l, int nvalid, int r, int hh) {
    if (nvalid < 64) {
#pragma unroll
        for (int i = 0; i < 16; ++i) { if (crow(i, hh) >= nvalid) s0[i] = -INFINITY; if (32 + crow(i, hh) >= nvalid) s1[i] = -INFINITY; }
    }
    float mx = s0[0];
#pragma unroll
    for (int i = 1; i < 16; ++i) mx = fmaxf(mx, s0[i]);
#pragma unroll
    for (int i = 0; i < 16; ++i) mx = fmaxf(mx, s1[i]);
    mx = fmaxf(mx, __shfl_xor(mx, 32, 64));
    const float mn = fmaxf(m, mx), alpha = __builtin_amdgcn_exp2f(m - mn);
    float rs = 0.f;
#pragma unroll
    for (int i = 0; i < 16; ++i) { s0[i] = __builtin_amdgcn_exp2f(s0[i] - mn); s1[i] = __builtin_amdgcn_exp2f(s1[i] - mn); rs += s0[i] + s1[i]; }
    rs += __shfl_xor(rs, 32, 64);
    l = l * alpha + rs; m = mn;
#pragma unroll
    for (int d = 0; d < NDB; ++d)
#pragma unroll
        for (int i = 0; i < 16; ++i) o[d][i] *= alpha;
    const bf16x8 p00 = pack8(s0, 0), p01 = pack8(s0, 1), p10 = pack8(s1, 0), p11 = pack8(s1, 1);
#pragma unroll
    for (int d = 0; d < NDB; ++d) {
        const bf16_t* vp = Vt + (d * 32 + r) * vstr + 4 * hh;
        o[d] = MFMA32(cat44(vp, vp + 8), p00, o[d]);
        o[d] = MFMA32(cat44(vp + 16, vp + 24), p01, o[d]);
        o[d] = MFMA32(cat44(vp + 32, vp + 40), p10, o[d]);
        o[d] = MFMA32(cat44(vp + 48, vp + 56), p11, o[d]);
    }
}
template <int NKS, int NDB, class QF>
DI void flash_tile(const bf16_t* Kt, int kstr, const bf16_t* Vt, int vstr, const QF& qf, f32x16 (&o)[NDB], float& m, float& l, int nvalid, int r, int hh) {
    f32x16 s0, s1;
    qk_tile<NKS>(Kt, kstr, qf, s0, s1, r, hh);
    softmax_pv_tile<NDB>(s0, s1, Vt, vstr, o, m, l, nvalid, r, hh);
}

DI void attn_prompt_unit(char* smem, int b, int hd, int qb, bf16_t* QN, const bf16_t* KN, const bf16_t* KPE, const bf16_t* VT, int dry = 0) {
    constexpr int KSTR = 104, VSTR = 72, KB = 64 * KSTR, VB = 64 * VSTR;
    bf16_t* Kb = (bf16_t*)smem;
    bf16_t* Vb = Kb + 3 * KB;
    const int tid = ltid(), wid = tid >> 6, lane = tid & 63, r = lane & 31, hh = lane >> 5;
    const size_t tok0 = (size_t)b * SEQ;
    const int qrow = qb * 256 + wid * 32 + r;
    bf16x8 qf[6];
#pragma unroll
    for (int s = 0; s < 4; ++s) qf[s] = ld8(QN + (tok0 + qrow) * NQ + hd * 64 + s * 16 + hh * 8);
#pragma unroll
    for (int s = 0; s < 2; ++s) qf[4 + s] = ld8(QN + (tok0 + qrow) * NQ + 1024 + hd * 32 + s * 16 + hh * 8);
    f32x16 o[2]; o[0] = zero16(); o[1] = zero16();
    float m = -INFINITY, l = 0.f;
    const int ntiles = 4 * qb + 4, myl = 4 * qb + (wid >> 1);
    const int sr = tid >> 3, sp = tid & 7;
    u32x4 kreg, vreg, preg = (u32x4){0, 0, 0, 0};
    auto gloadK = [&](int kt) { const size_t key = tok0 + (size_t)kt * 64;
        kreg = *(const u32x4*)(KN + (key + sr) * 1024 + hd * 64 + sp * 8);
        if (tid < 256) preg = *(const u32x4*)(KPE + (key + (tid >> 2)) * 32 + (tid & 3) * 8); };
    auto gloadV = [&](int kt) { const size_t key = tok0 + (size_t)kt * 64; vreg = *(const u32x4*)(VT + (size_t)(hd * 64 + sr) * MP + key + sp * 8); };
    auto lstoreK = [&](int bi) { *(u32x4*)(Kb + bi * KB + sr * KSTR + sp * 8) = kreg; if (tid < 256) *(u32x4*)(Kb + bi * KB + (tid >> 2) * KSTR + 64 + (tid & 3) * 8) = preg; };
    auto lstoreV = [&](int bi) { *(u32x4*)(Vb + bi * VB + sr * VSTR + sp * 8) = vreg; };
    {
        gloadK(0); gloadV(0);
        const u32x4 k0 = kreg, p0 = preg;
        gloadK(1);
        const u32x4 k1 = kreg, p1 = preg;
        kreg = k0; preg = p0; lstoreK(0); lstoreV(0);
        kreg = k1; preg = p1; lstoreK(1);
    }
    __syncthreads();
    f32x16 c0 = zero16(), c1 = zero16(), n0 = zero16(), n1 = zero16();
    qk_tile<6>(Kb, KSTR, [&](int s) { return qf[s]; }, c0, c1, r, hh);
    for (int kt = 0; kt < ntiles; ++kt) {
        if (kt + 2 < ntiles) gloadK(kt + 2);
        if (kt + 1 < ntiles) gloadV(kt + 1);
        if (kt + 1 < ntiles && kt + 1 <= myl) qk_tile<6>(Kb + ((kt + 1) % 3) * KB, KSTR, [&](int s) { return qf[s]; }, n0, n1, r, hh);
        if (kt <= myl) softmax_pv_tile<2>(c0, c1, Vb + (kt & 1) * VB, VSTR, o, m, l, 64, r, hh);
        if (kt + 2 < ntiles) lstoreK((kt + 2) % 3);
        if (kt + 1 < ntiles) lstoreV((kt + 1) & 1);
        __syncthreads();
        c0 = n0; c1 = n1;
    }
    const float inv = frcp(l);
#pragma unroll
    for (int d = 0; d < 2; ++d)
#pragma unroll
        for (int g = 0; g < 4; ++g) {
            u32x2 w; w.x = cvtpk(o[d][4 * g] * inv, o[d][4 * g + 1] * inv); w.y = cvtpk(o[d][4 * g + 2] * inv, o[d][4 * g + 3] * inv);
            if (!dry) *(u32x2*)(QN + (tok0 + qrow) * NQ + hd * 64 + d * 32 + 8 * g + 4 * hh) = w;
        }
    __syncthreads();
}

DI void attn_sample_unit(char* smem, int b, int sp, const bf16_t* QLAT, const bf16_t* CC, const bf16_t* CCT, bf16_t* OP, float* ML) {
    constexpr int KSTR = 296, VSTR = 72;
    bf16_t* Kt = (bf16_t*)smem;
    bf16_t* Vt = (bf16_t*)(smem + 64 * KSTR * 2);
    const int tid = ltid(), wid = tid >> 6, lane = tid & 63, r = lane & 31, hh = lane >> 5;
    const bf16_t* qrow = QLAT + ((size_t)b * 256 + wid * 32 + r) * DLAT;
    f32x16 o[8];
#pragma unroll
    for (int d = 0; d < 8; ++d) o[d] = zero16();
    float m = -INFINITY, l = 0.f;
    for (int kt = (NKT * sp) / NSPLIT; kt < (NKT * (sp + 1)) / NSPLIT; ++kt) {
        const int key0 = kt * 64;
        {
            u32x4 kk[5], vv[4];
#pragma unroll
            for (int it = 0; it < 5; ++it) { const int p = tid + 512 * it; kk[it] = (u32x4){0u, 0u, 0u, 0u}; if (p < 64 * 36) { const int row = p / 36, pc = p % 36; kk[it] = *(const u32x4*)(CC + ((size_t)b * KEYP + key0 + row) * DLAT + pc * 8); } }
#pragma unroll
            for (int it = 0; it < 4; ++it) { const int p = tid + 512 * it, row = p >> 3, pc = p & 7; vv[it] = *(const u32x4*)(CCT + ((size_t)b * 256 + row) * KEYP + key0 + pc * 8); }
#pragma unroll
            for (int it = 0; it < 5; ++it) { const int p = tid + 512 * it; if (p < 64 * 36) { const int row = p / 36, pc = p % 36; *(u32x4*)(Kt + row * KSTR + pc * 8) = kk[it]; } }
#pragma unroll
            for (int it = 0; it < 4; ++it) { const int p = tid + 512 * it, row = p >> 3, pc = p & 7; *(u32x4*)(Vt + row * VSTR + pc * 8) = vv[it]; }
        }
        __syncthreads();
        const int nvalid = (KEYS - key0) < 64 ? (KEYS - key0) : 64;
        { f32x16 s0, s1; qk_tile_stream<18, 9>(Kt, KSTR, qrow, s0, s1, r, hh); softmax_pv_tile<8>(s0, s1, Vt, VSTR, o, m, l, nvalid, r, hh); }
        __syncthreads();
    }
    bf16_t* op = OP + (((size_t)b * NSPLIT + sp) * 256 + wid * 32 + r) * 256;
#pragma unroll
    for (int d = 0; d < 8; ++d)
#pragma unroll
        for (int g = 0; g < 4; ++g) { u32x2 w; w.x = cvtpk(o[d][4 * g], o[d][4 * g + 1]); w.y = cvtpk(o[d][4 * g + 2], o[d][4 * g + 3]); *(u32x2*)(op + d * 32 + 8 * g + 4 * hh) = w; }
    if (hh == 0) { float* ml = ML + (((size_t)b * NSPLIT + sp) * 256 + wid * 32 + r) * 2; ml[0] = m; ml[1] = l; }
}


#define XB_TMO      128
#define XB_XCNT(j)  (256  + 64 * (j))
#define XB_XSUB(j)  (1280 + 64 * (j))
#define XB_XGEN(j)  (2304 + 64 * (j))
#define XB_TOP      3328
#define XB_TOPGEN   3392
#define XCD_BAR_WORDS 3456
#define XB_SPIN_CAP (1u << 18)
DI unsigned xb_ld(unsigned* p)              { return __hip_atomic_load(p, __ATOMIC_RELAXED, __HIP_MEMORY_SCOPE_AGENT); }
DI unsigned xb_add(unsigned* p, unsigned v) { return __hip_atomic_fetch_add(p, v, __ATOMIC_RELAXED, __HIP_MEMORY_SCOPE_AGENT); }
DI unsigned xb_xcc_id() { return (unsigned)__builtin_amdgcn_s_getreg((3 << 11) | 20) & 0xFu; }
#define XB_SPIN(cond, bar) do { unsigned _sp = 0; while (cond) { __builtin_amdgcn_s_sleep(1); \
    if ((++_sp & 255u) == 0u) { if (xb_ld(&(bar)[XB_TMO])) break; if (_sp > XB_SPIN_CAP) { atomicAdd(&(bar)[XB_TMO], 1u); break; } } } } while (0)
struct XcdBarrier { unsigned* bar; unsigned x; volatile LAS unsigned* st; };
DI XcdBarrier xcd_barrier_post(unsigned* bar, volatile LAS unsigned* st) {
    XcdBarrier b; b.bar = bar; b.x = xb_xcc_id(); b.st = st;
    if (threadIdx.x == 0) (void)xb_add(&bar[XB_XCNT(b.x)], 1u);
    return b;
}
DI void xcd_barrier_complete(unsigned* bar, unsigned x, unsigned& nloc, unsigned& nx) {
    const unsigned G = gridDim.x * gridDim.y * gridDim.z;
    unsigned sum, cnt, mine, sp = 0u;
    for (;;) {
        sum = 0u; cnt = 0u; mine = 0u;
#pragma unroll
        for (unsigned j = 0; j < 16; ++j) { const unsigned c = xb_ld(&bar[XB_XCNT(j)]); sum += c; cnt += (c > 0u) ? 1u : 0u; mine = (j == x) ? c : mine; }
        if (sum == G) break;
        __builtin_amdgcn_s_sleep(1);
        if ((++sp & 255u) == 0u) { if (xb_ld(&bar[XB_TMO])) break; if (sp > XB_SPIN_CAP) { atomicAdd(&bar[XB_TMO], 1u); break; } }
    }
    nloc = mine > 0u ? mine : 1u; nx = cnt > 0u ? cnt : 1u;
}
DI void xcd_barrier(const XcdBarrier& b) {
    asm volatile("s_waitcnt vmcnt(0)" ::: "memory");
    __syncthreads();
    if (threadIdx.x == 0) {
        unsigned* bar = b.bar;
        __builtin_amdgcn_s_waitcnt(0);
        unsigned nloc = b.st[0], nx = b.st[1];
        if (nloc == 0u) { xcd_barrier_complete(bar, b.x, nloc, nx); b.st[0] = nloc; b.st[1] = nx; }
        const unsigned old = xb_add(&bar[XB_XSUB(b.x)], 1u);
        const unsigned gen = old / nloc;
        if (old + 1u == (gen + 1u) * nloc) {
            __builtin_amdgcn_fence(__ATOMIC_RELEASE, "agent");
            asm volatile("s_waitcnt vmcnt(0)" ::: "memory");
            const unsigned og = xb_add(&bar[XB_TOP], 1u);
            const unsigned tg = og / nx;
            if (og + 1u == (tg + 1u) * nx) xb_add(&bar[XB_TOPGEN], 1u);
            else XB_SPIN(xb_ld(&bar[XB_TOPGEN]) == tg, bar);
            __builtin_amdgcn_fence(__ATOMIC_ACQUIRE, "agent");
            xb_add(&bar[XB_XGEN(b.x)], 1u);
            asm volatile("s_waitcnt vmcnt(0)" ::: "memory");
        } else {
            XB_SPIN(xb_ld(&bar[XB_XGEN(b.x)]) == gen, bar);
            __builtin_amdgcn_fence(__ATOMIC_ACQUIRE, "agent");
            asm volatile("s_waitcnt vmcnt(0)" ::: "memory");
        }
    }
    __syncthreads();
}
struct Args { const float* in[33]; float* out; char* ws; int ph_lo, ph_hi; };
enum { I_XP = 0, I_XS, I_SCONV, I_SLRU, I_SGLA, I_CCKV, I_CKPE, I_NMPRE, I_NMPOST, I_NFPRE, I_NFPOST, I_WINAB, I_CONVW, I_CONVB, I_LWA, I_LBA, I_LWX, I_LBX, I_LAM,
       I_GWG, I_GBG, I_GNORM, I_WOUTAB, I_WINC, I_QNORM, I_WUQ, I_KVNORM, I_WUK, I_WUV, I_WOUTC, I_FG, I_FU, I_FD };
constexpr int NPHASE = 21;
__device__ const int PH_ORDER_unused = 0;
#ifndef PH_MASK
#define PH_MASK 0x3FFFFF
#endif
#define PHM(n) ((PH_MASK >> (n)) & 1)
#ifndef PROBE_DUP
#define PROBE_DUP 0
#endif

extern __shared__ __attribute__((aligned(16))) unsigned char dyn_lds[];

__global__ void __launch_bounds__(512, 2) mk_fwd(Args a) {
    char* smem = (char*)dyn_lds;
    char* ws = a.ws; float* out = a.out;
    const int G = gridDim.x, bid = blockIdx.x;
    bf16_t* WIN = (bf16_t*)(ws + WS_WIN); bf16_t* WOUT = (bf16_t*)(ws + WS_WOUT); bf16_t* WGU0 = (bf16_t*)(ws + WS_WGU0); bf16_t* WDN0 = (bf16_t*)(ws + WS_WDN0);
    bf16_t* WAT = (bf16_t*)(ws + WS_WAT); bf16_t* WXT = WAT + 8 * 128 * 128; float* ROPE = (float*)(ws + WS_ROPE);
    bf16_t* Us = (bf16_t*)(ws + WS_US); bf16_t* Zs = (bf16_t*)(ws + WS_ZS); bf16_t* Gs = (bf16_t*)(ws + WS_GS); float* CQs = (float*)(ws + WS_CQS);
    bf16_t* CQNs = (bf16_t*)(ws + WS_CQNS); bf16_t* QNs = (bf16_t*)(ws + WS_QNS); bf16_t* QLAT = (bf16_t*)(ws + WS_QLAT); float* ML = (float*)(ws + WS_ML);
    bf16_t* OLAT = (bf16_t*)(ws + WS_OLAT); bf16_t* Os = (bf16_t*)(ws + WS_OS);
    bf16_t* U = (bf16_t*)(ws + WS_U); bf16_t* Z = (bf16_t*)(ws + WS_Z);
    bf16_t* WGU1 = (bf16_t*)(ws + ZR_WGU1); bf16_t* WDN1 = (bf16_t*)(ws + ZR_WDN1); bf16_t* WINC = (bf16_t*)(ws + WS_WINC); bf16_t* WUQ = (bf16_t*)(ws + WS_WUQ);
    bf16_t* WUKT = (bf16_t*)(ws + WS_WUKT); bf16_t* WUVT = (bf16_t*)(ws + WS_WUVT); bf16_t* WOC = (bf16_t*)(ws + WS_WOC); bf16_t* WUK = (bf16_t*)(ws + WS_WUKP);
    bf16_t* CC = (bf16_t*)(ws + ZR_CC); bf16_t* CCT = (bf16_t*)(ws + ZR_CCT); bf16_t* Gp = (bf16_t*)(ws + ZR_G);
    float* CQ = (float*)(ws + ZR_QN); bf16_t* QN = (bf16_t*)(ws + ZR_QN); bf16_t* VT = (bf16_t*)(ws + ZR_VT); bf16_t* OP = (bf16_t*)(ws + WS_WIN);
    bf16_t* CQN = (bf16_t*)(ws + ZR_CQN); bf16_t* CKVN = (bf16_t*)(ws + ZR_CKVN); bf16_t* KPE = (bf16_t*)(ws + ZR_KPE);
    bf16_t* U0 = (bf16_t*)(out + O_YP);
    float* Hp = out + O_YP; float* Hs = out + O_YS;
    bf16_t* Hb = (bf16_t*)(out + O_YP);
    bf16_t* Hb2 = (bf16_t*)(ws + ZR_CC);

    volatile LAS unsigned* bst = (volatile LAS unsigned*)(dyn_lds + LDS_BYTES - 16);
    if (threadIdx.x == 0) { bst[0] = 0u; bst[1] = 0u; }
    __syncthreads();
    XcdBarrier xb = xcd_barrier_post((unsigned*)(ws + WS_CTL), bst);
    if (a.ph_hi > NPHASE) cg::this_grid().sync();
    for (int ph = a.ph_lo; ph < a.ph_hi; ++ph) {
        if (ph > a.ph_lo) xcd_barrier(xb);
        const int phc = ph < 2 ? ph : (ph == 2 ? 20 : (ph == 3 ? 2 : (ph == 4 ? 21 : ph - 2)));
        for (int rep_ = 0; rep_ < (((PROBE_DUP >> phc) & 1) ? 2 : 1); ++rep_) {
        if (rep_) __syncthreads();
        const int dry_ = (((PROBE_DUP >> phc) & 1) && rep_ == 0) ? 1 : 0;
        int r9lo = 0, r9hi = 0;
        switch (phc) {
        case 0: if (PHM(0)) {
            const int tid = ltid(), wid = tid >> 6, lane = tid & 63; (void)wid; (void)lane;
            int tb = 0;
            transpose_job(smem, 1024, NZ, WIN, 1024, SrcWin{a.in[I_WINAB]}, tb);
            transpose_job(smem, 2048, 1024, WOUT, 2048, SrcPlain{a.in[I_WOUTAB], 1024}, tb);
            for (int e = bid * 512 + tid; e < 2 * 8 * 128 * 16; e += G * 512) {
                const int which = e >> 14, idx = e & 16383, n = idx >> 11, cg8 = (idx >> 7) & 15, d = idx & 127;
                const float* wsrc = a.in[which ? I_LWX : I_LWA] + ((size_t)(n * 128 + cg8 * 8)) * 128 + d;
                float v[8];
#pragma unroll
                for (int k = 0; k < 8; ++k) v[k] = wsrc[k * 128];
                u32x4 w; w.x = cvtpk(v[0], v[1]); w.y = cvtpk(v[2], v[3]); w.z = cvtpk(v[4], v[5]); w.w = cvtpk(v[6], v[7]);
                *(u32x4*)(WAT + (size_t)which * 131072 + ((size_t)(n * 128 + d)) * 128 + cg8 * 8) = w;
            }
            for (int e = bid * 512 + tid; e < 2064 * 16; e += G * 512) {
                const int pi = e >> 4, i = e & 15; const int pos = pi < 2048 ? pi : PAST + (pi - 2048);
                const float inv = __builtin_amdgcn_exp2f(-(float)i * 0.830482023721841f);
                const float ang = (float)pos * inv;
                const double rev = (double)ang * 0.15915494309189535; const float fr = (float)(rev - floor(rev));
                ROPE[pi * 32 + i] = __builtin_amdgcn_cosf(fr); ROPE[pi * 32 + 16 + i] = __builtin_amdgcn_sinf(fr);
            }
            rms_rows_to_bf16(a.in[I_XP], a.in[I_NMPRE], U0, MP);
            rms_rows_to_bf16(a.in[I_XS], a.in[I_NMPRE], Us, MS);
        } break;
        case 1: if (PHM(1)) {
            big_gemm(smem, U0, 1024, WIN, MP, 5120, 1024, 0, FZ{Z});
            for (int u = (bid + G - 64 % G) % G; u < MP / 128; u += G) small_gemm_unit(smem, U0 + (size_t)u * 128 * 1024, 1024, WIN, 1024, 1024, ZC_ZR, FZ{Z + (size_t)u * 128 * NZ});
            small_gemm2(smem, Us, 1024, WIN, 1024, 1024, 4096, 192, FZ{Zs});
            small_gemm_h(smem, Us, 1024, WIN + (size_t)4096 * 1024, 1024, 1024, IN_AB - 4096, 64, FB{Zs + 4096, NZ});
        } break;
        case 20: if (PHM(20)) {
            bf16_t* HL = (bf16_t*)(out + O_YP); bf16_t* AC = HL + (size_t)MP * 1024; float* DEC = (float*)(ws + WS_DEC); float* TA = (float*)(ws + WS_TA); float* TU = (float*)(ws + WS_TU);
            for (int u = bid; u < 1024; u += G) { const int b = u >> 7, hd = (u >> 5) & 3, ch = u & 31;
                gla_pre_unit(smem, Z + ((size_t)b * SEQ + ch * 64) * NZ, hd, a.in[I_GWG], a.in[I_GBG], U + ((size_t)(b * 4 + hd) * 32 + ch) * 16384, DEC + ((size_t)(b * 4 + hd) * 32 + ch) * 128, dry_); }
        } break;
        case 2: if (PHM(2)) {
            bf16_t* HL = (bf16_t*)(out + O_YP); bf16_t* AC = HL + (size_t)MP * 1024; float* DEC = (float*)(ws + WS_DEC); float* TA = (float*)(ws + WS_TA); float* TU = (float*)(ws + WS_TU);
            if (bid < 32) { const int b = bid >> 2, hd = bid & 3;
                gla_seq_unit(smem, Z + (size_t)b * SEQ * NZ, hd, U + (size_t)(b * 4 + hd) * 32 * 16384, DEC + (size_t)(b * 4 + hd) * 32 * 128, out + O_PS + ((size_t)b * 4 + hd) * 128 * 256, dry_);
            }
            const int nb2 = G > 64 ? G - 32 : G, me2 = G > 64 ? (int)bid - 32 : (int)bid;
            if (me2 >= 0) for (int u = me2; u < 32 + 128; u += nb2) {
                if (u < 32) { const int b = u >> 2, hd = u & 3;
                    gla_unit(smem, Zs + (size_t)b * DSEQ * NZ, DSEQ, hd, a.in[I_GWG], a.in[I_GBG], a.in[I_GNORM], a.in[I_SGLA] + ((size_t)b * 4 + hd) * 128 * 256, out + O_SS + ((size_t)b * 4 + hd) * 128 * 256, dry_);
                } else { const int w = u - 32, b = w >> 4, n = (w >> 1) & 7, half = w & 1;
                    lru_unit(smem, Zs + (size_t)b * DSEQ * NZ, DSEQ, n, half, a.in[I_CONVW], a.in[I_CONVB], WAT, WXT, a.in[I_LBA], a.in[I_LBX], a.in[I_LAM],
                             a.in[I_SCONV] + (size_t)b * 3 * 1024, a.in[I_SLRU] + (size_t)b * 1024, out + O_SCONV + (size_t)b * 3 * 1024, out + O_SH + (size_t)b * 1024, dry_);
                }
                __syncthreads();
            }
            const int sk2 = nb2 >= 96 ? 32 : 0;
            if (me2 >= sk2) { const int m3 = me2 - sk2, n3 = nb2 - sk2; const int nh = m3 & 15, grp = m3 >> 4, ngrp = (n3 + 15 - nh) / 16;
              if (ngrp > 0) { const int per = (128 + ngrp - 1) / ngrp, i0 = grp * per, i1 = (i0 + per < 128) ? i0 + per : 128;
                if (i0 < i1) lru_pre_multi(smem, Z, i0, i1 - i0, nh >> 1, nh & 1, a.in[I_CONVW], a.in[I_CONVB], WAT, WXT, a.in[I_LBA], a.in[I_LBX], a.in[I_LAM], HL, AC, TA, TU, out + O_PCONV); } }
            { int tb2 = 0;
              transpose_job(smem, 1024, NGU, WGU0, 1024, SrcGU{a.in[I_FG], a.in[I_FU]}, tb2, nb2, G > 64 ? me2 : (int)bid);
              transpose_job(smem, DFF, 1024, WDN0, DFF, SrcPlain{a.in[I_FD], 1024}, tb2, nb2, G > 64 ? me2 : (int)bid);
              const int mw = G > 64 ? me2 : (int)bid;
              transpose_job(smem, 1024, NINC, WINC, 1024, SrcInc{a.in[I_WINC]}, tb2, nb2, mw);
              transpose_job(smem, 384, NQ, WUQ, 384, SrcUq{a.in[I_WUQ]}, tb2, nb2, mw);
              transpose_job(smem, 256, 1024, WUKT, 256, SrcPlain{a.in[I_WUK], 1024}, tb2, nb2, mw);
              transpose_job(smem, 256, 1024, WUVT, 256, SrcPlain{a.in[I_WUV], 1024}, tb2, nb2, mw);
              transpose_job(smem, 1024, 1024, WOC, 1024, SrcPlain{a.in[I_WOUTC], 1024}, tb2, nb2, mw);
              if (mw >= 0) { const int tid = ltid(); for (int e = mw * 512 + tid; e < 256 * 1024 / 4; e += nb2 * 512) { const f32x4 v = *(const f32x4*)(a.in[I_WUK] + (size_t)e * 4); u32x2 w; w.x = cvtpk(v[0], v[1]); w.y = cvtpk(v[2], v[3]); *(u32x2*)(WUK + (size_t)e * 4) = w; } } }
        } break;
        case 21: if (PHM(21)) {
            for (int u = bid; u < 1024; u += G) { const int b = u >> 7, hd = (u >> 5) & 3, ch = u & 31;
                gla_post_unit(smem, Z + ((size_t)b * SEQ + ch * 64) * NZ, hd, U + ((size_t)(b * 4 + hd) * 32 + ch) * 16384, a.in[I_GNORM], dry_); }
            { bf16_t* HL = (bf16_t*)(out + O_YP); bf16_t* AC = HL + (size_t)MP * 1024; float* TA = (float*)(ws + WS_TA); float* TU = (float*)(ws + WS_TU);
              for (int v = bid; v < 256; v += G) { const int b = v >> 5, n = (v >> 2) & 7, q4 = v & 3;
                lru_fix_seq(Z + (size_t)b * SEQ * NZ, n, q4, HL + (size_t)b * SEQ * 1024, AC + (size_t)b * SEQ * 1024, TA + (size_t)b * 16 * 1024, TU + (size_t)b * 16 * 1024, out + O_PH + (size_t)b * 1024, dry_); } }
            small_gemm_h(smem, Zs + ZC_GA, NZ, WOUT, 2048, 2048, 1024, 0, FB{Us, 1024});
        } break;
        case 3: if (PHM(3)) {
            big_gemm(smem, Z + ZC_GA, NZ, WOUT, MP, 1024, 2048, 0, FB{U, 1024});
            norm_rows<0, 0>(Us, a.in[I_XS], Hs, a.in[I_NMPOST], a.in[I_NFPRE], Us, MS, dry_);
        } break;
        case 4: if (PHM(4)) {
            const int tid = ltid(), wid = tid >> 6, lane = tid & 63; (void)wid; (void)lane;
            norm_rows<0, 1>(U, a.in[I_XP], Hb, a.in[I_NMPOST], a.in[I_NFPRE], U, MP, dry_);
            { int tb = 0; for (int b = 0; b < NB; ++b) transpose_job(smem, PAST, 256, CCT + (size_t)b * 256 * KEYP, KEYP, SrcPlain{a.in[I_CCKV] + (size_t)b * PAST * 256, 256}, tb); }
            for (int e0 = bid * 512 + tid; e0 < NB * PAST * 64; e0 += 4 * G * 512) {
                f32x4 v[4];
#pragma unroll
                for (int k = 0; k < 4; ++k) { const int e = e0 + k * G * 512; v[k] = (f32x4){0.f, 0.f, 0.f, 0.f}; if (e < NB * PAST * 64) v[k] = *(const f32x4*)(a.in[I_CCKV] + (size_t)(e >> 6) * 256 + (e & 63) * 4); }
#pragma unroll
                for (int k = 0; k < 4; ++k) { const int e = e0 + k * G * 512; if (e < NB * PAST * 64) { const int row = e >> 6, c4 = (e & 63) * 4; const int b = row >> 12, key = row & 4095;
                    u32x2 w; w.x = cvtpk(v[k][0], v[k][1]); w.y = cvtpk(v[k][2], v[k][3]); *(u32x2*)(CC + ((size_t)b * KEYP + key) * DLAT + c4) = w; } }
            }
            {
                float x1[4], x2[4];
#pragma unroll
                for (int k = 0; k < 4; ++k) { const int e = bid * 512 + tid + k * G * 512; x1[k] = 0.f; x2[k] = 0.f;
                    if (e < NB * PAST * 16) { const int row = e >> 4, i = e & 15; x1[k] = a.in[I_CKPE][(size_t)row * 32 + i]; x2[k] = a.in[I_CKPE][(size_t)row * 32 + 16 + i]; } }
#pragma unroll
                for (int k = 0; k < 4; ++k) { const int e = bid * 512 + tid + k * G * 512;
                    if (e < NB * PAST * 16) { const int row = e >> 4, i = e & 15; const int b = row >> 12, key = row & 4095; *(unsigned*)(CC + ((size_t)b * KEYP + key) * DLAT + 256 + 2 * i) = cvtpk(x1[k], x2[k]); } }
                for (int e = bid * 512 + tid + 4 * G * 512; e < NB * PAST * 16; e += G * 512) { const int row = e >> 4, i = e & 15; const int b = row >> 12, key = row & 4095;
                    *(unsigned*)(CC + ((size_t)b * KEYP + key) * DLAT + 256 + 2 * i) = cvtpk(a.in[I_CKPE][(size_t)row * 32 + i], a.in[I_CKPE][(size_t)row * 32 + 16 + i]); }
            }
            small_gemm2(smem, Us, 1024, WGU0, 1024, 1024, NGU, 0, FSw{Gs});
        } break;
        case 5: if (PHM(5)) {
            big_gemm(smem, U, 1024, WGU0, MP, NGU, 1024, 0, FSw{Gp});
            { int tb5 = 0; const int nw5 = G > 128 ? G - 128 : G, me5 = G > 128 ? (int)bid - 128 : (int)bid;
              transpose_job(smem, 1024, NGU, WGU1, 1024, SrcGU{a.in[I_FG] + (size_t)1024 * DFF, a.in[I_FU] + (size_t)1024 * DFF}, tb5, nw5, me5);
              transpose_job(smem, DFF, 1024, WDN1, DFF, SrcPlain{a.in[I_FD] + (size_t)DFF * 1024, 1024}, tb5, nw5, me5); }
            small_gemm(smem, Gs, DFF, WDN0, DFF, DFF, 1024, 128, FB{Us, 1024});
        } break;
        case 6: if (PHM(6)) {
            big_gemm(smem, Gp, DFF, WDN0, MP, 1024, DFF, 0, FB{U, 1024});
            norm_rows<0, 0>(Us, Hs, Hs, a.in[I_NFPOST], a.in[I_NMPRE] + 1024, Us, MS, dry_);
        } break;
        case 7: if (PHM(7)) {
            norm_rows<1, 1>(U, Hb, Hb, a.in[I_NFPOST], a.in[I_NMPRE] + 1024, U, MP, dry_);
            small_gemm_h(smem, Us, 1024, WINC, 1024, 1024, INC, 0, FF32{CQs, NINC});
        } break;
        case 8: if (PHM(8)) {
            big_gemm(smem, U, 1024, WINC, MP, NINC, 1024, 0, FF32{CQ, NINC});
            r9lo = MP; r9hi = MP + MS;
        } break;
        case 9: if (PHM(9)) {
            r9lo = 0; r9hi = MP;
            small_gemm_h(smem, CQNs, 384, WUQ, 384, 384, NQ, 0, FQ{ROPE, 1, QNs, QLAT});
        } break;
        case 10: if (PHM(10)) {
            big_gemm(smem, CQN, 384, WUQ, MP, NQ, 384, 0, FQ{ROPE, 0, QN, nullptr});
            big_gemm(smem, CKVN, 256, WUKT, MP, 1024, 256, 128, FB{U, 1024});
            big_gemm(smem, WUVT, 256, CKVN, 1024, MP, 256, 128, FB{VT, MP});
            for (int u = bid; u < 256; u += G) { const int hd = u >> 4, nt = u & 15; small_gemm_unit(smem, QNs + hd * 64, 1024, WUK + hd * 64, 1024, 64, nt * 16, FQL{QLAT, hd}); }
        } break;
        case 11: if (PHM(11)) {
            { const int bh = bid >> 1, set = bid & 1, b = bh >> 4, hd = bh & 15;
              if (bid < 256) for (int i = 0; i < 4; ++i) { const int qb = set ? (i & 1 ? 2 + (i >> 1) : 5 - (i >> 1)) : (i & 1 ? (i >> 1) : 7 - (i >> 1)); attn_prompt_unit(smem, b, hd, qb, QN, U, KPE, VT, dry_); }
              if (G < 256) {   for (int u = G + bid; u < 256; u += G) { const int bh2 = u >> 1, s2 = u & 1; for (int i = 0; i < 4; ++i) { const int qb = s2 ? (i & 1 ? 2 + (i >> 1) : 5 - (i >> 1)) : (i & 1 ? (i >> 1) : 7 - (i >> 1)); attn_prompt_unit(smem, bh2 >> 4, bh2 & 15, qb, QN, U, KPE, VT, dry_); } } } }
            for (int u = bid; u < NB * NSPLIT; u += G) attn_sample_unit(smem, u / NSPLIT, u % NSPLIT, QLAT, CC, CCT, OP, ML);
        } break;
        case 12: if (PHM(12)) {
            big_gemm(smem, QN, NQ, WOC, MP, 1024, 1024, 0, FB{U, 1024});
            { const int tid = ltid(), wid = tid >> 6, lane = tid & 63; (void)lane;
            const int gw = bid * 8 + wid, GW = G * 8;
            for (int rr = gw; rr < 2048; rr += GW) { const int b = rr >> 8, qr = rr & 255;
                float mm[NSPLIT], ll[NSPLIT]; float M = -INFINITY;
#pragma unroll
                for (int j = 0; j < NSPLIT; ++j) { const float* ml = ML + (((size_t)b * NSPLIT + j) * 256 + qr) * 2; mm[j] = ml[0]; ll[j] = ml[1]; M = fmaxf(M, mm[j]); }
                float Lt = 0.f; f32x4 acc = (f32x4){0.f, 0.f, 0.f, 0.f};
#pragma unroll
                for (int j = 0; j < NSPLIT; ++j) { const float w = __builtin_amdgcn_exp2f(mm[j] - M); Lt += w * ll[j];
                    const u32x2 pv = *(const u32x2*)(OP + (((size_t)b * NSPLIT + j) * 256 + qr) * 256 + lane * 4); acc += (f32x4){lo2f(pv.x), hi2f(pv.x), lo2f(pv.y), hi2f(pv.y)} * w; }
                const float inv = frcp(Lt); u32x2 w; w.x = cvtpk(acc[0] * inv, acc[1] * inv); w.y = cvtpk(acc[2] * inv, acc[3] * inv);
                *(u32x2*)(OLAT + (size_t)rr * 256 + lane * 4) = w; }
            }
        } break;
        case 13: if (PHM(13)) {
            const int tid = ltid(), wid = tid >> 6, lane = tid & 63; (void)wid; (void)lane;
            norm_rows<1, 1>(U, Hb, Hb2, a.in[I_NMPOST] + 1024, a.in[I_NFPRE] + 1024, U, MP, dry_);
            for (int u = bid; u < 128; u += G) { const int hd = u >> 3, nt = (u >> 1) & 3, hf = u & 1; small_gemm_unit_h(smem, OLAT + hd * 256, 4096, WUVT + (size_t)hd * 64 * 256, 256, 256, nt * 16, hf * 64, FOS{Os, hd}); }
        } break;
        case 14: if (PHM(14)) {
            big_gemm(smem, U, 1024, WGU1, MP, NGU, 1024, 0, FSw{Gp});
            small_gemm(smem, Os, 1024, WOC, 1024, 1024, 1024, 128, FB{Us, 1024});
        } break;
        case 15: if (PHM(15)) {
            big_gemm(smem, Gp, DFF, WDN1, MP, 1024, DFF, 0, FB{U, 1024});
            norm_rows<0, 0>(Us, Hs, Hs, a.in[I_NMPOST] + 1024, a.in[I_NFPRE] + 1024, Us, MS, dry_);
        } break;
        case 16: if (PHM(16)) {
            norm_rows<1, 0>(U, Hb2, Hp, a.in[I_NFPOST] + 1024, nullptr, nullptr, MP, dry_);
            small_gemm2(smem, Us, 1024, WGU1, 1024, 1024, NGU, 0, FSw{Gs});
        } break;
        case 17: if (PHM(17)) small_gemm_h(smem, Gs, DFF, WDN1, DFF, DFF, 1024, 0, FB{Us, 1024}); break;
        case 18: if (PHM(18)) norm_rows<0, 0>(Us, Hs, Hs, a.in[I_NFPOST] + 1024, nullptr, nullptr, MS, dry_); break;
        default: break;
        }
        if (r9hi > r9lo) {
            const int tid = ltid(), wid = tid >> 6, lane = tid & 63; (void)wid; (void)lane;
            const int gw = bid * 8 + wid, GW = G * 8;
            float nq[6]; f32x4 nkv = (f32x4){0.f, 0.f, 0.f, 0.f}; float nx1 = 0.f, nx2 = 0.f;
            auto p9load = [&](int rr_) { const bool smp_ = rr_ >= MP; const float* cq_ = (smp_ ? CQs + (size_t)(rr_ - MP) * NINC : CQ + (size_t)rr_ * NINC);
#pragma unroll
                for (int i = 0; i < 6; ++i) nq[i] = cq_[i * 64 + lane];
                nkv = *(const f32x4*)(cq_ + 384 + lane * 4); nx1 = cq_[640 + (lane & 15)]; nx2 = cq_[656 + (lane & 15)]; };
            float gqn[6];
#pragma unroll
            for (int i = 0; i < 6; ++i) gqn[i] = a.in[I_QNORM][i * 64 + lane];
            const f32x4 gkn = *(const f32x4*)(a.in[I_KVNORM] + lane * 4);
            if (r9lo + gw < r9hi) p9load(r9lo + gw);
            for (int rr = r9lo + gw; rr < r9hi; rr += GW) {
                const bool smp = rr >= MP; const int row = smp ? rr - MP : rr;
                const float* cq = (smp ? CQs : CQ) + (size_t)row * NINC;
                float q[6]; float ss = 0.f;
#pragma unroll
                for (int i = 0; i < 6; ++i) { q[i] = nq[i]; ss += q[i] * q[i]; }
                const f32x4 kv = nkv; const float x1 = nx1, x2 = nx2;
                if (rr + GW < r9hi) p9load(rr + GW);
                ss = wave_sum(ss); const float rq = __builtin_amdgcn_rsqf(ss * (1.0f / 384.0f) + EPS);
                bf16_t* cqn = (smp ? CQNs : CQN) + (size_t)row * 384;
#pragma unroll
                for (int i = 0; i < 6; ++i) cqn[i * 64 + lane] = f2bf(q[i] * rq * gqn[i]);
                float s2 = kv[0] * kv[0] + kv[1] * kv[1] + kv[2] * kv[2] + kv[3] * kv[3]; s2 = wave_sum(s2); const float rk = __builtin_amdgcn_rsqf(s2 * (1.0f / 256.0f) + EPS);
                const f32x4 gk = gkn;
                const f32x4 kn = (f32x4){kv[0] * rk * gk[0], kv[1] * rk * gk[1], kv[2] * rk * gk[2], kv[3] * rk * gk[3]};
                *(f32x4*)(out + (smp ? O_SCKV : O_PCKV) + (size_t)row * 256 + lane * 4) = kn;
                u32x2 w; w.x = cvtpk(kn[0], kn[1]); w.y = cvtpk(kn[2], kn[3]);
                const int b = row >> 4, t = row & 15;
                if (!smp) *(u32x2*)(CKVN + (size_t)row * 256 + lane * 4) = w;
                else { *(u32x2*)(CC + ((size_t)b * KEYP + PAST + t) * DLAT + lane * 4) = w;
#pragma unroll
                    for (int j = 0; j < 4; ++j) CCT[((size_t)b * 256 + lane * 4 + j) * KEYP + PAST + t] = f2bf(kn[j]); }
                if (lane < 16) {
                    const int pidx = smp ? 2048 + t : (row & 2047);
                    const float c = ROPE[pidx * 32 + lane], s = ROPE[pidx * 32 + 16 + lane];
                    const float o1 = x1 * c - x2 * s, o2 = x1 * s + x2 * c;
                    float* ko = out + (smp ? O_SKPE : O_PKPE) + (size_t)row * 32; ko[lane] = o1; ko[16 + lane] = o2;
                    if (!smp) *(unsigned*)(KPE + (size_t)row * 32 + 2 * lane) = cvtpk(o1, o2);
                    else *(unsigned*)(CC + ((size_t)b * KEYP + PAST + t) * DLAT + 256 + 2 * lane) = cvtpk(o1, o2);
                }
            }
            }
        }
    }
}

#ifndef MK_COOP
#define MK_COOP 1
#endif
extern "C" void kernel_launch(void* const* d_in, const int* in_sizes, int n_in, void* d_out, int out_size, void* d_ws, size_t ws_size, hipStream_t stream) {
    static int grid = 0;
    if (grid == 0) {
        if (n_in != 33 || ws_size < WS_END) { fprintf(stderr, "kernel_launch: unexpected n_in %d / ws %zu\n", n_in, ws_size); grid = -1; return; }
        int dev = 0, cus = 0, per_cu = 0;
        hipGetDevice(&dev); hipDeviceGetAttribute(&cus, hipDeviceAttributeMultiprocessorCount, dev);
        if (hipFuncSetAttribute((const void*)mk_fwd, hipFuncAttributeMaxDynamicSharedMemorySize, LDS_BYTES) != hipSuccess) { fprintf(stderr, "hipFuncSetAttribute failed\n"); grid = -1; return; }
        hipOccupancyMaxActiveBlocksPerMultiprocessor(&per_cu, (const void*)mk_fwd, 512, LDS_BYTES);
        (void)hipGetLastError();
        if (per_cu < 1) per_cu = 1;
        grid = cus;
    }
    if (grid < 0) return;
    if (hipMemsetAsync((char*)d_ws + WS_CTL, 0, CTL_BYTES, stream) != hipSuccess) { fprintf(stderr, "memset failed\n"); return; }
    Args a{};
    for (int i = 0; i < 33; ++i) a.in[i] = (const float*)d_in[i];
    a.out = (float*)d_out; a.ws = (char*)d_ws;
#if MK_COOP
    a.ph_lo = 0; a.ph_hi = NPHASE;
    void* args[] = {&a};
    hipError_t e = hipLaunchCooperativeKernel((const void*)mk_fwd, dim3(grid), dim3(512), args, LDS_BYTES, stream);
    if (e != hipSuccess) fprintf(stderr, "cooperative launch failed: %s (grid %d)\n", hipGetErrorString(e), grid);
#else
    for (int ph = 0; ph < NPHASE; ++ph) { a.ph_lo = ph; a.ph_hi = ph + 1; hipLaunchKernelGGL(mk_fwd, dim3(grid), dim3(512), LDS_BYTES, stream, a); }
#endif
}
```
